# Optimizing an MI355X kernel written in HIP

```python
import jax, jax.numpy as jnp
from jax import lax
import numpy as np

D_MODEL = 1024
BATCH = 32
SEQ = 2048
DEPTH = 2

N_MIXERS = 2
N_ATTN_LAYERS = (DEPTH + 1) // 2
N_REC_LAYERS = DEPTH // 2

HEAD_DIM = 64
N_HEADS = D_MODEL // HEAD_DIM
N_KV_HEADS = 2
GROUP = N_HEADS // N_KV_HEADS
ATTN_WIDTH = N_HEADS * HEAD_DIM
KV_WIDTH = N_KV_HEADS * HEAD_DIM
ATTN_IN = 2 * ATTN_WIDTH + 2 * KV_WIDTH
WINDOW = 128
ATTN_BLOCK = 128
ROPE_THETA = 500000.0
ROPE_DIM = HEAD_DIM // 4

REC_HEADS = 8
REC_KEY_DIM = 128
REC_VALUE_DIM = D_MODEL // REC_HEADS
FORGET_DIM = REC_HEADS * REC_KEY_DIM
REC_WIDTH = REC_HEADS * REC_VALUE_DIM
REC_IN = 2 * FORGET_DIM + 2 * REC_WIDTH
REC_CHUNK = 32

NORM_EPS = 1e-6

kernel_name = "hybrid_swa_sink_hgrn2_interleaved"


def rmsnorm(x, w):
    xf = x.astype(jnp.float32)
    y = xf * lax.rsqrt(jnp.mean(xf * xf, axis=-1, keepdims=True) + NORM_EPS)
    return (y * w.astype(jnp.float32)).astype(x.dtype)


def partial_rope(x, positions):
    half = ROPE_DIM // 2
    inv_freq = ROPE_THETA ** (-(jnp.arange(half, dtype=jnp.float32) * 2.0 / ROPE_DIM))
    ang = positions.astype(jnp.float32)[..., None] * inv_freq
    cos = jnp.cos(ang)[:, :, None, :]
    sin = jnp.sin(ang)[:, :, None, :]
    x1 = x[..., :half].astype(jnp.float32)
    x2 = x[..., half:ROPE_DIM].astype(jnp.float32)
    r1 = x1 * cos - x2 * sin
    r2 = x2 * cos + x1 * sin
    return jnp.concatenate([r1.astype(x.dtype), r2.astype(x.dtype), x[..., ROPE_DIM:]], axis=-1)


def sliding_window_gqa(q, k, v, sinks):
    B, T = q.shape[0], q.shape[1]
    nb = T // ATTN_BLOCK
    qb = q.reshape(B, nb, ATTN_BLOCK, N_KV_HEADS, GROUP, HEAD_DIM).transpose(1, 0, 2, 3, 4, 5)

    def span(t):
        tb = t.reshape(B, nb, ATTN_BLOCK, N_KV_HEADS, HEAD_DIM)
        prev = jnp.pad(tb, ((0, 0), (1, 0), (0, 0), (0, 0), (0, 0)))[:, :-1]
        return jnp.concatenate([prev, tb], axis=2).transpose(1, 0, 2, 3, 4)

    kk, vv = span(k), span(v)
    q_rel = jnp.arange(ATTN_BLOCK)[:, None] + ATTN_BLOCK
    k_rel = jnp.arange(2 * ATTN_BLOCK)[None, :]
    band = (k_rel <= q_rel) & (q_rel - k_rel < WINDOW)
    sink = sinks.astype(jnp.float32).reshape(N_KV_HEADS, GROUP)[None, :, :, None]
    scale = HEAD_DIM ** -0.5

    def block(args):
        qi, ki, vi, idx = args
        s = jnp.einsum('bqhgd,bkhd->bhgqk', qi, ki, preferred_element_type=jnp.float32) * scale
        valid = band & ((idx > 0) | (k_rel >= ATTN_BLOCK))
        s = jnp.where(valid, s, -jnp.inf)
        m = jnp.maximum(jnp.max(s, axis=-1), sink)
        p = jnp.exp(s - m[..., None])
        denom = jnp.sum(p, axis=-1) + jnp.exp(sink - m)
        p = (p / denom[..., None]).astype(vi.dtype)
        return jnp.einsum('bhgqk,bkhd->bqhgd', p, vi)

    out = lax.map(block, (qb, kk, vv, jnp.arange(nb)))
    return out.transpose(1, 0, 2, 3, 4, 5).reshape(B, T, ATTN_WIDTH)


def attention_mixer(h, positions, w_in, b_in, sinks, w_out, b_out):
    B, T = h.shape[0], h.shape[1]
    proj = h @ w_in + b_in
    q, k, v, z = jnp.split(proj, [ATTN_WIDTH, ATTN_WIDTH + KV_WIDTH, ATTN_WIDTH + 2 * KV_WIDTH], axis=-1)
    q = partial_rope(q.reshape(B, T, N_HEADS, HEAD_DIM), positions)
    k = partial_rope(k.reshape(B, T, N_KV_HEADS, HEAD_DIM), positions)
    v = v.reshape(B, T, N_KV_HEADS, HEAD_DIM)
    o = sliding_window_gqa(q, k, v, sinks)
    return (o * jax.nn.silu(z)) @ w_out + b_out


def chunked_gated_recurrence(q, k, v, log_f):
    B, T, H, K = q.shape
    V = v.shape[-1]
    nc = T // REC_CHUNK

    def to_chunks(t):
        return t.reshape(B, nc, REC_CHUNK, H, t.shape[-1]).transpose(1, 0, 3, 2, 4)

    qc, kc, vc, gc = to_chunks(q), to_chunks(k), to_chunks(v), to_chunks(log_f)
    causal = jnp.tril(jnp.ones((REC_CHUNK, REC_CHUNK), dtype=bool))[:, :, None]

    def step(S, inp):
        qi, ki, vi, gi = inp
        b = jnp.cumsum(gi, axis=2)
        b_last = b[:, :, -1:, :]
        o_inter = jnp.einsum('bhck,bhkv->bhcv', qi * jnp.exp(b), S)
        diff = b[:, :, :, None, :] - b[:, :, None, :, :]
        decay = jnp.exp(jnp.where(causal, diff, -jnp.inf))
        scores = jnp.einsum('bhtk,bhtsk->bhts', qi, decay * ki[:, :, None, :, :])
        o_intra = jnp.einsum('bhts,bhsv->bhtv', scores, vi)
        S_new = S * jnp.exp(b_last)[:, :, 0, :, None] + jnp.einsum(
            'bhck,bhcv->bhkv', ki * jnp.exp(b_last - b), vi)
        return S_new, o_inter + o_intra

    S0 = jnp.zeros((B, H, K, V), jnp.float32)
    _, o = lax.scan(step, S0, (qc, kc, vc, gc))
    return o.transpose(1, 0, 3, 2, 4).reshape(B, T, H, V)


def hgrn2_mixer(h, lower_bound, w_in, gnorm_w, w_out):
    B, T = h.shape[0], h.shape[1]
    proj = h @ w_in
    q, f, i, z = jnp.split(proj, [FORGET_DIM, 2 * FORGET_DIM, 2 * FORGET_DIM + REC_WIDTH], axis=-1)
    q = jax.nn.silu(q.astype(jnp.float32)).reshape(B, T, REC_HEADS, REC_KEY_DIM)
    lb = lower_bound.astype(jnp.float32)
    log_f = jnp.logaddexp(jnp.log(lb), jnp.log1p(-lb) + jax.nn.log_sigmoid(f.astype(jnp.float32)))
    k = -jnp.expm1(log_f)
    log_f = log_f.reshape(B, T, REC_HEADS, REC_KEY_DIM)
    k = k.reshape(B, T, REC_HEADS, REC_KEY_DIM)
    v = i.astype(jnp.float32).reshape(B, T, REC_HEADS, REC_VALUE_DIM)
    o = chunked_gated_recurrence(q, k, v, log_f)
    o = o * lax.rsqrt(jnp.mean(o * o, axis=-1, keepdims=True) + NORM_EPS) * gnorm_w.astype(jnp.float32)
    o = o.reshape(B, T, REC_WIDTH) * jax.nn.silu(z.astype(jnp.float32))
    return o.astype(h.dtype) @ w_out


def setup_inputs(seed: int = 0) -> dict:
    key = jax.random.key(seed)
    ks = jax.random.split(key, 16)
    f32 = jnp.float32
    x = jax.random.normal(ks[0], (BATCH, SEQ, D_MODEL), f32)
    offsets = jax.random.randint(ks[1], (BATCH, 1), 0, 4096, dtype=jnp.int32)
    positions = offsets + jnp.arange(SEQ, dtype=jnp.int32)[None, :]
    pre_norm_w = 1.0 + 0.02 * jax.random.normal(ks[2], (DEPTH, D_MODEL), f32)
    post_norm_w = 1.0 + 0.02 * jax.random.normal(ks[3], (DEPTH, D_MODEL), f32)
    attn_w_in = jax.random.normal(ks[4], (N_ATTN_LAYERS, D_MODEL, ATTN_IN), f32) * D_MODEL ** -0.5
    attn_b_in = 0.02 * jax.random.normal(ks[5], (N_ATTN_LAYERS, ATTN_IN), f32)
    attn_sinks = 0.5 * jax.random.normal(ks[6], (N_ATTN_LAYERS, N_HEADS), f32)
    attn_w_out = jax.random.normal(ks[7], (N_ATTN_LAYERS, ATTN_WIDTH, D_MODEL), f32) * ATTN_WIDTH ** -0.5
    attn_b_out = 0.02 * jax.random.normal(ks[8], (N_ATTN_LAYERS, D_MODEL), f32)
    rec_w_in = jax.random.normal(ks[9], (N_REC_LAYERS, D_MODEL, REC_IN), f32) * D_MODEL ** -0.5
    rec_lb_logits = 0.5 * jax.random.normal(ks[10], (DEPTH, FORGET_DIM), f32)
    rec_gnorm_w = 1.0 + 0.02 * jax.random.normal(ks[11], (N_REC_LAYERS, REC_VALUE_DIM), f32)
    rec_w_out = jax.random.normal(ks[12], (N_REC_LAYERS, REC_WIDTH, D_MODEL), f32) * REC_WIDTH ** -0.5
    return {"x": x, "positions": positions, "pre_norm_w": pre_norm_w, "post_norm_w": post_norm_w,
            "attn_w_in": attn_w_in, "attn_b_in": attn_b_in, "attn_sinks": attn_sinks,
            "attn_w_out": attn_w_out, "attn_b_out": attn_b_out, "rec_w_in": rec_w_in,
            "rec_lb_logits": rec_lb_logits, "rec_gnorm_w": rec_gnorm_w, "rec_w_out": rec_w_out}


def reference(x, positions, pre_norm_w, post_norm_w, attn_w_in, attn_b_in, attn_sinks,
              attn_w_out, attn_b_out, rec_w_in, rec_lb_logits, rec_gnorm_w, rec_w_out):
    probs = jax.nn.softmax(rec_lb_logits.astype(jnp.float32), axis=0)
    cum = jnp.cumsum(probs, axis=0)
    lower_bounds = cum - cum[0:1]
    for layer in range(DEPTH):
        h = rmsnorm(x, pre_norm_w[layer])
        j = layer // N_MIXERS
        if layer % N_MIXERS == 0:
            y = attention_mixer(h, positions, attn_w_in[j], attn_b_in[j], attn_sinks[j],
                                attn_w_out[j], attn_b_out[j])
        else:
            y = hgrn2_mixer(h, lower_bounds[layer], rec_w_in[j], rec_gnorm_w[j], rec_w_out[j])
        x = x + rmsnorm(y, post_norm_w[layer])
    return x
```

```cpp
#include <hip/hip_runtime.h>
#include <hip/hip_cooperative_groups.h>
#include <cstdio>
#include <cstdint>
namespace cg = cooperative_groups;

#define LAS __attribute__((address_space(3)))
typedef unsigned short bf16_t;
typedef short bf16x8 __attribute__((ext_vector_type(8)));
typedef float f32x4 __attribute__((ext_vector_type(4)));
typedef float f32x16 __attribute__((ext_vector_type(16)));
typedef unsigned u32x4 __attribute__((ext_vector_type(4)));
typedef unsigned u32x2 __attribute__((ext_vector_type(2)));
typedef float f32x2_t __attribute__((ext_vector_type(2)));
typedef __bf16 bf16x2_t __attribute__((ext_vector_type(2)));
typedef _Float16 f16x2_t __attribute__((ext_vector_type(2)));

constexpr int NB = 32, SEQ = 2048, DM = 1024, MTOK = NB * SEQ;
constexpr int ATTN_IN = 2304, REC_IN = 4096;
constexpr float NORM_EPS = 1e-6f;
constexpr float LOG2E = 1.4426950408889634f;
constexpr float QSCALE = 0.125f * 1.4426950408889634f;

constexpr size_t WS_WIN0 = 0;
constexpr size_t WS_WOUT0 = WS_WIN0 + (size_t)ATTN_IN * DM * 2;
constexpr size_t WS_WIN1 = WS_WOUT0 + (size_t)DM * DM * 2;
constexpr size_t WS_WOUT1 = WS_WIN1 + (size_t)REC_IN * DM * 2;
constexpr size_t WS_ROPE = WS_WOUT1 + (size_t)DM * DM * 2;
constexpr size_t WS_LB = WS_ROPE + (size_t)MTOK * 16 * 4;
constexpr size_t WS_PART = WS_LB + 4096;
constexpr size_t WS_H = WS_PART + (size_t)MTOK * 16 * 4;
constexpr size_t WS_Y = WS_H + (size_t)MTOK * DM * 2;
constexpr size_t WS_G1 = WS_Y + (size_t)MTOK * DM * 2;
constexpr size_t WS_BIG = WS_G1 + (size_t)MTOK * DM * 2;
constexpr size_t WS_QKVZ = WS_BIG;
constexpr size_t WS_G0 = WS_QKVZ + (size_t)MTOK * ATTN_IN * 2;
constexpr size_t WS_VT = WS_G0 + (size_t)MTOK * DM * 2;
constexpr size_t WS_END = WS_BIG + (size_t)MTOK * REC_IN * 2;
static_assert(WS_VT + (size_t)MTOK * 128 * 2 <= WS_END, "overlay");

__device__ __forceinline__ unsigned cvtpk(float lo, float hi) { f32x2_t v = {lo, hi}; bf16x2_t b = __builtin_convertvector(v, bf16x2_t); return __builtin_bit_cast(unsigned, b); }
__device__ __forceinline__ unsigned cvtpk_h(float lo, float hi) { f32x2_t v = {lo, hi}; f16x2_t b = __builtin_convertvector(v, f16x2_t); return __builtin_bit_cast(unsigned, b); }
__device__ __forceinline__ float bf_lo(unsigned u) { return __uint_as_float(u << 16); }
__device__ __forceinline__ float bf_hi(unsigned u) { return __uint_as_float(u & 0xffff0000u); }
__device__ __forceinline__ float h_lo(unsigned u) { f16x2_t h = __builtin_bit_cast(f16x2_t, u); return (float)h[0]; }
__device__ __forceinline__ float h_hi(unsigned u) { f16x2_t h = __builtin_bit_cast(f16x2_t, u); return (float)h[1]; }
__device__ __forceinline__ float silu_f(float v) { return v * __builtin_amdgcn_rcpf(1.0f + __expf(-v)); }
__device__ __forceinline__ float wave_sum(float v) {
#pragma unroll
    for (int o = 1; o < 64; o <<= 1) v += __shfl_xor(v, o);
    return v;
}

namespace pg8 {
constexpr int BM = 256, BK = 64, HALF = 128, HTB = HALF * BK * 2, STAGE_BYTES = 8 * HTB, NXCD = 8, WGM = 8;
__host__ __device__ __forceinline__ int lds_byte(int r, int c) { const int st = (r >> 4) * 2 + (c >> 5), rr = r & 15, cc = c & 31, ob = rr * 64 + cc * 2; return st * 1024 + (ob ^ (((ob >> 9) & 1) << 5)); }
__host__ __device__ __forceinline__ void stage_rc(int b, int& R, int& C) { const int st = b / 1024, sb = b % 1024, swz = sb ^ (((sb >> 9) & 1) << 5); R = (st >> 1) * 16 + swz / 64; C = (st & 1) * 32 + (swz % 64) / 2; }
__host__ __device__ __forceinline__ int perm32(int rho) { const int n = rho >> 4, i = rho & 15; return 8 * (i >> 2) + 4 * n + (i & 3); }

struct Unit { int pm, pn; };
struct Gemm { const bf16_t* A; const bf16_t* Bt; int M, N, K; };

struct StaticOrder {
    int nM, nN, nwg, G, c;
    __host__ __device__ void init(int M, int N, int G_, int c_) { nM = M / BM; nN = N / BM; nwg = nM * nN; G = G_; c = c_; }
    __host__ __device__ bool next(int i, Unit& u) const {
        const long L = (long)i * G + c; if (L >= nwg) return false;
        int wgid = (int)L; { const int q = nwg / NXCD, r = nwg % NXCD, xcd = wgid % NXCD, off = wgid / NXCD; wgid = (xcd < r ? xcd * (q + 1) : r * (q + 1) + (xcd - r) * q) + off; }
        const int nig = WGM * nN, gid = wgid / nig, fm = gid * WGM, gsz = (nM - fm) < WGM ? (nM - fm) : WGM;
        u.pm = fm + ((wgid % nig) % gsz); u.pn = (wgid % nig) / gsz; return true;
    }
};

template <class Epi, bool ALIGN_EPI, bool SP2>
__device__ __forceinline__ void gemm_phase(LAS unsigned char* lds, const Gemm g, const StaticOrder& S, const Epi& E) {
    const int tid = threadIdx.x, wid = __builtin_amdgcn_readfirstlane(tid >> 6), lane = tid & 63, wr = wid >> 2, wc = wid & 3, fr = lane & 15, fq = lane >> 4;
    const int K = g.K, nt = K / BK;
    unsigned voffA[2], voffB[2];
#pragma unroll
    for (int i = 0; i < 2; ++i) { int R, C; stage_rc(tid * 16 + i * 8192, R, C); const int Rb = Epi::PERM ? ((R & ~31) + perm32(R & 31)) : R;
        voffA[i] = (unsigned)(R * K + C) * 2u; voffB[i] = (unsigned)(Rb * K + C) * 2u; }
    const size_t kstep = (size_t)(BK * 2);
    const size_t hstep = (size_t)HALF * K * 2;
    const size_t tstep = 2 * hstep;
    const unsigned ldsw = (unsigned)wid * 1024u;
    const int aoff = lds_byte(wr * 64 + fr, fq * 8), boff = lds_byte(wc * 32 + fr, fq * 8);
#define PG8_SA(b, h) (((b) * 2 + (h)) * HTB)
#define PG8_SB(b, h) ((4 + (b) * 2 + (h)) * HTB)
#define PG8_STAGE(bufoff, gbase, voff) do { _Pragma("unroll") for (int _i = 0; _i < 2; ++_i) \
        __builtin_amdgcn_global_load_lds((const unsigned*)((const char*)(gbase) + (voff)[_i]), (LAS unsigned*)(lds + (bufoff) + ldsw + _i * 8192), 16, 0, 0); } while (0)
#define PG8_LDA(dst, b, h) do { _Pragma("unroll") for (int m = 0; m < 4; ++m) _Pragma("unroll") for (int k = 0; k < 2; ++k) dst[m][k] = *(const LAS bf16x8*)(lds + PG8_SA(b, h) + aoff + m * 2048 + k * 1024); } while (0)
#define PG8_LDB(dst, b, h) do { _Pragma("unroll") for (int n = 0; n < 2; ++n) _Pragma("unroll") for (int k = 0; k < 2; ++k) dst[n][k] = *(const LAS bf16x8*)(lds + PG8_SB(b, h) + boff + n * 2048 + k * 1024); } while (0)
#define PG8_MMA(ai, bj, Af, Bf) do { __builtin_amdgcn_s_setprio(1); _Pragma("unroll") for (int m = 0; m < 4; ++m) _Pragma("unroll") for (int n = 0; n < 2; ++n) _Pragma("unroll") for (int k = 0; k < 2; ++k) \
        acc[ai][bj][m][n] = __builtin_amdgcn_mfma_f32_16x16x32_bf16(Bf[n][k], Af[m][k], acc[ai][bj][m][n], 0, 0, 0); __builtin_amdgcn_s_setprio(0); } while (0)
#define PG8_WAIT_V(n) asm volatile("s_waitcnt vmcnt(" #n ")" ::: "memory")
#define PG8_WAIT_L(n) asm volatile("s_waitcnt lgkmcnt(" #n ")" ::: "memory")
#define PG8_BAR __builtin_amdgcn_s_barrier()
#define PG8_SCHED __builtin_amdgcn_sched_barrier(0)
    Unit cur, nxt; int ui = 0;
    if (!S.next(0, cur)) return;
    f32x4 acc[2][2][4][2];
#pragma unroll
    for (int a = 0; a < 2; ++a)
#pragma unroll
        for (int b = 0; b < 2; ++b)
#pragma unroll
            for (int m = 0; m < 4; ++m)
#pragma unroll
                for (int n = 0; n < 2; ++n) acc[a][b][m][n] = (f32x4){0.f, 0.f, 0.f, 0.f};
    bf16x8 At[4][2], B0[2][2], B1[2][2];
    const char* cA = (const char*)g.A + (size_t)cur.pm * tstep; const char* cB = (const char*)g.Bt + (size_t)cur.pn * tstep;
    if constexpr (SP2) {
        PG8_STAGE(PG8_SB(0, 0), cB, voffB); PG8_STAGE(PG8_SB(0, 1), cB + hstep, voffB); PG8_STAGE(PG8_SA(0, 0), cA, voffA); PG8_STAGE(PG8_SA(0, 1), cA + hstep, voffA);
        if (wr == 1) PG8_BAR;
        PG8_WAIT_V(2); PG8_BAR;
        PG8_STAGE(PG8_SB(1, 0), cB + kstep, voffB); PG8_STAGE(PG8_SA(1, 0), cA + kstep, voffA); PG8_STAGE(PG8_SB(1, 1), cB + hstep + kstep, voffB);
        PG8_WAIT_V(6); PG8_BAR;
    } else {
        PG8_STAGE(PG8_SB(0, 0), cB, voffB); PG8_STAGE(PG8_SA(0, 0), cA, voffA); PG8_STAGE(PG8_SB(0, 1), cB + hstep, voffB); PG8_STAGE(PG8_SA(0, 1), cA + hstep, voffA);
        if (wr == 1) PG8_BAR;
        PG8_WAIT_V(4); PG8_BAR;
        PG8_STAGE(PG8_SB(1, 0), cB + kstep, voffB); PG8_STAGE(PG8_SA(1, 0), cA + kstep, voffA); PG8_STAGE(PG8_SB(1, 1), cB + hstep + kstep, voffB);
        PG8_WAIT_V(6); PG8_BAR;
    }
    for (;;) {
        const bool has_next = S.next(ui + 1, nxt);
        const char* nA = has_next ? (const char*)g.A + (size_t)nxt.pm * tstep : cA; const char* nB = has_next ? (const char*)g.Bt + (size_t)nxt.pn * tstep : cB;
        for (int t = 0; t < nt; t += 2) {
            const bool last = (t == nt - 2);
            const char* a1 = cA + (size_t)(t + 1) * kstep;
            const char* a2 = last ? nA : cA + (size_t)(t + 2) * kstep; const char* b2 = last ? nB : cB + (size_t)(t + 2) * kstep;
            const char* a3 = a2 + kstep; const char* b3 = b2 + kstep;
            if constexpr (SP2) {
            PG8_LDB(B0, 0, 0); PG8_LDB(B1, 0, 1); PG8_SCHED; PG8_LDA(At, 0, 0); PG8_STAGE(PG8_SA(1, 1), a1 + hstep, voffA);
            PG8_WAIT_V(8); PG8_WAIT_L(0); PG8_BAR; PG8_MMA(0, 0, At, B0); PG8_MMA(0, 1, At, B1); PG8_BAR; PG8_SCHED;
            PG8_LDA(At, 0, 1); PG8_STAGE(PG8_SB(0, 0), b2, voffB); PG8_STAGE(PG8_SB(0, 1), b2 + hstep, voffB); PG8_STAGE(PG8_SA(0, 0), a2, voffA);
            PG8_WAIT_V(8); PG8_WAIT_L(0); PG8_BAR; PG8_MMA(1, 0, At, B0); PG8_MMA(1, 1, At, B1); PG8_BAR; PG8_SCHED;
            PG8_LDB(B0, 1, 0); PG8_LDB(B1, 1, 1); PG8_SCHED; PG8_LDA(At, 1, 0); PG8_STAGE(PG8_SA(0, 1), a2 + hstep, voffA);
            PG8_WAIT_V(8); PG8_WAIT_L(0); PG8_BAR; PG8_MMA(0, 0, At, B0); PG8_MMA(0, 1, At, B1); PG8_BAR; PG8_SCHED;
            PG8_LDA(At, 1, 1); PG8_STAGE(PG8_SB(1, 0), b3, voffB); PG8_STAGE(PG8_SB(1, 1), b3 + hstep, voffB); PG8_STAGE(PG8_SA(1, 0), a3, voffA);
            PG8_WAIT_V(8); PG8_WAIT_L(0); PG8_BAR; PG8_MMA(1, 0, At, B0); PG8_MMA(1, 1, At, B1); PG8_BAR; PG8_SCHED;
            } else {
            PG8_LDB(B0, 0, 0); PG8_SCHED; PG8_LDA(At, 0, 0); PG8_STAGE(PG8_SA(1, 1), a1 + hstep, voffA);
            PG8_WAIT_L(8); PG8_BAR; PG8_WAIT_L(0); PG8_MMA(0, 0, At, B0); PG8_BAR; PG8_SCHED;
            PG8_LDB(B1, 0, 1); PG8_STAGE(PG8_SB(0, 0), b2, voffB);
            PG8_BAR; PG8_WAIT_L(0); PG8_MMA(0, 1, At, B1); PG8_BAR;
            PG8_LDA(At, 0, 1); PG8_STAGE(PG8_SA(0, 0), a2, voffA);
            PG8_BAR; PG8_WAIT_L(0); PG8_MMA(1, 0, At, B0); PG8_BAR; PG8_SCHED;
            PG8_STAGE(PG8_SB(0, 1), b2 + hstep, voffB);
            PG8_WAIT_V(6); PG8_BAR; PG8_MMA(1, 1, At, B1); PG8_BAR;
            PG8_LDB(B0, 1, 0); PG8_SCHED; PG8_LDA(At, 1, 0); PG8_STAGE(PG8_SA(0, 1), a2 + hstep, voffA);
            PG8_WAIT_L(8); PG8_BAR; PG8_WAIT_L(0); PG8_MMA(0, 0, At, B0); PG8_BAR; PG8_SCHED;
            PG8_LDB(B1, 1, 1); PG8_STAGE(PG8_SB(1, 0), b3, voffB);
            PG8_BAR; PG8_WAIT_L(0); PG8_MMA(0, 1, At, B1); PG8_BAR;
            PG8_LDA(At, 1, 1); PG8_STAGE(PG8_SA(1, 0), a3, voffA);
            PG8_BAR; PG8_WAIT_L(0); PG8_MMA(1, 0, At, B0); PG8_BAR; PG8_SCHED;
            PG8_STAGE(PG8_SB(1, 1), b3 + hstep, voffB);
            PG8_WAIT_V(6); PG8_BAR; PG8_MMA(1, 1, At, B1); PG8_BAR;
            }
        }
        if constexpr (ALIGN_EPI) { if (wr == 0) PG8_BAR; }
        E(acc, cur, wr, wc, fr, fq);
        if (!has_next) break;
#pragma unroll
        for (int a = 0; a < 2; ++a)
#pragma unroll
            for (int b = 0; b < 2; ++b)
#pragma unroll
                for (int m = 0; m < 4; ++m)
#pragma unroll
                    for (int n = 0; n < 2; ++n) acc[a][b][m][n] = (f32x4){0.f, 0.f, 0.f, 0.f};
        cur = nxt; cA = nA; cB = nB; ++ui;
        if constexpr (ALIGN_EPI) { if (wr == 1) PG8_BAR; }
    }
    PG8_WAIT_V(0);
    if constexpr (!ALIGN_EPI) { if (wr == 0) PG8_BAR; }
    PG8_BAR;
#undef PG8_SA
#undef PG8_SB
#undef PG8_STAGE
#undef PG8_LDA
#undef PG8_LDB
#undef PG8_MMA
#undef PG8_WAIT_V
#undef PG8_WAIT_L
#undef PG8_BAR
#undef PG8_SCHED
}

struct EpiAttnIn {
    static constexpr bool PERM = true;
    bf16_t* O; bf16_t* VT; const float* bias; const float* rope;
    __device__ __forceinline__ void operator()(const f32x4 (&acc)[2][2][4][2], const Unit& u, int wr, int wc, int fr, int fq) const {
        const int row0 = u.pm * BM + wr * 64 + fr;
#pragma unroll
        for (int bj = 0; bj < 2; ++bj) {
            const int cbase = u.pn * BM + bj * HALF;
            const int c0 = cbase + wc * 32 + 8 * fq;
            const f32x4 bv0 = *(const f32x4*)(bias + c0), bv1 = *(const f32x4*)(bias + c0 + 4);
            const int kind = cbase < 1024 ? 0 : (cbase < 1152 ? 1 : (cbase < 1280 ? 2 : 3));
            const bool ropew = (kind <= 1) && ((wc & 1) == 0);
#pragma unroll
            for (int ai = 0; ai < 2; ++ai)
#pragma unroll
                for (int m = 0; m < 4; ++m) {
                    const int row = row0 + ai * HALF + m * 16;
                    f32x4 v0 = acc[ai][bj][m][0] + bv0, v1 = acc[ai][bj][m][1] + bv1;
                    if (ropew) {
                        f32x4 p0, p1;
#pragma unroll
                        for (int i = 0; i < 4; ++i) { p0[i] = __shfl_xor(v0[i], 16); p1[i] = __shfl_xor(v1[i], 16); }
                        if (fq < 2) {
                            const float* rp = rope + (size_t)row * 16;
                            const f32x4 c0v = *(const f32x4*)(rp), c1v = *(const f32x4*)(rp + 4), s0v = *(const f32x4*)(rp + 8), s1v = *(const f32x4*)(rp + 12);
                            const float sg = (fq == 0) ? -1.f : 1.f;
                            v0 = v0 * c0v + sg * (p0 * s0v); v1 = v1 * c1v + sg * (p1 * s1v);
                        }
                    }
                    if (kind == 0) { v0 = v0 * QSCALE; v1 = v1 * QSCALE; }
                    if (kind == 3) {
#pragma unroll
                        for (int i = 0; i < 4; ++i) { v0[i] = silu_f(v0[i]); v1[i] = silu_f(v1[i]); }
                    }
                    if (kind == 2) {
                        const int b = row >> 11, t = row & 2047, dd = (c0 - 1152);
                        bf16_t* vp = VT + ((size_t)(b * 128 + dd)) * SEQ + t;
#pragma unroll
                        for (int i = 0; i < 4; ++i) { vp[(size_t)i * SEQ] = (bf16_t)(cvtpk(v0[i], 0.f) & 0xffffu); vp[(size_t)(i + 4) * SEQ] = (bf16_t)(cvtpk(v1[i], 0.f) & 0xffffu); }
                    } else {
                        u32x4 w; w.x = cvtpk(v0[0], v0[1]); w.y = cvtpk(v0[2], v0[3]); w.z = cvtpk(v1[0], v1[1]); w.w = cvtpk(v1[2], v1[3]);
                        *(u32x4*)(O + (size_t)row * ATTN_IN + c0) = w;
                    }
                }
        }
    }
};
struct EpiRecIn {
    static constexpr bool PERM = true;
    bf16_t* O; const float* lb;
    __device__ __forceinline__ void operator()(const f32x4 (&acc)[2][2][4][2], const Unit& u, int wr, int wc, int fr, int fq) const {
        const int row0 = u.pm * BM + wr * 64 + fr;
        const int seg = u.pn >> 2;
#pragma unroll
        for (int bj = 0; bj < 2; ++bj) {
            const int c0 = u.pn * BM + bj * HALF + wc * 32 + 8 * fq;
            f32x4 l0 = (f32x4){0.f, 0.f, 0.f, 0.f}, l1 = l0;
            if (seg == 1) { l0 = *(const f32x4*)(lb + (c0 - 1024)); l1 = *(const f32x4*)(lb + (c0 - 1024) + 4); }
#pragma unroll
            for (int ai = 0; ai < 2; ++ai)
#pragma unroll
                for (int m = 0; m < 4; ++m) {
                    const int row = row0 + ai * HALF + m * 16;
                    f32x4 v0 = acc[ai][bj][m][0], v1 = acc[ai][bj][m][1];
                    u32x4 w;
                    if (seg == 1) {
#pragma unroll
                        for (int i = 0; i < 4; ++i) {
                            const float s0 = __builtin_amdgcn_rcpf(1.0f + __expf(-v0[i])), s1 = __builtin_amdgcn_rcpf(1.0f + __expf(-v1[i]));
                            v0[i] = __logf(l0[i] + (1.0f - l0[i]) * s0); v1[i] = __logf(l1[i] + (1.0f - l1[i]) * s1);
                        }
                        w.x = cvtpk_h(v0[0], v0[1]); w.y = cvtpk_h(v0[2], v0[3]); w.z = cvtpk_h(v1[0], v1[1]); w.w = cvtpk_h(v1[2], v1[3]);
                    } else {
                        if (seg != 2) {
#pragma unroll
                            for (int i = 0; i < 4; ++i) { v0[i] = silu_f(v0[i]); v1[i] = silu_f(v1[i]); }
                        }
                        w.x = cvtpk(v0[0], v0[1]); w.y = cvtpk(v0[2], v0[3]); w.z = cvtpk(v1[0], v1[1]); w.w = cvtpk(v1[2], v1[3]);
                    }
                    *(u32x4*)(O + (size_t)row * REC_IN + c0) = w;
                }
        }
    }
};
struct EpiOut {
    static constexpr bool PERM = true;
    bf16_t* O; const float* bias; float* part;
    __device__ __forceinline__ void operator()(const f32x4 (&acc)[2][2][4][2], const Unit& u, int wr, int wc, int fr, int fq) const {
        const int row0 = u.pm * BM + wr * 64 + fr;
        f32x4 bv[2][2];
#pragma unroll
        for (int bj = 0; bj < 2; ++bj) { const int c0 = u.pn * BM + bj * HALF + wc * 32 + 8 * fq;
            bv[bj][0] = bias ? *(const f32x4*)(bias + c0) : (f32x4){0.f, 0.f, 0.f, 0.f}; bv[bj][1] = bias ? *(const f32x4*)(bias + c0 + 4) : (f32x4){0.f, 0.f, 0.f, 0.f}; }
#pragma unroll
        for (int ai = 0; ai < 2; ++ai)
#pragma unroll
            for (int m = 0; m < 4; ++m) {
                const int row = row0 + ai * HALF + m * 16;
                float ss = 0.f;
#pragma unroll
                for (int bj = 0; bj < 2; ++bj) {
                    const int c0 = u.pn * BM + bj * HALF + wc * 32 + 8 * fq;
                    const f32x4 v0 = acc[ai][bj][m][0] + bv[bj][0], v1 = acc[ai][bj][m][1] + bv[bj][1];
                    ss += (v0[0] * v0[0] + v0[1] * v0[1]) + (v0[2] * v0[2] + v0[3] * v0[3]) + (v1[0] * v1[0] + v1[1] * v1[1]) + (v1[2] * v1[2] + v1[3] * v1[3]);
                    u32x4 w; w.x = cvtpk(v0[0], v0[1]); w.y = cvtpk(v0[2], v0[3]); w.z = cvtpk(v1[0], v1[1]); w.w = cvtpk(v1[2], v1[3]);
                    *(u32x4*)(O + (size_t)row * DM + c0) = w;
                }
                ss += __shfl_xor(ss, 16); ss += __shfl_xor(ss, 32);
                if (fq == 0) part[(size_t)row * 16 + u.pn * 4 + wc] = ss;
            }
    }
};
}

__device__ __forceinline__ void transpose_item(const float* W, int K, int N, bf16_t* WT, LAS float* scr, int item, int lane) {
    const int nblk = N / 32, kb = item / nblk, nb = item % nblk, k0 = 64 * kb, n0 = 32 * nb;
#pragma unroll 8
    for (int i = 0; i < 32; ++i) { const int kk = 2 * i + (lane >> 5); scr[kk * 33 + (lane & 31)] = W[(size_t)(k0 + kk) * N + n0 + (lane & 31)]; }
    asm volatile("s_waitcnt lgkmcnt(0)" ::: "memory");
    const int c = lane & 7;
#pragma unroll
    for (int j = 0; j < 4; ++j) { const int n = (lane >> 3) + 8 * j; const LAS float* s = scr + (8 * c) * 33 + n;
        u32x4 o; o.x = cvtpk(s[0 * 33], s[1 * 33]); o.y = cvtpk(s[2 * 33], s[3 * 33]); o.z = cvtpk(s[4 * 33], s[5 * 33]); o.w = cvtpk(s[6 * 33], s[7 * 33]);
        *(u32x4*)(WT + (size_t)(n0 + n) * K + k0 + 8 * c) = o; }
    asm volatile("s_waitcnt lgkmcnt(0)" ::: "memory");
}

struct Args {
    const float* x; const int* pos; const float* pre_w; const float* post_w; const float* a_win; const float* a_bin; const float* a_sinks;
    const float* a_wout; const float* a_bout; const float* r_win; const float* r_lbl; const float* r_gw; const float* r_wout;
    float* out; unsigned char* ws; int ph_lo, ph_hi;
};

__device__ __forceinline__ void load_w16(const float* w, int lane, f32x4 (&r)[2][2]) {
#pragma unroll
    for (int j = 0; j < 2; ++j)
#pragma unroll
        for (int h = 0; h < 2; ++h) r[j][h] = *(const f32x4*)(w + 512 * j + 8 * lane + 4 * h);
}

__device__ __forceinline__ void p_prologue(const Args& a, LAS unsigned char* lds, int G) {
    const int tid = threadIdx.x, lane = tid & 63, wid = __builtin_amdgcn_readfirstlane(tid >> 6);
    LAS float* scr = (LAS float*)(lds + wid * 16384);
    const int gw = blockIdx.x * 8 + wid, NGW = G * 8;
    constexpr int I_A = (DM / 64) * (ATTN_IN / 32), I_O = (DM / 64) * (DM / 32), I_R = (DM / 64) * (REC_IN / 32);
    constexpr int NITEMS = I_A + I_O + I_R + I_O;
    for (int it = gw; it < NITEMS; it += NGW) {
        int r = it;
        if (r < I_A) { transpose_item(a.a_win, DM, ATTN_IN, (bf16_t*)(a.ws + WS_WIN0), scr, r, lane); continue; } r -= I_A;
        if (r < I_O) { transpose_item(a.a_wout, DM, DM, (bf16_t*)(a.ws + WS_WOUT0), scr, r, lane); continue; } r -= I_O;
        if (r < I_R) { transpose_item(a.r_win, DM, REC_IN, (bf16_t*)(a.ws + WS_WIN1), scr, r, lane); continue; } r -= I_R;
        transpose_item(a.r_wout, DM, DM, (bf16_t*)(a.ws + WS_WOUT1), scr, r, lane);
    }
    {
        float* rope = (float*)(a.ws + WS_ROPE);
        const int gt = blockIdx.x * 512 + tid, NGT = G * 512;
        for (int e = gt; e < MTOK * 8; e += NGT) {
            const int row = e >> 3, i = e & 7;
            const float invf = (i == 0) ? 1.0f : (i == 1) ? 0.19392274474868576f : (i == 2) ? 0.03760603093086393f : (i == 3) ? 0.007292664737217109f :
                               (i == 4) ? 0.001414213562373095f : (i == 5) ? 0.0002742481756762073f : (i == 6) ? 5.318295896944988e-05f : 1.031338537721246e-05f;
            const float ang = (float)a.pos[row] * invf;
            rope[(size_t)row * 16 + i] = cosf(ang); rope[(size_t)row * 16 + 8 + i] = sinf(ang);
        }
        float* lb = (float*)(a.ws + WS_LB);
        for (int e = gt; e < DM; e += NGT) { const float l0 = a.r_lbl[e], l1 = a.r_lbl[DM + e]; lb[e] = 1.0f / (1.0f + expf(l0 - l1)); }
    }
    {
        f32x4 wv[2][2]; load_w16(a.pre_w, lane, wv);
        bf16_t* H = (bf16_t*)(a.ws + WS_H);
        for (int row = gw; row < MTOK; row += NGW) {
            const float* xr = a.x + (size_t)row * DM;
            f32x4 xv[2][2]; float ss = 0.f;
#pragma unroll
            for (int j = 0; j < 2; ++j)
#pragma unroll
                for (int h = 0; h < 2; ++h) { xv[j][h] = *(const f32x4*)(xr + 512 * j + 8 * lane + 4 * h); const f32x4 t = xv[j][h]; ss += (t[0] * t[0] + t[1] * t[1]) + (t[2] * t[2] + t[3] * t[3]); }
            const float rstd = rsqrtf(wave_sum(ss) * (1.0f / DM) + NORM_EPS);
#pragma unroll
            for (int j = 0; j < 2; ++j) {
                const f32x4 h0 = xv[j][0] * rstd * wv[j][0], h1 = xv[j][1] * rstd * wv[j][1];
                u32x4 w; w.x = cvtpk(h0[0], h0[1]); w.y = cvtpk(h0[2], h0[3]); w.z = cvtpk(h1[0], h1[1]); w.w = cvtpk(h1[2], h1[3]);
                *(u32x4*)(H + (size_t)row * DM + 512 * j + 8 * lane) = w;
            }
        }
    }
}

template <bool WITH_H>
__device__ __forceinline__ void p_residual(const bf16_t* Y, const float* part, const float* xin, const float* post_w, const float* pre_w_next, float* xout, bf16_t* Hout, int G) {
    const int tid = threadIdx.x, lane = tid & 63, wid = __builtin_amdgcn_readfirstlane(tid >> 6);
    const int gw = blockIdx.x * 8 + wid, NGW = G * 8;
    f32x4 wp[2][2], wn[2][2]; load_w16(post_w, lane, wp);
    if (WITH_H) load_w16(pre_w_next, lane, wn);
    for (int row = gw; row < MTOK; row += NGW) {
        const float ps = (lane < 16) ? part[(size_t)row * 16 + lane] : 0.f;
        u32x4 yv[2]; f32x4 xv[2][2];
#pragma unroll
        for (int j = 0; j < 2; ++j) { yv[j] = *(const u32x4*)(Y + (size_t)row * DM + 512 * j + 8 * lane);
#pragma unroll
            for (int h = 0; h < 2; ++h) xv[j][h] = *(const f32x4*)(xin + (size_t)row * DM + 512 * j + 8 * lane + 4 * h); }
        const float rstd = rsqrtf(wave_sum(ps) * (1.0f / DM) + NORM_EPS);
        float ss = 0.f;
#pragma unroll
        for (int j = 0; j < 2; ++j) {
            const f32x4 y0 = (f32x4){bf_lo(yv[j].x), bf_hi(yv[j].x), bf_lo(yv[j].y), bf_hi(yv[j].y)}, y1 = (f32x4){bf_lo(yv[j].z), bf_hi(yv[j].z), bf_lo(yv[j].w), bf_hi(yv[j].w)};
            xv[j][0] = xv[j][0] + y0 * rstd * wp[j][0]; xv[j][1] = xv[j][1] + y1 * rstd * wp[j][1];
#pragma unroll
            for (int h = 0; h < 2; ++h) { const f32x4 t = xv[j][h]; ss += (t[0] * t[0] + t[1] * t[1]) + (t[2] * t[2] + t[3] * t[3]); *(f32x4*)(xout + (size_t)row * DM + 512 * j + 8 * lane + 4 * h) = t; }
        }
        if (WITH_H) {
            const float r2 = rsqrtf(wave_sum(ss) * (1.0f / DM) + NORM_EPS);
#pragma unroll
            for (int j = 0; j < 2; ++j) {
                const f32x4 h0 = xv[j][0] * r2 * wn[j][0], h1 = xv[j][1] * r2 * wn[j][1];
                u32x4 w; w.x = cvtpk(h0[0], h0[1]); w.y = cvtpk(h0[2], h0[3]); w.z = cvtpk(h1[0], h1[1]); w.w = cvtpk(h1[2], h1[3]);
                *(u32x4*)(Hout + (size_t)row * DM + 512 * j + 8 * lane) = w;
            }
        }
    }
}

constexpr int AK_STRIDE = 144, AV_STRIDE = 520, AK_BYTES = 256 * AK_STRIDE, AV_BYTES = 64 * AV_STRIDE;
__device__ __forceinline__ void p_attention(LAS unsigned char* lds, const bf16_t* QKVZ, const bf16_t* VT, const float* sinks, bf16_t* G0, int G) {
    const int tid = threadIdx.x, lane = tid & 63, wid = __builtin_amdgcn_readfirstlane(tid >> 6), r32 = lane & 31, hi = lane >> 5;
    LAS unsigned char* Ks = lds; LAS unsigned char* Vs = lds + AK_BYTES;
    const float NEG = -INFINITY;
    for (int u = blockIdx.x; u < NB * 16 * 2; u += G) {
        const int kvh = u & 1, n = (u >> 1) & 15, b = u >> 5;
        const size_t rowb = (size_t)b * SEQ;
        const int kstart = n * 128 - 128;
#pragma unroll
        for (int i = 0; i < 4; ++i) {
            const int idx = tid + 512 * i, kr = idx >> 3, ch = idx & 7, tok = kstart + kr;
            u32x4 v = (u32x4){0u, 0u, 0u, 0u};
            if (tok >= 0) v = *(const u32x4*)(QKVZ + (rowb + tok) * ATTN_IN + 1024 + kvh * 64 + ch * 8);
            *(LAS u32x4*)(Ks + kr * AK_STRIDE + ch * 16) = v;
        }
#pragma unroll
        for (int i = 0; i < 4; ++i) {
            const int idx = tid + 512 * i, d = idx >> 5, ch = idx & 31, tok = kstart + ch * 8;
            u32x4 v = (u32x4){0u, 0u, 0u, 0u};
            if (tok >= 0) v = *(const u32x4*)(VT + ((size_t)(b * 128 + kvh * 64 + d)) * SEQ + tok);
            *(LAS u32x2*)(Vs + d * AV_STRIDE + ch * 16) = (u32x2){v.x, v.y};
            *(LAS u32x2*)(Vs + d * AV_STRIDE + ch * 16 + 8) = (u32x2){v.z, v.w};
        }
        __syncthreads();
        const int hq = kvh * 8 + wid;
        const float sink2 = sinks[hq] * LOG2E;
        for (int j = 0; j < 4; ++j) {
            const size_t row = rowb + n * 128 + 32 * j + r32;
            bf16x8 qf[4];
#pragma unroll
            for (int d0 = 0; d0 < 4; ++d0) qf[d0] = *(const bf16x8*)(QKVZ + row * ATTN_IN + hq * 64 + d0 * 16 + hi * 8);
            f32x16 st[5];
#pragma unroll
            for (int tt = 0; tt < 5; ++tt) {
                const bool tv = (n > 0) || (j + tt >= 4);
                if (tv) {
#pragma unroll
                    for (int r = 0; r < 16; ++r) st[tt][r] = 0.f;
#pragma unroll
                    for (int d0 = 0; d0 < 4; ++d0) {
                        const bf16x8 kf = *(const LAS bf16x8*)(Ks + (32 * (j + tt) + r32) * AK_STRIDE + d0 * 32 + hi * 16);
                        st[tt] = __builtin_amdgcn_mfma_f32_32x32x16_bf16(kf, qf[d0], st[tt], 0, 0, 0);
                    }
                } else {
#pragma unroll
                    for (int r = 0; r < 16; ++r) st[tt][r] = NEG;
                }
            }
            float mx = sink2;
#pragma unroll
            for (int r = 0; r < 16; ++r) {
                const int kk = (r & 3) + 8 * (r >> 2) + 4 * hi;
                if (!(kk > r32)) st[0][r] = NEG;
                if (!(kk <= r32)) st[4][r] = NEG;
            }
#pragma unroll
            for (int tt = 0; tt < 5; ++tt)
#pragma unroll
                for (int r = 0; r < 16; ++r) mx = fmaxf(mx, st[tt][r]);
            mx = fmaxf(mx, __shfl_xor(mx, 32));
            float l = 0.f;
#pragma unroll
            for (int tt = 0; tt < 5; ++tt)
#pragma unroll
                for (int r = 0; r < 16; ++r) { const float p = __builtin_amdgcn_exp2f(st[tt][r] - mx); st[tt][r] = p; l += p; }
            l += __shfl_xor(l, 32);
            l += __builtin_amdgcn_exp2f(sink2 - mx);
            const float inv = 1.0f / l;
            f32x16 ot[2];
#pragma unroll
            for (int r = 0; r < 16; ++r) { ot[0][r] = 0.f; ot[1][r] = 0.f; }
#pragma unroll
            for (int tt = 0; tt < 5; ++tt) {
                const bool tv = (n > 0) || (j + tt >= 4);
                if (tv) {
#pragma unroll
                    for (int ks = 0; ks < 2; ++ks) {
                        u32x4 pw; pw.x = cvtpk(st[tt][8 * ks + 0], st[tt][8 * ks + 1]); pw.y = cvtpk(st[tt][8 * ks + 2], st[tt][8 * ks + 3]);
                        pw.z = cvtpk(st[tt][8 * ks + 4], st[tt][8 * ks + 5]); pw.w = cvtpk(st[tt][8 * ks + 6], st[tt][8 * ks + 7]);
                        const bf16x8 pf = __builtin_bit_cast(bf16x8, pw);
#pragma unroll
                        for (int blk = 0; blk < 2; ++blk) {
                            const LAS unsigned char* vp = Vs + (32 * blk + r32) * AV_STRIDE + (32 * (j + tt) + 16 * ks + 4 * hi) * 2;
                            const u32x2 lo = *(const LAS u32x2*)vp, hh = *(const LAS u32x2*)(vp + 16);
                            const bf16x8 vf = __builtin_bit_cast(bf16x8, (u32x4){lo.x, lo.y, hh.x, hh.y});
                            ot[blk] = __builtin_amdgcn_mfma_f32_32x32x16_bf16(vf, pf, ot[blk], 0, 0, 0);
                        }
                    }
                }
            }
#pragma unroll
            for (int blk = 0; blk < 2; ++blk)
#pragma unroll
                for (int rq = 0; rq < 4; ++rq) {
                    const int d = 32 * blk + 8 * rq + 4 * hi;
                    const u32x2 z = *(const u32x2*)(QKVZ + row * ATTN_IN + 1280 + hq * 64 + d);
                    const float o0 = ot[blk][4 * rq + 0] * inv * bf_lo(z.x), o1 = ot[blk][4 * rq + 1] * inv * bf_hi(z.x);
                    const float o2 = ot[blk][4 * rq + 2] * inv * bf_lo(z.y), o3 = ot[blk][4 * rq + 3] * inv * bf_hi(z.y);
                    *(u32x2*)(G0 + row * DM + hq * 64 + d) = (u32x2){cvtpk(o0, o1), cvtpk(o2, o3)};
                }
        }
        __syncthreads();
    }
}

constexpr int RC = 32, RQ_STRIDE = 272;
constexpr int R_QD = 0, R_QR = R_QD + RC * RQ_STRIDE, R_KR = R_QR + RC * RQ_STRIDE, R_KDT = R_KR + RC * RQ_STRIDE, R_VT = R_KDT + 128 * 64, R_PS = R_VT + 128 * 64,
              R_DEC = R_PS + 8 * 128 * 4, R_OSQ = R_DEC + 512, R_END = R_OSQ + 8 * 32 * 4;
__device__ __forceinline__ void p_recurrence(LAS unsigned char* lds, const bf16_t* REC, const float* gnw, bf16_t* G1, int G) {
    const int tid = threadIdx.x, lane = tid & 63, wid = __builtin_amdgcn_readfirstlane(tid >> 6), c16 = lane & 15, quad = lane >> 4;
    for (int u = blockIdx.x; u < NB * 8; u += G) {
        const int b = u >> 3, h = u & 7;
        const size_t rowb = (size_t)b * SEQ;
        const float gwv = gnw[16 * wid + c16];
        f32x4 S[8];
#pragma unroll
        for (int kt = 0; kt < 8; ++kt) S[kt] = (f32x4){0.f, 0.f, 0.f, 0.f};
        for (int c = 0; c < SEQ / RC; ++c) {
            const size_t crow = rowb + (size_t)c * RC;
            unsigned qv[4], gv[4], vv[4];
#pragma unroll
            for (int i = 0; i < 4; ++i) {
                const bf16_t* rp = REC + (crow + 4 * wid + i) * REC_IN + h * 128 + 2 * lane;
                qv[i] = *(const unsigned*)(rp); gv[i] = *(const unsigned*)(rp + 1024); vv[i] = *(const unsigned*)(rp + 2048);
            }
            bf16_t zv[8];
#pragma unroll
            for (int ti = 0; ti < 2; ++ti)
#pragma unroll
                for (int r = 0; r < 4; ++r) zv[ti * 4 + r] = REC[(crow + 16 * ti + 4 * quad + r) * REC_IN + 3072 + h * 128 + 16 * wid + c16];
            float g0[4], g1[4], c0 = 0.f, c1 = 0.f, cs0[4], cs1[4];
#pragma unroll
            for (int i = 0; i < 4; ++i) { g0[i] = h_lo(gv[i]); g1[i] = h_hi(gv[i]); c0 += g0[i]; c1 += g1[i]; cs0[i] = c0; cs1[i] = c1; }
            *(LAS f32x2_t*)(lds + R_PS + (wid * 128 + 2 * lane) * 4) = (f32x2_t){c0, c1};
            __syncthreads();
            float pre0 = 0.f, pre1 = 0.f, ref0 = 0.f, ref1 = 0.f, tot0 = 0.f, tot1 = 0.f;
#pragma unroll
            for (int p = 0; p < 8; ++p) {
                const f32x2_t s = *(const LAS f32x2_t*)(lds + R_PS + (p * 128 + 2 * lane) * 4);
                if (p < wid) { pre0 += s.x; pre1 += s.y; }
                if (p < 4) { ref0 += s.x; ref1 += s.y; }
                tot0 += s.x; tot1 += s.y;
            }
            unsigned kd0[4], kd1[4];
#pragma unroll
            for (int i = 0; i < 4; ++i) {
                const int t = 4 * wid + i;
                const float b0 = pre0 + cs0[i], b1 = pre1 + cs1[i];
                const float q0 = bf_lo(qv[i]), q1 = bf_hi(qv[i]);
                const float k0 = 1.0f - __expf(g0[i]), k1 = 1.0f - __expf(g1[i]);
                *(LAS unsigned*)(lds + R_QD + t * RQ_STRIDE + lane * 4) = cvtpk(q0 * __expf(b0), q1 * __expf(b1));
                *(LAS unsigned*)(lds + R_QR + t * RQ_STRIDE + lane * 4) = cvtpk(q0 * __expf(fminf(b0 - ref0, 80.f)), q1 * __expf(fminf(b1 - ref1, 80.f)));
                *(LAS unsigned*)(lds + R_KR + t * RQ_STRIDE + lane * 4) = cvtpk(k0 * __expf(fminf(ref0 - b0, 80.f)), k1 * __expf(fminf(ref1 - b1, 80.f)));
                kd0[i] = cvtpk(k0 * __expf(tot0 - b0), 0.f) & 0xffffu; kd1[i] = cvtpk(k1 * __expf(tot1 - b1), 0.f) & 0xffffu;
            }
            *(LAS u32x2*)(lds + R_KDT + (2 * lane) * 64 + wid * 8) = (u32x2){kd0[0] | (kd0[1] << 16), kd0[2] | (kd0[3] << 16)};
            *(LAS u32x2*)(lds + R_KDT + (2 * lane + 1) * 64 + wid * 8) = (u32x2){kd1[0] | (kd1[1] << 16), kd1[2] | (kd1[3] << 16)};
            *(LAS u32x2*)(lds + R_VT + (2 * lane) * 64 + wid * 8) = (u32x2){(vv[0] & 0xffffu) | (vv[1] << 16), (vv[2] & 0xffffu) | (vv[3] << 16)};
            *(LAS u32x2*)(lds + R_VT + (2 * lane + 1) * 64 + wid * 8) = (u32x2){(vv[0] >> 16) | (vv[1] & 0xffff0000u), (vv[2] >> 16) | (vv[3] & 0xffff0000u)};
            if (wid == 0) *(LAS f32x2_t*)(lds + R_DEC + 2 * lane * 4) = (f32x2_t){__expf(tot0), __expf(tot1)};
            __syncthreads();
            f32x4 s00 = (f32x4){0.f, 0.f, 0.f, 0.f}, s01 = s00, s11 = s00;
#pragma unroll
            for (int kk = 0; kk < 4; ++kk) {
                const bf16x8 ka0 = *(const LAS bf16x8*)(lds + R_KR + (c16) * RQ_STRIDE + kk * 64 + quad * 16);
                const bf16x8 ka1 = *(const LAS bf16x8*)(lds + R_KR + (16 + c16) * RQ_STRIDE + kk * 64 + quad * 16);
                const bf16x8 qb0 = *(const LAS bf16x8*)(lds + R_QR + (c16) * RQ_STRIDE + kk * 64 + quad * 16);
                const bf16x8 qb1 = *(const LAS bf16x8*)(lds + R_QR + (16 + c16) * RQ_STRIDE + kk * 64 + quad * 16);
                s00 = __builtin_amdgcn_mfma_f32_16x16x32_bf16(ka0, qb0, s00, 0, 0, 0);
                s01 = __builtin_amdgcn_mfma_f32_16x16x32_bf16(ka0, qb1, s01, 0, 0, 0);
                s11 = __builtin_amdgcn_mfma_f32_16x16x32_bf16(ka1, qb1, s11, 0, 0, 0);
            }
#pragma unroll
            for (int r = 0; r < 4; ++r) { if (4 * quad + r > c16) { s00[r] = 0.f; s11[r] = 0.f; } }
            u32x4 pw0, pw1;
            pw0.x = cvtpk(s00[0], s00[1]); pw0.y = cvtpk(s00[2], s00[3]); pw0.z = 0u; pw0.w = 0u;
            pw1.x = cvtpk(s01[0], s01[1]); pw1.y = cvtpk(s01[2], s01[3]); pw1.z = cvtpk(s11[0], s11[1]); pw1.w = cvtpk(s11[2], s11[3]);
            f32x4 o0 = (f32x4){0.f, 0.f, 0.f, 0.f}, o1 = o0;
#pragma unroll
            for (int jj = 0; jj < 4; ++jj) {
                u32x4 sw; sw.x = cvtpk(S[2 * jj][0], S[2 * jj][1]); sw.y = cvtpk(S[2 * jj][2], S[2 * jj][3]); sw.z = cvtpk(S[2 * jj + 1][0], S[2 * jj + 1][1]); sw.w = cvtpk(S[2 * jj + 1][2], S[2 * jj + 1][3]);
                const bf16x8 sb = __builtin_bit_cast(bf16x8, sw);
                const LAS unsigned char* qp0 = lds + R_QD + (c16) * RQ_STRIDE + (32 * jj + 4 * quad) * 2;
                const LAS unsigned char* qp1 = lds + R_QD + (16 + c16) * RQ_STRIDE + (32 * jj + 4 * quad) * 2;
                const u32x2 a0 = *(const LAS u32x2*)qp0, a1 = *(const LAS u32x2*)(qp0 + 32), a2 = *(const LAS u32x2*)qp1, a3 = *(const LAS u32x2*)(qp1 + 32);
                o0 = __builtin_amdgcn_mfma_f32_16x16x32_bf16(__builtin_bit_cast(bf16x8, (u32x4){a0.x, a0.y, a1.x, a1.y}), sb, o0, 0, 0, 0);
                o1 = __builtin_amdgcn_mfma_f32_16x16x32_bf16(__builtin_bit_cast(bf16x8, (u32x4){a2.x, a2.y, a3.x, a3.y}), sb, o1, 0, 0, 0);
            }
            {
                const LAS unsigned char* vp = lds + R_VT + (16 * wid + c16) * 64 + (4 * quad) * 2;
                const u32x2 v0 = *(const LAS u32x2*)vp, v1 = *(const LAS u32x2*)(vp + 32);
                const bf16x8 vb = __builtin_bit_cast(bf16x8, (u32x4){v0.x, v0.y, v1.x, v1.y});
                o0 = __builtin_amdgcn_mfma_f32_16x16x32_bf16(__builtin_bit_cast(bf16x8, pw0), vb, o0, 0, 0, 0);
                o1 = __builtin_amdgcn_mfma_f32_16x16x32_bf16(__builtin_bit_cast(bf16x8, pw1), vb, o1, 0, 0, 0);
            }
            {
                f32x4 q0 = o0 * o0, q1 = o1 * o1;
#pragma unroll
                for (int o = 1; o < 16; o <<= 1) {
#pragma unroll
                    for (int r = 0; r < 4; ++r) { q0[r] += __shfl_xor(q0[r], o); q1[r] += __shfl_xor(q1[r], o); }
                }
                if (c16 == 0) { *(LAS f32x4*)(lds + R_OSQ + (wid * 32 + 4 * quad) * 4) = q0; *(LAS f32x4*)(lds + R_OSQ + (wid * 32 + 16 + 4 * quad) * 4) = q1; }
            }
            {
                const bf16x8 vb = *(const LAS bf16x8*)(lds + R_VT + (16 * wid + c16) * 64 + quad * 16);
#pragma unroll
                for (int kt = 0; kt < 8; ++kt) {
                    const f32x4 dv = *(const LAS f32x4*)(lds + R_DEC + (16 * kt + 4 * quad) * 4);
                    const bf16x8 ka = *(const LAS bf16x8*)(lds + R_KDT + (16 * kt + c16) * 64 + quad * 16);
                    S[kt] = __builtin_amdgcn_mfma_f32_16x16x32_bf16(ka, vb, S[kt] * dv, 0, 0, 0);
                }
            }
            __syncthreads();
            f32x4 t0 = (f32x4){0.f, 0.f, 0.f, 0.f}, t1 = t0;
#pragma unroll
            for (int w = 0; w < 8; ++w) { t0 += *(const LAS f32x4*)(lds + R_OSQ + (w * 32 + 4 * quad) * 4); t1 += *(const LAS f32x4*)(lds + R_OSQ + (w * 32 + 16 + 4 * quad) * 4); }
#pragma unroll
            for (int r = 0; r < 4; ++r) {
                const float r0 = rsqrtf(t0[r] * (1.0f / 128.0f) + NORM_EPS), r1 = rsqrtf(t1[r] * (1.0f / 128.0f) + NORM_EPS);
                const float z0 = __uint_as_float((unsigned)zv[r] << 16), z1 = __uint_as_float((unsigned)zv[4 + r] << 16);
                G1[(crow + 4 * quad + r) * DM + h * 128 + 16 * wid + c16] = (bf16_t)(cvtpk(o0[r] * r0 * gwv * z0, 0.f) & 0xffffu);
                G1[(crow + 16 + 4 * quad + r) * DM + h * 128 + 16 * wid + c16] = (bf16_t)(cvtpk(o1[r] * r1 * gwv * z1, 0.f) & 0xffffu);
            }
        }
    }
}

constexpr int LDS_BYTES = 147456;
static_assert(pg8::STAGE_BYTES <= LDS_BYTES && AK_BYTES + AV_BYTES <= LDS_BYTES && R_END <= LDS_BYTES, "LDS map");
constexpr int N_PHASES = 9;

__global__ void __launch_bounds__(512, 2) hybrid_fwd(Args a) {
    extern __shared__ __attribute__((aligned(16))) unsigned char lds_raw[];
    LAS unsigned char* lds = (LAS unsigned char*)lds_raw;
    cg::grid_group grid = cg::this_grid();
    const int G = gridDim.x;
    const int lo = a.ph_lo, hi = a.ph_hi;
    unsigned char* ws = a.ws;
#define IN(k) (lo <= (k) && (k) < hi)
#define SEAM(k) do { if (IN(k) && IN((k) + 1)) grid.sync(); } while (0)
    if (IN(0)) { p_prologue(a, lds, G); __syncthreads(); }
    SEAM(0);
    if (IN(1)) {
        pg8::Gemm g{(const bf16_t*)(ws + WS_H), (const bf16_t*)(ws + WS_WIN0), MTOK, ATTN_IN, DM}; pg8::StaticOrder S; S.init(MTOK, ATTN_IN, G, (int)blockIdx.x);
        pg8::EpiAttnIn E{(bf16_t*)(ws + WS_QKVZ), (bf16_t*)(ws + WS_VT), a.a_bin, (const float*)(ws + WS_ROPE)};
        pg8::gemm_phase<pg8::EpiAttnIn, true, true>(lds, g, S, E);
    }
    SEAM(1);
    if (IN(2)) p_attention(lds, (const bf16_t*)(ws + WS_QKVZ), (const bf16_t*)(ws + WS_VT), a.a_sinks, (bf16_t*)(ws + WS_G0), G);
    SEAM(2);
    if (IN(3)) {
        pg8::Gemm g{(const bf16_t*)(ws + WS_G0), (const bf16_t*)(ws + WS_WOUT0), MTOK, DM, DM}; pg8::StaticOrder S; S.init(MTOK, DM, G, (int)blockIdx.x);
        pg8::EpiOut E{(bf16_t*)(ws + WS_Y), a.a_bout, (float*)(ws + WS_PART)};
        pg8::gemm_phase<pg8::EpiOut, true, true>(lds, g, S, E);
    }
    SEAM(3);
    if (IN(4)) p_residual<true>((const bf16_t*)(ws + WS_Y), (const float*)(ws + WS_PART), a.x, a.post_w, a.pre_w + DM, a.out, (bf16_t*)(ws + WS_H), G);
    SEAM(4);
    if (IN(5)) {
        pg8::Gemm g{(const bf16_t*)(ws + WS_H), (const bf16_t*)(ws + WS_WIN1), MTOK, REC_IN, DM}; pg8::StaticOrder S; S.init(MTOK, REC_IN, G, (int)blockIdx.x);
        pg8::EpiRecIn E{(bf16_t*)(ws + WS_BIG), (const float*)(ws + WS_LB)};
        pg8::gemm_phase<pg8::EpiRecIn, true, true>(lds, g, S, E);
    }
    SEAM(5);
    if (IN(6)) p_recurrence(lds, (const bf16_t*)(ws + WS_BIG), a.r_gw, (bf16_t*)(ws + WS_G1), G);
    SEAM(6);
    if (IN(7)) {
        pg8::Gemm g{(const bf16_t*)(ws + WS_G1), (const bf16_t*)(ws + WS_WOUT1), MTOK, DM, DM}; pg8::StaticOrder S; S.init(MTOK, DM, G, (int)blockIdx.x);
        pg8::EpiOut E{(bf16_t*)(ws + WS_Y), nullptr, (float*)(ws + WS_PART)};
        pg8::gemm_phase<pg8::EpiOut, true, true>(lds, g, S, E);
    }
    SEAM(7);
    if (IN(8)) p_residual<false>((const bf16_t*)(ws + WS_Y), (const float*)(ws + WS_PART), a.out, a.post_w + DM, nullptr, a.out, nullptr, G);
#undef IN
#undef SEAM
}

extern "C" void kernel_launch(void* const* d_in, const int* in_sizes, int n_in, void* d_out, int out_size, void* d_ws, size_t ws_size, hipStream_t stream) {
    static int grid = 0;
    if (grid == 0) {
        if (n_in != 13 || in_sizes[0] != MTOK * DM || out_size != MTOK * DM || ws_size < WS_END) { fprintf(stderr, "kernel_launch: unexpected shapes (n_in %d, ws %zu < %zu)\n", n_in, ws_size, (size_t)WS_END); grid = -1; return; }
        int dev = 0, cus = 0, per_cu = 0;
        hipGetDevice(&dev); hipDeviceGetAttribute(&cus, hipDeviceAttributeMultiprocessorCount, dev);
        if (hipFuncSetAttribute((const void*)hybrid_fwd, hipFuncAttributeMaxDynamicSharedMemorySize, LDS_BYTES) != hipSuccess) { fprintf(stderr, "kernel_launch: hipFuncSetAttribute failed\n"); grid = -1; return; }
        if (hipOccupancyMaxActiveBlocksPerMultiprocessor(&per_cu, (const void*)hybrid_fwd, 512, LDS_BYTES) != hipSuccess || per_cu < 1) { fprintf(stderr, "kernel_launch: occupancy query says %d\n", per_cu); per_cu = 1; }
        (void)hipGetLastError();
        grid = cus * 1;
    }
    if (grid < 0) return;
    Args a{};
    a.x = (const float*)d_in[0]; a.pos = (const int*)d_in[1]; a.pre_w = (const float*)d_in[2]; a.post_w = (const float*)d_in[3];
    a.a_win = (const float*)d_in[4]; a.a_bin = (const float*)d_in[5]; a.a_sinks = (const float*)d_in[6]; a.a_wout = (const float*)d_in[7]; a.a_bout = (const float*)d_in[8];
    a.r_win = (const float*)d_in[9]; a.r_lbl = (const float*)d_in[10]; a.r_gw = (const float*)d_in[11]; a.r_wout = (const float*)d_in[12];
    a.out = (float*)d_out; a.ws = (unsigned char*)d_ws; a.ph_lo = 0; a.ph_hi = N_PHASES;
    void* args[] = {&a};
    hipError_t e = hipLaunchCooperativeKernel((const void*)hybrid_fwd, dim3(grid), dim3(512), args, LDS_BYTES, stream);
    if (e != hipSuccess) fprintf(stderr, "kernel_launch: cooperative launch failed: %s (grid %d)\n", hipGetErrorString(e), grid);
}
```

```cpp
#include <hip/hip_runtime.h>
#include <hip/hip_cooperative_groups.h>
#include <cstdio>
#include <cstdint>
namespace cg = cooperative_groups;

#define LAS __attribute__((address_space(3)))
typedef unsigned short bf16_t;
typedef short bf16x8 __attribute__((ext_vector_type(8)));
typedef float f32x4 __attribute__((ext_vector_type(4)));
typedef float f32x16 __attribute__((ext_vector_type(16)));
typedef unsigned u32x4 __attribute__((ext_vector_type(4)));
typedef unsigned u32x2 __attribute__((ext_vector_type(2)));
typedef float f32x2_t __attribute__((ext_vector_type(2)));
typedef __bf16 bf16x2_t __attribute__((ext_vector_type(2)));
typedef _Float16 f16x2_t __attribute__((ext_vector_type(2)));

constexpr int NB = 32, SEQ = 2048, DM = 1024, MTOK = NB * SEQ;
constexpr int ATTN_IN = 2304, REC_IN = 4096;
constexpr float NORM_EPS = 1e-6f;
constexpr float LOG2E = 1.4426950408889634f;
constexpr float QSCALE = 0.125f * 1.4426950408889634f;

constexpr size_t WS_WIN0 = 0;
constexpr size_t WS_WOUT0 = WS_WIN0 + (size_t)ATTN_IN * DM * 2;
constexpr size_t WS_WIN1 = WS_WOUT0 + (size_t)DM * DM * 2;
constexpr size_t WS_WOUT1 = WS_WIN1 + (size_t)REC_IN * DM * 2;
constexpr size_t WS_ROPE = WS_WOUT1 + (size_t)DM * DM * 2;
constexpr size_t WS_LB = WS_ROPE + (size_t)MTOK * 16 * 4;
constexpr size_t WS_PART = WS_LB + 4096;
constexpr size_t WS_H = WS_PART + (size_t)MTOK * 16 * 4;
constexpr size_t WS_Y = WS_H + (size_t)MTOK * DM * 2;
constexpr size_t WS_G1 = WS_Y + (size_t)MTOK * DM * 2;
constexpr size_t WS_BIG = WS_G1 + (size_t)MTOK * DM * 2;
constexpr size_t WS_QKVZ = WS_BIG;
constexpr size_t WS_G0 = WS_QKVZ + (size_t)MTOK * ATTN_IN * 2;
constexpr size_t WS_VT = WS_G0 + (size_t)MTOK * DM * 2;
constexpr size_t WS_END = WS_BIG + (size_t)MTOK * REC_IN * 2;
static_assert(WS_VT + (size_t)MTOK * 128 * 2 <= WS_END, "overlay");

__device__ __forceinline__ unsigned cvtpk(float lo, float hi) { f32x2_t v = {lo, hi}; bf16x2_t b = __builtin_convertvector(v, bf16x2_t); return __builtin_bit_cast(unsigned, b); }
__device__ __forceinline__ unsigned cvtpk_h(float lo, float hi) { f32x2_t v = {lo, hi}; f16x2_t b = __builtin_convertvector(v, f16x2_t); return __builtin_bit_cast(unsigned, b); }
__device__ __forceinline__ float bf_lo(unsigned u) { return __uint_as_float(u << 16); }
__device__ __forceinline__ float bf_hi(unsigned u) { return __uint_as_float(u & 0xffff0000u); }
__device__ __forceinline__ float h_lo(unsigned u) { f16x2_t h = __builtin_bit_cast(f16x2_t, u); return (float)h[0]; }
__device__ __forceinline__ float h_hi(unsigned u) { f16x2_t h = __builtin_bit_cast(f16x2_t, u); return (float)h[1]; }
__device__ __forceinline__ float silu_f(float v) { return v * __builtin_amdgcn_rcpf(1.0f + __expf(-v)); }
__device__ __forceinline__ float wave_sum(float v) {
#pragma unroll
    for (int o = 1; o < 64; o <<= 1) v += __shfl_xor(v, o);
    return v;
}

namespace pg8 {
constexpr int BM = 256, BK = 64, HALF = 128, HTB = HALF * BK * 2, STAGE_BYTES = 8 * HTB, NXCD = 8, WGM = 8;
__host__ __device__ __forceinline__ int lds_byte(int r, int c) { const int st = (r >> 4) * 2 + (c >> 5), rr = r & 15, cc = c & 31, ob = rr * 64 + cc * 2; return st * 1024 + (ob ^ (((ob >> 9) & 1) << 5)); }
__host__ __device__ __forceinline__ void stage_rc(int b, int& R, int& C) { const int st = b / 1024, sb = b % 1024, swz = sb ^ (((sb >> 9) & 1) << 5); R = (st >> 1) * 16 + swz / 64; C = (st & 1) * 32 + (swz % 64) / 2; }
__host__ __device__ __forceinline__ int perm32(int rho) { const int n = rho >> 4, i = rho & 15; return 8 * (i >> 2) + 4 * n + (i & 3); }

struct Unit { int pm, pn; };
struct Gemm { const bf16_t* A; const bf16_t* Bt; int M, N, K; };

struct StaticOrder {
    int nM, nN, nwg, G, c;
    __host__ __device__ void init(int M, int N, int G_, int c_) { nM = M / BM; nN = N / BM; nwg = nM * nN; G = G_; c = c_; }
    __host__ __device__ bool next(int i, Unit& u) const {
        const long L = (long)i * G + c; if (L >= nwg) return false;
        int wgid = (int)L; { const int q = nwg / NXCD, r = nwg % NXCD, xcd = wgid % NXCD, off = wgid / NXCD; wgid = (xcd < r ? xcd * (q + 1) : r * (q + 1) + (xcd - r) * q) + off; }
        const int nig = WGM * nN, gid = wgid / nig, fm = gid * WGM, gsz = (nM - fm) < WGM ? (nM - fm) : WGM;
        u.pm = fm + ((wgid % nig) % gsz); u.pn = (wgid % nig) / gsz; return true;
    }
};

template <class Epi, bool ALIGN_EPI, bool SP2>
__device__ __forceinline__ void gemm_phase(LAS unsigned char* lds, const Gemm g, const StaticOrder& S, const Epi& E) {
    const int tid = threadIdx.x, wid = __builtin_amdgcn_readfirstlane(tid >> 6), lane = tid & 63, wr = wid >> 2, wc = wid & 3, fr = lane & 15, fq = lane >> 4;
    const int K = g.K, nt = K / BK;
    unsigned voffA[2], voffB[2];
#pragma unroll
    for (int i = 0; i < 2; ++i) { int R, C; stage_rc(tid * 16 + i * 8192, R, C); const int Rb = Epi::PERM ? ((R & ~31) + perm32(R & 31)) : R;
        voffA[i] = (unsigned)(R * K + C) * 2u; voffB[i] = (unsigned)(Rb * K + C) * 2u; }
    const size_t kstep = (size_t)(BK * 2);
    const size_t hstep = (size_t)HALF * K * 2;
    const size_t tstep = 2 * hstep;
    const unsigned ldsw = (unsigned)wid * 1024u;
    const int aoff = lds_byte(wr * 64 + fr, fq * 8), boff = lds_byte(wc * 32 + fr, fq * 8);
#define PG8_SA(b, h) (((b) * 2 + (h)) * HTB)
#define PG8_SB(b, h) ((4 + (b) * 2 + (h)) * HTB)
#define PG8_STAGE(bufoff, gbase, voff) do { _Pragma("unroll") for (int _i = 0; _i < 2; ++_i) \
        __builtin_amdgcn_global_load_lds((const unsigned*)((const char*)(gbase) + (voff)[_i]), (LAS unsigned*)(lds + (bufoff) + ldsw + _i * 8192), 16, 0, 0); } while (0)
#define PG8_LDA(dst, b, h) do { _Pragma("unroll") for (int m = 0; m < 4; ++m) _Pragma("unroll") for (int k = 0; k < 2; ++k) dst[m][k] = *(const LAS bf16x8*)(lds + PG8_SA(b, h) + aoff + m * 2048 + k * 1024); } while (0)
#define PG8_LDB(dst, b, h) do { _Pragma("unroll") for (int n = 0; n < 2; ++n) _Pragma("unroll") for (int k = 0; k < 2; ++k) dst[n][k] = *(const LAS bf16x8*)(lds + PG8_SB(b, h) + boff + n * 2048 + k * 1024); } while (0)
#define PG8_MMA(ai, bj, Af, Bf) do { __builtin_amdgcn_s_setprio(1); _Pragma("unroll") for (int m = 0; m < 4; ++m) _Pragma("unroll") for (int n = 0; n < 2; ++n) _Pragma("unroll") for (int k = 0; k < 2; ++k) \
        acc[ai][bj][m][n] = __builtin_amdgcn_mfma_f32_16x16x32_bf16(Bf[n][k], Af[m][k], acc[ai][bj][m][n], 0, 0, 0); __builtin_amdgcn_s_setprio(0); } while (0)
#define PG8_WAIT_V(n) asm volatile("s_waitcnt vmcnt(" #n ")" ::: "memory")
#define PG8_WAIT_L(n) asm volatile("s_waitcnt lgkmcnt(" #n ")" ::: "memory")
#define PG8_BAR __builtin_amdgcn_s_barrier()
#define PG8_SCHED __builtin_amdgcn_sched_barrier(0)
    Unit cur, nxt; int ui = 0;
    if (!S.next(0, cur)) return;
    f32x4 acc[2][2][4][2];
#pragma unroll
    for (int a = 0; a < 2; ++a)
#pragma unroll
        for (int b = 0; b < 2; ++b)
#pragma unroll
            for (int m = 0; m < 4; ++m)
#pragma unroll
                for (int n = 0; n < 2; ++n) acc[a][b][m][n] = (f32x4){0.f, 0.f, 0.f, 0.f};
    bf16x8 At[4][2], B0[2][2], B1[2][2];
    const char* cA = (const char*)g.A + (size_t)cur.pm * tstep; const char* cB = (const char*)g.Bt + (size_t)cur.pn * tstep;
    if constexpr (SP2) {
        PG8_STAGE(PG8_SB(0, 0), cB, voffB); PG8_STAGE(PG8_SB(0, 1), cB + hstep, voffB); PG8_STAGE(PG8_SA(0, 0), cA, voffA); PG8_STAGE(PG8_SA(0, 1), cA + hstep, voffA);
        if (wr == 1) PG8_BAR;
        PG8_WAIT_V(2); PG8_BAR;
        PG8_STAGE(PG8_SB(1, 0), cB + kstep, voffB); PG8_STAGE(PG8_SA(1, 0), cA + kstep, voffA); PG8_STAGE(PG8_SB(1, 1), cB + hstep + kstep, voffB);
        PG8_WAIT_V(6); PG8_BAR;
    } else {
        PG8_STAGE(PG8_SB(0, 0), cB, voffB); PG8_STAGE(PG8_SA(0, 0), cA, voffA); PG8_STAGE(PG8_SB(0, 1), cB + hstep, voffB); PG8_STAGE(PG8_SA(0, 1), cA + hstep, voffA);
        if (wr == 1) PG8_BAR;
        PG8_WAIT_V(4); PG8_BAR;
        PG8_STAGE(PG8_SB(1, 0), cB + kstep, voffB); PG8_STAGE(PG8_SA(1, 0), cA + kstep, voffA); PG8_STAGE(PG8_SB(1, 1), cB + hstep + kstep, voffB);
        PG8_WAIT_V(6); PG8_BAR;
    }
    for (;;) {
        const bool has_next = S.next(ui + 1, nxt);
        const char* nA = has_next ? (const char*)g.A + (size_t)nxt.pm * tstep : cA; const char* nB = has_next ? (const char*)g.Bt + (size_t)nxt.pn * tstep : cB;
        for (int t = 0; t < nt; t += 2) {
            const bool last = (t == nt - 2);
            const char* a1 = cA + (size_t)(t + 1) * kstep;
            const char* a2 = last ? nA : cA + (size_t)(t + 2) * kstep; const char* b2 = last ? nB : cB + (size_t)(t + 2) * kstep;
            const char* a3 = a2 + kstep; const char* b3 = b2 + kstep;
            if constexpr (SP2) {
            PG8_LDB(B0, 0, 0); PG8_LDB(B1, 0, 1); PG8_SCHED; PG8_LDA(At, 0, 0); PG8_STAGE(PG8_SA(1, 1), a1 + hstep, voffA);
            PG8_WAIT_V(8); PG8_WAIT_L(0); PG8_BAR; PG8_MMA(0, 0, At, B0); PG8_MMA(0, 1, At, B1); PG8_BAR; PG8_SCHED;
            PG8_LDA(At, 0, 1); PG8_STAGE(PG8_SB(0, 0), b2, voffB); PG8_STAGE(PG8_SB(0, 1), b2 + hstep, voffB); PG8_STAGE(PG8_SA(0, 0), a2, voffA);
            PG8_WAIT_V(8); PG8_WAIT_L(0); PG8_BAR; PG8_MMA(1, 0, At, B0); PG8_MMA(1, 1, At, B1); PG8_BAR; PG8_SCHED;
            PG8_LDB(B0, 1, 0); PG8_LDB(B1, 1, 1); PG8_SCHED; PG8_LDA(At, 1, 0); PG8_STAGE(PG8_SA(0, 1), a2 + hstep, voffA);
            PG8_WAIT_V(8); PG8_WAIT_L(0); PG8_BAR; PG8_MMA(0, 0, At, B0); PG8_MMA(0, 1, At, B1); PG8_BAR; PG8_SCHED;
            PG8_LDA(At, 1, 1); PG8_STAGE(PG8_SB(1, 0), b3, voffB); PG8_STAGE(PG8_SB(1, 1), b3 + hstep, voffB); PG8_STAGE(PG8_SA(1, 0), a3, voffA);
            PG8_WAIT_V(8); PG8_WAIT_L(0); PG8_BAR; PG8_MMA(1, 0, At, B0); PG8_MMA(1, 1, At, B1); PG8_BAR; PG8_SCHED;
            } else {
            PG8_LDB(B0, 0, 0); PG8_SCHED; PG8_LDA(At, 0, 0); PG8_STAGE(PG8_SA(1, 1), a1 + hstep, voffA);
            PG8_WAIT_L(8); PG8_BAR; PG8_WAIT_L(0); PG8_MMA(0, 0, At, B0); PG8_BAR; PG8_SCHED;
            PG8_LDB(B1, 0, 1); PG8_STAGE(PG8_SB(0, 0), b2, voffB);
            PG8_BAR; PG8_WAIT_L(0); PG8_MMA(0, 1, At, B1); PG8_BAR;
            PG8_LDA(At, 0, 1); PG8_STAGE(PG8_SA(0, 0), a2, voffA);
            PG8_BAR; PG8_WAIT_L(0); PG8_MMA(1, 0, At, B0); PG8_BAR; PG8_SCHED;
            PG8_STAGE(PG8_SB(0, 1), b2 + hstep, voffB);
            PG8_WAIT_V(6); PG8_BAR; PG8_MMA(1, 1, At, B1); PG8_BAR;
            PG8_LDB(B0, 1, 0); PG8_SCHED; PG8_LDA(At, 1, 0); PG8_STAGE(PG8_SA(0, 1), a2 + hstep, voffA);
            PG8_WAIT_L(8); PG8_BAR; PG8_WAIT_L(0); PG8_MMA(0, 0, At, B0); PG8_BAR; PG8_SCHED;
            PG8_LDB(B1, 1, 1); PG8_STAGE(PG8_SB(1, 0), b3, voffB);
            PG8_BAR; PG8_WAIT_L(0); PG8_MMA(0, 1, At, B1); PG8_BAR;
            PG8_LDA(At, 1, 1); PG8_STAGE(PG8_SA(1, 0), a3, voffA);
            PG8_BAR; PG8_WAIT_L(0); PG8_MMA(1, 0, At, B0); PG8_BAR; PG8_SCHED;
            PG8_STAGE(PG8_SB(1, 1), b3 + hstep, voffB);
            PG8_WAIT_V(6); PG8_BAR; PG8_MMA(1, 1, At, B1); PG8_BAR;
            }
        }
        if constexpr (ALIGN_EPI) { if (wr == 0) PG8_BAR; }
        E(acc, cur, wr, wc, fr, fq);
        if (!has_next) break;
#pragma unroll
        for (int a = 0; a < 2; ++a)
#pragma unroll
            for (int b = 0; b < 2; ++b)
#pragma unroll
                for (int m = 0; m < 4; ++m)
#pragma unroll
                    for (int n = 0; n < 2; ++n) acc[a][b][m][n] = (f32x4){0.f, 0.f, 0.f, 0.f};
        cur = nxt; cA = nA; cB = nB; ++ui;
        if constexpr (ALIGN_EPI) { if (wr == 1) PG8_BAR; }
    }
    PG8_WAIT_V(0);
    if constexpr (!ALIGN_EPI) { if (wr == 0) PG8_BAR; }
    PG8_BAR;
#undef PG8_SA
#undef PG8_SB
#undef PG8_STAGE
#undef PG8_LDA
#undef PG8_LDB
#undef PG8_MMA
#undef PG8_WAIT_V
#undef PG8_WAIT_L
#undef PG8_BAR
#undef PG8_SCHED
}

struct EpiAttnIn {
    static constexpr bool PERM = true;
    bf16_t* O; bf16_t* VT; const float* bias; const float* rope;
    __device__ __forceinline__ void operator()(const f32x4 (&acc)[2][2][4][2], const Unit& u, int wr, int wc, int fr, int fq) const {
        const int row0 = u.pm * BM + wr * 64 + fr;
#pragma unroll
        for (int bj = 0; bj < 2; ++bj) {
            const int cbase = u.pn * BM + bj * HALF;
            const int c0 = cbase + wc * 32 + 8 * fq;
            const f32x4 bv0 = *(const f32x4*)(bias + c0), bv1 = *(const f32x4*)(bias + c0 + 4);
            const int kind = cbase < 1024 ? 0 : (cbase < 1152 ? 1 : (cbase < 1280 ? 2 : 3));
            const bool ropew = (kind <= 1) && ((wc & 1) == 0);
#pragma unroll
            for (int ai = 0; ai < 2; ++ai)
#pragma unroll
                for (int m = 0; m < 4; ++m) {
                    const int row = row0 + ai * HALF + m * 16;
                    f32x4 v0 = acc[ai][bj][m][0] + bv0, v1 = acc[ai][bj][m][1] + bv1;
                    if (ropew) {
                        f32x4 p0, p1;
#pragma unroll
                        for (int i = 0; i < 4; ++i) { p0[i] = __shfl_xor(v0[i], 16); p1[i] = __shfl_xor(v1[i], 16); }
                        if (fq < 2) {
                            const float* rp = rope + (size_t)row * 16;
                            const f32x4 c0v = *(const f32x4*)(rp), c1v = *(const f32x4*)(rp + 4), s0v = *(const f32x4*)(rp + 8), s1v = *(const f32x4*)(rp + 12);
                            const float sg = (fq == 0) ? -1.f : 1.f;
                            v0 = v0 * c0v + sg * (p0 * s0v); v1 = v1 * c1v + sg * (p1 * s1v);
                        }
                    }
                    if (kind == 0) { v0 = v0 * QSCALE; v1 = v1 * QSCALE; }
                    if (kind == 3) {
#pragma unroll
                        for (int i = 0; i < 4; ++i) { v0[i] = silu_f(v0[i]); v1[i] = silu_f(v1[i]); }
                    }
                    if (kind == 2) {
                        const int b = row >> 11, t = row & 2047, dd = (c0 - 1152);
                        bf16_t* vp = VT + ((size_t)(b * 128 + dd)) * SEQ + t;
#pragma unroll
                        for (int i = 0; i < 4; ++i) { vp[(size_t)i * SEQ] = (bf16_t)(cvtpk(v0[i], 0.f) & 0xffffu); vp[(size_t)(i + 4) * SEQ] = (bf16_t)(cvtpk(v1[i], 0.f) & 0xffffu); }
                    } else {
                        u32x4 w; w.x = cvtpk(v0[0], v0[1]); w.y = cvtpk(v0[2], v0[3]); w.z = cvtpk(v1[0], v1[1]); w.w = cvtpk(v1[2], v1[3]);
                        *(u32x4*)(O + (size_t)row * ATTN_IN + c0) = w;
                    }
                }
        }
    }
};
struct EpiRecIn {
    static constexpr bool PERM = true;
    bf16_t* O; const float* lb;
    __device__ __forceinline__ void operator()(const f32x4 (&acc)[2][2][4][2], const Unit& u, int wr, int wc, int fr, int fq) const {
        const int row0 = u.pm * BM + wr * 64 + fr;
        const int seg = u.pn >> 2;
#pragma unroll
        for (int bj = 0; bj < 2; ++bj) {
            const int c0 = u.pn * BM + bj * HALF + wc * 32 + 8 * fq;
            f32x4 l0 = (f32x4){0.f, 0.f, 0.f, 0.f}, l1 = l0;
            if (seg == 1) { l0 = *(const f32x4*)(lb + (c0 - 1024)); l1 = *(const f32x4*)(lb + (c0 - 1024) + 4); }
#pragma unroll
            for (int ai = 0; ai < 2; ++ai)
#pragma unroll
                for (int m = 0; m < 4; ++m) {
                    const int row = row0 + ai * HALF + m * 16;
                    f32x4 v0 = acc[ai][bj][m][0], v1 = acc[ai][bj][m][1];
                    u32x4 w;
                    if (seg == 1) {
#pragma unroll
                        for (int i = 0; i < 4; ++i) {
                            const float s0 = __builtin_amdgcn_rcpf(1.0f + __expf(-v0[i])), s1 = __builtin_amdgcn_rcpf(1.0f + __expf(-v1[i]));
                            v0[i] = __log2f(l0[i] + (1.0f - l0[i]) * s0); v1[i] = __log2f(l1[i] + (1.0f - l1[i]) * s1);
                        }
                        w.x = cvtpk_h(v0[0], v0[1]); w.y = cvtpk_h(v0[2], v0[3]); w.z = cvtpk_h(v1[0], v1[1]); w.w = cvtpk_h(v1[2], v1[3]);
                    } else {
                        if (seg != 2) {
#pragma unroll
                            for (int i = 0; i < 4; ++i) { v0[i] = silu_f(v0[i]); v1[i] = silu_f(v1[i]); }
                        }
                        w.x = cvtpk(v0[0], v0[1]); w.y = cvtpk(v0[2], v0[3]); w.z = cvtpk(v1[0], v1[1]); w.w = cvtpk(v1[2], v1[3]);
                    }
                    *(u32x4*)(O + ((size_t)((row >> 11) * 8 + (u.pn & 3) * 2 + bj) * SEQ + (row & 2047)) * 512 + seg * 128 + wc * 32 + 8 * fq) = w;
                }
        }
    }
};
struct EpiOut {
    static constexpr bool PERM = true;
    bf16_t* O; const float* bias; float* part;
    __device__ __forceinline__ void operator()(const f32x4 (&acc)[2][2][4][2], const Unit& u, int wr, int wc, int fr, int fq) const {
        const int row0 = u.pm * BM + wr * 64 + fr;
        f32x4 bv[2][2];
#pragma unroll
        for (int bj = 0; bj < 2; ++bj) { const int c0 = u.pn * BM + bj * HALF + wc * 32 + 8 * fq;
            bv[bj][0] = bias ? *(const f32x4*)(bias + c0) : (f32x4){0.f, 0.f, 0.f, 0.f}; bv[bj][1] = bias ? *(const f32x4*)(bias + c0 + 4) : (f32x4){0.f, 0.f, 0.f, 0.f}; }
#pragma unroll
        for (int ai = 0; ai < 2; ++ai)
#pragma unroll
            for (int m = 0; m < 4; ++m) {
                const int row = row0 + ai * HALF + m * 16;
                float ss = 0.f;
#pragma unroll
                for (int bj = 0; bj < 2; ++bj) {
                    const int c0 = u.pn * BM + bj * HALF + wc * 32 + 8 * fq;
                    const f32x4 v0 = acc[ai][bj][m][0] + bv[bj][0], v1 = acc[ai][bj][m][1] + bv[bj][1];
                    ss += (v0[0] * v0[0] + v0[1] * v0[1]) + (v0[2] * v0[2] + v0[3] * v0[3]) + (v1[0] * v1[0] + v1[1] * v1[1]) + (v1[2] * v1[2] + v1[3] * v1[3]);
                    u32x4 w; w.x = cvtpk(v0[0], v0[1]); w.y = cvtpk(v0[2], v0[3]); w.z = cvtpk(v1[0], v1[1]); w.w = cvtpk(v1[2], v1[3]);
                    *(u32x4*)(O + (size_t)row * DM + c0) = w;
                }
                ss += __shfl_xor(ss, 16); ss += __shfl_xor(ss, 32);
                if (fq == 0) part[(size_t)row * 16 + u.pn * 4 + wc] = ss;
            }
    }
};
}

__device__ __forceinline__ void transpose_item(const float* W, int K, int N, bf16_t* WT, LAS float* scr, int item, int lane) {
    const int nblk = N / 32, kb = item / nblk, nb = item % nblk, k0 = 64 * kb, n0 = 32 * nb;
#pragma unroll 8
    for (int i = 0; i < 32; ++i) { const int kk = 2 * i + (lane >> 5); scr[kk * 33 + (lane & 31)] = W[(size_t)(k0 + kk) * N + n0 + (lane & 31)]; }
    asm volatile("s_waitcnt lgkmcnt(0)" ::: "memory");
    const int c = lane & 7;
#pragma unroll
    for (int j = 0; j < 4; ++j) { const int n = (lane >> 3) + 8 * j; const LAS float* s = scr + (8 * c) * 33 + n;
        u32x4 o; o.x = cvtpk(s[0 * 33], s[1 * 33]); o.y = cvtpk(s[2 * 33], s[3 * 33]); o.z = cvtpk(s[4 * 33], s[5 * 33]); o.w = cvtpk(s[6 * 33], s[7 * 33]);
        *(u32x4*)(WT + (size_t)(n0 + n) * K + k0 + 8 * c) = o; }
    asm volatile("s_waitcnt lgkmcnt(0)" ::: "memory");
}

struct Args {
    const float* x; const int* pos; const float* pre_w; const float* post_w; const float* a_win; const float* a_bin; const float* a_sinks;
    const float* a_wout; const float* a_bout; const float* r_win; const float* r_lbl; const float* r_gw; const float* r_wout;
    float* out; unsigned char* ws; int ph_lo, ph_hi;
};

__device__ __forceinline__ void load_w16(const float* w, int lane, f32x4 (&r)[2][2]) {
#pragma unroll
    for (int j = 0; j < 2; ++j)
#pragma unroll
        for (int h = 0; h < 2; ++h) r[j][h] = *(const f32x4*)(w + 512 * j + 8 * lane + 4 * h);
}

__device__ __forceinline__ void p_prologue(const Args& a, LAS unsigned char* lds, int G) {
    const int tid = threadIdx.x, lane = tid & 63, wid = __builtin_amdgcn_readfirstlane(tid >> 6);
    LAS float* scr = (LAS float*)(lds + wid * 16384);
    const int gw = blockIdx.x * 8 + wid, NGW = G * 8;
    constexpr int I_A = (DM / 64) * (ATTN_IN / 32), I_O = (DM / 64) * (DM / 32), I_R = (DM / 64) * (REC_IN / 32);
    constexpr int NITEMS = I_A + I_O + I_R + I_O;
    for (int it = gw; it < NITEMS; it += NGW) {
        int r = it;
        if (r < I_A) { transpose_item(a.a_win, DM, ATTN_IN, (bf16_t*)(a.ws + WS_WIN0), scr, r, lane); continue; } r -= I_A;
        if (r < I_O) { transpose_item(a.a_wout, DM, DM, (bf16_t*)(a.ws + WS_WOUT0), scr, r, lane); continue; } r -= I_O;
        if (r < I_R) { transpose_item(a.r_win, DM, REC_IN, (bf16_t*)(a.ws + WS_WIN1), scr, r, lane); continue; } r -= I_R;
        transpose_item(a.r_wout, DM, DM, (bf16_t*)(a.ws + WS_WOUT1), scr, r, lane);
    }
    {
        float* rope = (float*)(a.ws + WS_ROPE);
        const int gt = blockIdx.x * 512 + tid, NGT = G * 512;
        for (int e = gt; e < MTOK * 8; e += NGT) {
            const int row = e >> 3, i = e & 7;
            const float invf = (i == 0) ? 1.0f : (i == 1) ? 0.19392274474868576f : (i == 2) ? 0.03760603093086393f : (i == 3) ? 0.007292664737217109f :
                               (i == 4) ? 0.001414213562373095f : (i == 5) ? 0.0002742481756762073f : (i == 6) ? 5.318295896944988e-05f : 1.031338537721246e-05f;
            const float ang = (float)a.pos[row] * invf;
            rope[(size_t)row * 16 + i] = cosf(ang); rope[(size_t)row * 16 + 8 + i] = sinf(ang);
        }
        float* lb = (float*)(a.ws + WS_LB);
        for (int e = gt; e < DM; e += NGT) { const float l0 = a.r_lbl[e], l1 = a.r_lbl[DM + e]; lb[e] = 1.0f / (1.0f + expf(l0 - l1)); }
    }
    {
        f32x4 wv[2][2]; load_w16(a.pre_w, lane, wv);
        bf16_t* H = (bf16_t*)(a.ws + WS_H);
        for (int row = gw; row < MTOK; row += NGW) {
            const float* xr = a.x + (size_t)row * DM;
            f32x4 xv[2][2]; float ss = 0.f;
#pragma unroll
            for (int j = 0; j < 2; ++j)
#pragma unroll
                for (int h = 0; h < 2; ++h) { xv[j][h] = *(const f32x4*)(xr + 512 * j + 8 * lane + 4 * h); const f32x4 t = xv[j][h]; ss += (t[0] * t[0] + t[1] * t[1]) + (t[2] * t[2] + t[3] * t[3]); }
            const float rstd = rsqrtf(wave_sum(ss) * (1.0f / DM) + NORM_EPS);
#pragma unroll
            for (int j = 0; j < 2; ++j) {
                const f32x4 h0 = xv[j][0] * rstd * wv[j][0], h1 = xv[j][1] * rstd * wv[j][1];
                u32x4 w; w.x = cvtpk(h0[0], h0[1]); w.y = cvtpk(h0[2], h0[3]); w.z = cvtpk(h1[0], h1[1]); w.w = cvtpk(h1[2], h1[3]);
                *(u32x4*)(H + (size_t)row * DM + 512 * j + 8 * lane) = w;
            }
        }
    }
}

template <bool WITH_H>
__device__ __forceinline__ void p_residual(const bf16_t* Y, const float* part, const float* xin, const float* post_w, const float* pre_w_next, float* xout, bf16_t* Hout, int G) {
    const int tid = threadIdx.x, lane = tid & 63, wid = __builtin_amdgcn_readfirstlane(tid >> 6);
    const int gw = blockIdx.x * 8 + wid, NGW = G * 8;
    f32x4 wp[2][2], wn[2][2]; load_w16(post_w, lane, wp);
    if (WITH_H) load_w16(pre_w_next, lane, wn);
    for (int row = gw; row < MTOK; row += NGW) {
        const float ps = (lane < 16) ? part[(size_t)row * 16 + lane] : 0.f;
        u32x4 yv[2]; f32x4 xv[2][2];
#pragma unroll
        for (int j = 0; j < 2; ++j) { yv[j] = *(const u32x4*)(Y + (size_t)row * DM + 512 * j + 8 * lane);
#pragma unroll
            for (int h = 0; h < 2; ++h) xv[j][h] = *(const f32x4*)(xin + (size_t)row * DM + 512 * j + 8 * lane + 4 * h); }
        const float rstd = rsqrtf(wave_sum(ps) * (1.0f / DM) + NORM_EPS);
        float ss = 0.f;
#pragma unroll
        for (int j = 0; j < 2; ++j) {
            const f32x4 y0 = (f32x4){bf_lo(yv[j].x), bf_hi(yv[j].x), bf_lo(yv[j].y), bf_hi(yv[j].y)}, y1 = (f32x4){bf_lo(yv[j].z), bf_hi(yv[j].z), bf_lo(yv[j].w), bf_hi(yv[j].w)};
            xv[j][0] = xv[j][0] + y0 * rstd * wp[j][0]; xv[j][1] = xv[j][1] + y1 * rstd * wp[j][1];
#pragma unroll
            for (int h = 0; h < 2; ++h) { const f32x4 t = xv[j][h]; ss += (t[0] * t[0] + t[1] * t[1]) + (t[2] * t[2] + t[3] * t[3]); *(f32x4*)(xout + (size_t)row * DM + 512 * j + 8 * lane + 4 * h) = t; }
        }
        if (WITH_H) {
            const float r2 = rsqrtf(wave_sum(ss) * (1.0f / DM) + NORM_EPS);
#pragma unroll
            for (int j = 0; j < 2; ++j) {
                const f32x4 h0 = xv[j][0] * r2 * wn[j][0], h1 = xv[j][1] * r2 * wn[j][1];
                u32x4 w; w.x = cvtpk(h0[0], h0[1]); w.y = cvtpk(h0[2], h0[3]); w.z = cvtpk(h1[0], h1[1]); w.w = cvtpk(h1[2], h1[3]);
                *(u32x4*)(Hout + (size_t)row * DM + 512 * j + 8 * lane) = w;
            }
        }
    }
}

constexpr int AK_STRIDE = 144, AV_STRIDE = 520, AK_BYTES = 256 * AK_STRIDE, AV_BYTES = 64 * AV_STRIDE;
__device__ __forceinline__ void p_attention(LAS unsigned char* lds, const bf16_t* QKVZ, const bf16_t* VT, const float* sinks, bf16_t* G0, int G) {
    const int tid = threadIdx.x, lane = tid & 63, wid = __builtin_amdgcn_readfirstlane(tid >> 6), r32 = lane & 31, hi = lane >> 5;
    LAS unsigned char* Ks = lds; LAS unsigned char* Vs = lds + AK_BYTES;
    const float NEG = -INFINITY;
    for (int u = blockIdx.x; u < NB * 16 * 2; u += G) {
        const int kvh = u & 1, n = (u >> 1) & 15, b = u >> 5;
        const size_t rowb = (size_t)b * SEQ;
        const int kstart = n * 128 - 128;
#pragma unroll
        for (int i = 0; i < 4; ++i) {
            const int idx = tid + 512 * i, kr = idx >> 3, ch = idx & 7, tok = kstart + kr;
            u32x4 v = (u32x4){0u, 0u, 0u, 0u};
            if (tok >= 0) v = *(const u32x4*)(QKVZ + (rowb + tok) * ATTN_IN + 1024 + kvh * 64 + ch * 8);
            *(LAS u32x4*)(Ks + kr * AK_STRIDE + ch * 16) = v;
        }
#pragma unroll
        for (int i = 0; i < 4; ++i) {
            const int idx = tid + 512 * i, d = idx >> 5, ch = idx & 31, tok = kstart + ch * 8;
            u32x4 v = (u32x4){0u, 0u, 0u, 0u};
            if (tok >= 0) v = *(const u32x4*)(VT + ((size_t)(b * 128 + kvh * 64 + d)) * SEQ + tok);
            *(LAS u32x2*)(Vs + d * AV_STRIDE + ch * 16) = (u32x2){v.x, v.y};
            *(LAS u32x2*)(Vs + d * AV_STRIDE + ch * 16 + 8) = (u32x2){v.z, v.w};
        }
        __syncthreads();
        const int hq = kvh * 8 + wid;
        const float sink2 = sinks[hq] * LOG2E;
        for (int j = 0; j < 4; ++j) {
            const size_t row = rowb + n * 128 + 32 * j + r32;
            bf16x8 qf[4];
#pragma unroll
            for (int d0 = 0; d0 < 4; ++d0) qf[d0] = *(const bf16x8*)(QKVZ + row * ATTN_IN + hq * 64 + d0 * 16 + hi * 8);
            f32x16 st[5];
#pragma unroll
            for (int tt = 0; tt < 5; ++tt) {
                const bool tv = (n > 0) || (j + tt >= 4);
                if (tv) {
#pragma unroll
                    for (int r = 0; r < 16; ++r) st[tt][r] = 0.f;
#pragma unroll
                    for (int d0 = 0; d0 < 4; ++d0) {
                        const bf16x8 kf = *(const LAS bf16x8*)(Ks + (32 * (j + tt) + r32) * AK_STRIDE + d0 * 32 + hi * 16);
                        st[tt] = __builtin_amdgcn_mfma_f32_32x32x16_bf16(kf, qf[d0], st[tt], 0, 0, 0);
                    }
                } else {
#pragma unroll
                    for (int r = 0; r < 16; ++r) st[tt][r] = NEG;
                }
            }
            float mx = sink2;
#pragma unroll
            for (int r = 0; r < 16; ++r) {
                const int kk = (r & 3) + 8 * (r >> 2) + 4 * hi;
                if (!(kk > r32)) st[0][r] = NEG;
                if (!(kk <= r32)) st[4][r] = NEG;
            }
#pragma unroll
            for (int tt = 0; tt < 5; ++tt)
#pragma unroll
                for (int r = 0; r < 16; ++r) mx = fmaxf(mx, st[tt][r]);
            mx = fmaxf(mx, __shfl_xor(mx, 32));
            float l = 0.f;
#pragma unroll
            for (int tt = 0; tt < 5; ++tt)
#pragma unroll
                for (int r = 0; r < 16; ++r) { const float p = __builtin_amdgcn_exp2f(st[tt][r] - mx); st[tt][r] = p; l += p; }
            l += __shfl_xor(l, 32);
            l += __builtin_amdgcn_exp2f(sink2 - mx);
            const float inv = 1.0f / l;
            f32x16 ot[2];
#pragma unroll
            for (int r = 0; r < 16; ++r) { ot[0][r] = 0.f; ot[1][r] = 0.f; }
#pragma unroll
            for (int tt = 0; tt < 5; ++tt) {
                const bool tv = (n > 0) || (j + tt >= 4);
                if (tv) {
#pragma unroll
                    for (int ks = 0; ks < 2; ++ks) {
                        u32x4 pw; pw.x = cvtpk(st[tt][8 * ks + 0], st[tt][8 * ks + 1]); pw.y = cvtpk(st[tt][8 * ks + 2], st[tt][8 * ks + 3]);
                        pw.z = cvtpk(st[tt][8 * ks + 4], st[tt][8 * ks + 5]); pw.w = cvtpk(st[tt][8 * ks + 6], st[tt][8 * ks + 7]);
                        const bf16x8 pf = __builtin_bit_cast(bf16x8, pw);
#pragma unroll
                        for (int blk = 0; blk < 2; ++blk) {
                            const LAS unsigned char* vp = Vs + (32 * blk + r32) * AV_STRIDE + (32 * (j + tt) + 16 * ks + 4 * hi) * 2;
                            const u32x2 lo = *(const LAS u32x2*)vp, hh = *(const LAS u32x2*)(vp + 16);
                            const bf16x8 vf = __builtin_bit_cast(bf16x8, (u32x4){lo.x, lo.y, hh.x, hh.y});
                            ot[blk] = __builtin_amdgcn_mfma_f32_32x32x16_bf16(vf, pf, ot[blk], 0, 0, 0);
                        }
                    }
                }
            }
#pragma unroll
            for (int blk = 0; blk < 2; ++blk)
#pragma unroll
                for (int rq = 0; rq < 4; ++rq) {
                    const int d = 32 * blk + 8 * rq + 4 * hi;
                    const u32x2 z = *(const u32x2*)(QKVZ + row * ATTN_IN + 1280 + hq * 64 + d);
                    const float o0 = ot[blk][4 * rq + 0] * inv * bf_lo(z.x), o1 = ot[blk][4 * rq + 1] * inv * bf_hi(z.x);
                    const float o2 = ot[blk][4 * rq + 2] * inv * bf_lo(z.y), o3 = ot[blk][4 * rq + 3] * inv * bf_hi(z.y);
                    *(u32x2*)(G0 + row * DM + hq * 64 + d) = (u32x2){cvtpk(o0, o1), cvtpk(o2, o3)};
                }
        }
        __syncthreads();
    }
}

constexpr int RC = 32, RQ_STRIDE = 272, R_OSTRIDE = 528;
constexpr int R_QD = 0, R_QR = R_QD + RC * RQ_STRIDE, R_KR = R_QR + RC * RQ_STRIDE, R_KD = R_KR + RC * RQ_STRIDE, R_V = R_KD + RC * RQ_STRIDE, R_PS = R_V + RC * RQ_STRIDE,
              R_DEC = R_PS + 8 * 128 * 4, R_O = R_DEC + 512, R_END = R_O + RC * R_OSTRIDE;
#define LDS_BAR() do { asm volatile("s_waitcnt lgkmcnt(0)" ::: "memory"); __builtin_amdgcn_s_barrier(); asm volatile("" ::: "memory"); } while (0)
typedef short v4i16_t __attribute__((ext_vector_type(4)));
__device__ __forceinline__ u32x2 tr4(const LAS unsigned char* p) { return __builtin_bit_cast(u32x2, __builtin_amdgcn_ds_read_tr16_b64_v4i16((LAS v4i16_t*)p)); }
__device__ __forceinline__ bf16x8 tr8(const LAS unsigned char* p0, const LAS unsigned char* p1) { const u32x2 a = tr4(p0), b = tr4(p1); return __builtin_bit_cast(bf16x8, (u32x4){a.x, a.y, b.x, b.y}); }
struct RecRegs { unsigned q[4], g[4], v[4]; u32x4 z; };
__device__ __forceinline__ void rec_load(RecRegs& R, const bf16_t* REC, size_t crow, int wid, int lane, int tid) {
#pragma unroll
    for (int i = 0; i < 4; ++i) {
        const bf16_t* rp = REC + (crow + 4 * wid + i) * 512 + 2 * lane;
        R.q[i] = *(const unsigned*)(rp); R.g[i] = *(const unsigned*)(rp + 128); R.v[i] = *(const unsigned*)(rp + 256);
    }
    R.z = *(const u32x4*)(REC + (crow + (tid >> 4)) * 512 + 384 + 8 * (tid & 15));
}
__device__ __forceinline__ void rec_finalize(LAS unsigned char* lds, const u32x4& z, const f32x4& gw0, const f32x4& gw1, bf16_t* G1row, int tid) {
    const LAS unsigned char* op = lds + R_O + (tid >> 4) * R_OSTRIDE + (tid & 15) * 32;
    const f32x4 a = *(const LAS f32x4*)op, b = *(const LAS f32x4*)(op + 16);
    float ss = (a[0] * a[0] + a[1] * a[1]) + (a[2] * a[2] + a[3] * a[3]) + (b[0] * b[0] + b[1] * b[1]) + (b[2] * b[2] + b[3] * b[3]);
#pragma unroll
    for (int o = 1; o < 16; o <<= 1) ss += __shfl_xor(ss, o);
    const float rs = rsqrtf(ss * (1.0f / 128.0f) + NORM_EPS);
    const f32x4 x = a * rs * gw0, y = b * rs * gw1;
    u32x4 w;
    w.x = cvtpk(x[0] * bf_lo(z.x), x[1] * bf_hi(z.x)); w.y = cvtpk(x[2] * bf_lo(z.y), x[3] * bf_hi(z.y));
    w.z = cvtpk(y[0] * bf_lo(z.z), y[1] * bf_hi(z.z)); w.w = cvtpk(y[2] * bf_lo(z.w), y[3] * bf_hi(z.w));
    *(u32x4*)G1row = w;
}
__device__ __forceinline__ void p_recurrence(LAS unsigned char* lds, const bf16_t* REC, const float* gnw, bf16_t* G1, int G) {
    const int tid = threadIdx.x, lane = tid & 63, wid = __builtin_amdgcn_readfirstlane(tid >> 6), c16 = lane & 15, quad = lane >> 4;
    constexpr int NC = SEQ / RC;
    for (int u = blockIdx.x; u < NB * 8; u += G) {
        const int b = u >> 3, h = u & 7;
        const size_t hrow = (size_t)u * SEQ;
        const f32x4 gw0 = *(const f32x4*)(gnw + 8 * (tid & 15)), gw1 = *(const f32x4*)(gnw + 8 * (tid & 15) + 4);
        bf16_t* G1t = G1 + ((size_t)b * SEQ + (tid >> 4)) * DM + h * 128 + 8 * (tid & 15);
        f32x4 S[8];
#pragma unroll
        for (int kt = 0; kt < 8; ++kt) S[kt] = (f32x4){0.f, 0.f, 0.f, 0.f};
        RecRegs cur, nx1, nx2;
        rec_load(cur, REC, hrow, wid, lane, tid);
        rec_load(nx1, REC, hrow + RC, wid, lane, tid);
        u32x4 zprev = (u32x4){0u, 0u, 0u, 0u};
        const int tr_row = (c16 >> 2), tr_col = 4 * (c16 & 3);
        for (int c = 0; c < NC; ++c) {
            { const int cn = (c + 2 < NC) ? c + 2 : NC - 1; rec_load(nx2, REC, hrow + (size_t)cn * RC, wid, lane, tid); }
            float g0[4], g1[4], c0 = 0.f, c1 = 0.f, cs0[4], cs1[4];
#pragma unroll
            for (int i = 0; i < 4; ++i) { g0[i] = h_lo(cur.g[i]); g1[i] = h_hi(cur.g[i]); c0 += g0[i]; c1 += g1[i]; cs0[i] = c0; cs1[i] = c1; }
            *(LAS f32x2_t*)(lds + R_PS + (wid * 128 + 2 * lane) * 4) = (f32x2_t){c0, c1};
            LDS_BAR();
            if (c > 0) rec_finalize(lds, zprev, gw0, gw1, G1t + (size_t)(c - 1) * RC * DM, tid);
            float pre0 = 0.f, pre1 = 0.f, ref0 = 0.f, ref1 = 0.f, tot0 = 0.f, tot1 = 0.f;
#pragma unroll
            for (int p = 0; p < 8; ++p) {
                const f32x2_t s = *(const LAS f32x2_t*)(lds + R_PS + (p * 128 + 2 * lane) * 4);
                if (p < wid) { pre0 += s.x; pre1 += s.y; }
                if (p < 4) { ref0 += s.x; ref1 += s.y; }
                tot0 += s.x; tot1 += s.y;
            }
            const float er0 = __builtin_amdgcn_exp2f(ref0), er1 = __builtin_amdgcn_exp2f(ref1);
            const float et0 = __builtin_amdgcn_exp2f(tot0 - ref0), et1 = __builtin_amdgcn_exp2f(tot1 - ref1);
            pre0 -= ref0; pre1 -= ref1;
#pragma unroll
            for (int i = 0; i < 4; ++i) {
                const int t = 4 * wid + i;
                const float d0 = pre0 + cs0[i], d1 = pre1 + cs1[i];
                const float qr0 = bf_lo(cur.q[i]) * __builtin_amdgcn_exp2f(fminf(d0, 100.f)), qr1 = bf_hi(cur.q[i]) * __builtin_amdgcn_exp2f(fminf(d1, 100.f));
                const float kr0 = (1.0f - __builtin_amdgcn_exp2f(g0[i])) * __builtin_amdgcn_exp2f(fminf(-d0, 100.f)), kr1 = (1.0f - __builtin_amdgcn_exp2f(g1[i])) * __builtin_amdgcn_exp2f(fminf(-d1, 100.f));
                *(LAS unsigned*)(lds + R_QR + t * RQ_STRIDE + lane * 4) = cvtpk(qr0, qr1);
                *(LAS unsigned*)(lds + R_KR + t * RQ_STRIDE + lane * 4) = cvtpk(kr0, kr1);
                *(LAS unsigned*)(lds + R_QD + t * RQ_STRIDE + lane * 4) = cvtpk(qr0 * er0, qr1 * er1);
                *(LAS unsigned*)(lds + R_KD + t * RQ_STRIDE + lane * 4) = cvtpk(kr0 * et0, kr1 * et1);
                *(LAS unsigned*)(lds + R_V + t * RQ_STRIDE + lane * 4) = cur.v[i];
            }
            if (wid == 0) *(LAS f32x2_t*)(lds + R_DEC + 2 * lane * 4) = (f32x2_t){__builtin_amdgcn_exp2f(tot0), __builtin_amdgcn_exp2f(tot1)};
            zprev = cur.z;
            LDS_BAR();
            f32x4 s00 = (f32x4){0.f, 0.f, 0.f, 0.f}, s01 = s00, s11 = s00;
#pragma unroll
            for (int kk = 0; kk < 4; ++kk) {
                const bf16x8 ka0 = *(const LAS bf16x8*)(lds + R_KR + (c16) * RQ_STRIDE + kk * 64 + quad * 16);
                const bf16x8 ka1 = *(const LAS bf16x8*)(lds + R_KR + (16 + c16) * RQ_STRIDE + kk * 64 + quad * 16);
                const bf16x8 qb0 = *(const LAS bf16x8*)(lds + R_QR + (c16) * RQ_STRIDE + kk * 64 + quad * 16);
                const bf16x8 qb1 = *(const LAS bf16x8*)(lds + R_QR + (16 + c16) * RQ_STRIDE + kk * 64 + quad * 16);
                s00 = __builtin_amdgcn_mfma_f32_16x16x32_bf16(ka0, qb0, s00, 0, 0, 0);
                s01 = __builtin_amdgcn_mfma_f32_16x16x32_bf16(ka0, qb1, s01, 0, 0, 0);
                s11 = __builtin_amdgcn_mfma_f32_16x16x32_bf16(ka1, qb1, s11, 0, 0, 0);
            }
#pragma unroll
            for (int r = 0; r < 4; ++r) { if (4 * quad + r > c16) { s00[r] = 0.f; s11[r] = 0.f; } }
            u32x4 pw0, pw1;
            pw0.x = cvtpk(s00[0], s00[1]); pw0.y = cvtpk(s00[2], s00[3]); pw0.z = 0u; pw0.w = 0u;
            pw1.x = cvtpk(s01[0], s01[1]); pw1.y = cvtpk(s01[2], s01[3]); pw1.z = cvtpk(s11[0], s11[1]); pw1.w = cvtpk(s11[2], s11[3]);
            f32x4 o0 = (f32x4){0.f, 0.f, 0.f, 0.f}, o1 = o0;
#pragma unroll
            for (int jj = 0; jj < 4; ++jj) {
                u32x4 sw; sw.x = cvtpk(S[2 * jj][0], S[2 * jj][1]); sw.y = cvtpk(S[2 * jj][2], S[2 * jj][3]); sw.z = cvtpk(S[2 * jj + 1][0], S[2 * jj + 1][1]); sw.w = cvtpk(S[2 * jj + 1][2], S[2 * jj + 1][3]);
                const bf16x8 sb = __builtin_bit_cast(bf16x8, sw);
                const LAS unsigned char* qp0 = lds + R_QD + (c16) * RQ_STRIDE + (32 * jj + 4 * quad) * 2;
                const LAS unsigned char* qp1 = lds + R_QD + (16 + c16) * RQ_STRIDE + (32 * jj + 4 * quad) * 2;
                const u32x2 a0 = *(const LAS u32x2*)qp0, a1 = *(const LAS u32x2*)(qp0 + 32), a2 = *(const LAS u32x2*)qp1, a3 = *(const LAS u32x2*)(qp1 + 32);
                o0 = __builtin_amdgcn_mfma_f32_16x16x32_bf16(__builtin_bit_cast(bf16x8, (u32x4){a0.x, a0.y, a1.x, a1.y}), sb, o0, 0, 0, 0);
                o1 = __builtin_amdgcn_mfma_f32_16x16x32_bf16(__builtin_bit_cast(bf16x8, (u32x4){a2.x, a2.y, a3.x, a3.y}), sb, o1, 0, 0, 0);
            }
            {
                const LAS unsigned char* vp = lds + R_V + (4 * quad + tr_row) * RQ_STRIDE + (16 * wid + tr_col) * 2;
                const bf16x8 vb = tr8(vp, vp + 16 * RQ_STRIDE);
                o0 = __builtin_amdgcn_mfma_f32_16x16x32_bf16(__builtin_bit_cast(bf16x8, pw0), vb, o0, 0, 0, 0);
                o1 = __builtin_amdgcn_mfma_f32_16x16x32_bf16(__builtin_bit_cast(bf16x8, pw1), vb, o1, 0, 0, 0);
            }
#pragma unroll
            for (int r = 0; r < 4; ++r) {
                *(LAS float*)(lds + R_O + (4 * quad + r) * R_OSTRIDE + (16 * wid + c16) * 4) = o0[r];
                *(LAS float*)(lds + R_O + (16 + 4 * quad + r) * R_OSTRIDE + (16 * wid + c16) * 4) = o1[r];
            }
            {
                const LAS unsigned char* vp = lds + R_V + (8 * quad + tr_row) * RQ_STRIDE + (16 * wid + tr_col) * 2;
                const bf16x8 vb = tr8(vp, vp + 4 * RQ_STRIDE);
                const LAS unsigned char* kp = lds + R_KD + (8 * quad + tr_row) * RQ_STRIDE + tr_col * 2;
#pragma unroll
                for (int kt = 0; kt < 8; ++kt) {
                    const f32x4 dv = *(const LAS f32x4*)(lds + R_DEC + (16 * kt + 4 * quad) * 4);
                    const bf16x8 ka = tr8(kp + kt * 32, kp + kt * 32 + 4 * RQ_STRIDE);
                    S[kt] = __builtin_amdgcn_mfma_f32_16x16x32_bf16(ka, vb, S[kt] * dv, 0, 0, 0);
                }
            }
            cur = nx1; nx1 = nx2;
        }
        LDS_BAR();
        rec_finalize(lds, zprev, gw0, gw1, G1t + (size_t)(NC - 1) * RC * DM, tid);
        LDS_BAR();
    }
}

constexpr int LDS_BYTES = 147456;
static_assert(pg8::STAGE_BYTES <= LDS_BYTES && AK_BYTES + AV_BYTES <= LDS_BYTES && R_END <= LDS_BYTES, "LDS map");
constexpr int N_PHASES = 9;
#define PROBE_LO -1
#define PROBE_HI 1

__global__ void __launch_bounds__(512, 2) hybrid_fwd(Args a) {
    extern __shared__ __attribute__((aligned(16))) unsigned char lds_raw[];
    LAS unsigned char* lds = (LAS unsigned char*)lds_raw;
    cg::grid_group grid = cg::this_grid();
    const int G = gridDim.x;
    const int lo = a.ph_lo, hi = a.ph_hi;
    unsigned char* ws = a.ws;
#define IN(k) (lo <= (k) && (k) < hi)
#define SEAM(k) do { if (IN(k) && IN((k) + 1)) grid.sync(); } while (0)
    if (IN(0)) { p_prologue(a, lds, G); __syncthreads(); }
    SEAM(0);
    if (IN(1)) {
        pg8::Gemm g{(const bf16_t*)(ws + WS_H), (const bf16_t*)(ws + WS_WIN0), MTOK, ATTN_IN, DM}; pg8::StaticOrder S; S.init(MTOK, ATTN_IN, G, (int)blockIdx.x);
        pg8::EpiAttnIn E{(bf16_t*)(ws + WS_QKVZ), (bf16_t*)(ws + WS_VT), a.a_bin, (const float*)(ws + WS_ROPE)};
        pg8::gemm_phase<pg8::EpiAttnIn, true, true>(lds, g, S, E);
    }
    SEAM(1);
    if (IN(2)) p_attention(lds, (const bf16_t*)(ws + WS_QKVZ), (const bf16_t*)(ws + WS_VT), a.a_sinks, (bf16_t*)(ws + WS_G0), G);
    SEAM(2);
    if (IN(3)) {
        pg8::Gemm g{(const bf16_t*)(ws + WS_G0), (const bf16_t*)(ws + WS_WOUT0), MTOK, DM, DM}; pg8::StaticOrder S; S.init(MTOK, DM, G, (int)blockIdx.x);
        pg8::EpiOut E{(bf16_t*)(ws + WS_Y), a.a_bout, (float*)(ws + WS_PART)};
        pg8::gemm_phase<pg8::EpiOut, true, true>(lds, g, S, E);
    }
    SEAM(3);
    if (IN(4)) p_residual<true>((const bf16_t*)(ws + WS_Y), (const float*)(ws + WS_PART), a.x, a.post_w, a.pre_w + DM, a.out, (bf16_t*)(ws + WS_H), G);
    SEAM(4);
    if (IN(5)) {
        pg8::Gemm g{(const bf16_t*)(ws + WS_H), (const bf16_t*)(ws + WS_WIN1), MTOK, REC_IN, DM}; pg8::StaticOrder S; S.init(MTOK, REC_IN, G, (int)blockIdx.x);
        pg8::EpiRecIn E{(bf16_t*)(ws + WS_BIG), (const float*)(ws + WS_LB)};
        pg8::gemm_phase<pg8::EpiRecIn, true, true>(lds, g, S, E);
    }
    SEAM(5);
    if (IN(6)) p_recurrence(lds, (const bf16_t*)(ws + WS_BIG), a.r_gw, (bf16_t*)(ws + WS_G1), G);
    SEAM(6);
    if (IN(7)) {
        pg8::Gemm g{(const bf16_t*)(ws + WS_G1), (const bf16_t*)(ws + WS_WOUT1), MTOK, DM, DM}; pg8::StaticOrder S; S.init(MTOK, DM, G, (int)blockIdx.x);
        pg8::EpiOut E{(bf16_t*)(ws + WS_Y), nullptr, (float*)(ws + WS_PART)};
        pg8::gemm_phase<pg8::EpiOut, true, true>(lds, g, S, E);
    }
    SEAM(7);
    if (IN(8)) p_residual<false>((const bf16_t*)(ws + WS_Y), (const float*)(ws + WS_PART), a.out, a.post_w + DM, nullptr, a.out, nullptr, G);
#undef IN
#undef SEAM
}

extern "C" void kernel_launch(void* const* d_in, const int* in_sizes, int n_in, void* d_out, int out_size, void* d_ws, size_t ws_size, hipStream_t stream) {
    static int grid = 0;
    if (grid == 0) {
        if (n_in != 13 || in_sizes[0] != MTOK * DM || out_size != MTOK * DM || ws_size < WS_END) { fprintf(stderr, "kernel_launch: unexpected shapes (n_in %d, ws %zu < %zu)\n", n_in, ws_size, (size_t)WS_END); grid = -1; return; }
        int dev = 0, cus = 0, per_cu = 0;
        hipGetDevice(&dev); hipDeviceGetAttribute(&cus, hipDeviceAttributeMultiprocessorCount, dev);
        if (hipFuncSetAttribute((const void*)hybrid_fwd, hipFuncAttributeMaxDynamicSharedMemorySize, LDS_BYTES) != hipSuccess) { fprintf(stderr, "kernel_launch: hipFuncSetAttribute failed\n"); grid = -1; return; }
        if (hipOccupancyMaxActiveBlocksPerMultiprocessor(&per_cu, (const void*)hybrid_fwd, 512, LDS_BYTES) != hipSuccess || per_cu < 1) { fprintf(stderr, "kernel_launch: occupancy query says %d\n", per_cu); per_cu = 1; }
        (void)hipGetLastError();
        grid = cus * 1;
    }
    if (grid < 0) return;
    Args a{};
    a.x = (const float*)d_in[0]; a.pos = (const int*)d_in[1]; a.pre_w = (const float*)d_in[2]; a.post_w = (const float*)d_in[3];
    a.a_win = (const float*)d_in[4]; a.a_bin = (const float*)d_in[5]; a.a_sinks = (const float*)d_in[6]; a.a_wout = (const float*)d_in[7]; a.a_bout = (const float*)d_in[8];
    a.r_win = (const float*)d_in[9]; a.r_lbl = (const float*)d_in[10]; a.r_gw = (const float*)d_in[11]; a.r_wout = (const float*)d_in[12];
    a.out = (float*)d_out; a.ws = (unsigned char*)d_ws;
    void* args[] = {&a};
#if PROBE_LO >= 0
    a.ph_lo = 0; a.ph_hi = PROBE_HI;
    (void)hipLaunchCooperativeKernel((const void*)hybrid_fwd, dim3(grid), dim3(512), args, LDS_BYTES, stream);
    a.ph_lo = PROBE_LO; a.ph_hi = N_PHASES;
#else
    a.ph_lo = 0; a.ph_hi = N_PHASES;
#endif
    hipError_t e = hipLaunchCooperativeKernel((const void*)hybrid_fwd, dim3(grid), dim3(512), args, LDS_BYTES, stream);
    if (e != hipSuccess) fprintf(stderr, "kernel_launch: cooperative launch failed: %s (grid %d)\n", hipGetErrorString(e), grid);
}
```

```cpp
#include <hip/hip_runtime.h>
#include <hip/hip_cooperative_groups.h>
#include <cstdio>
#include <cstdint>
namespace cg = cooperative_groups;

#define LAS __attribute__((address_space(3)))
typedef unsigned short bf16_t;
typedef short bf16x8 __attribute__((ext_vector_type(8)));
typedef float f32x4 __attribute__((ext_vector_type(4)));
typedef float f32x16 __attribute__((ext_vector_type(16)));
typedef unsigned u32x4 __attribute__((ext_vector_type(4)));
typedef unsigned u32x2 __attribute__((ext_vector_type(2)));
typedef float f32x2_t __attribute__((ext_vector_type(2)));
typedef __bf16 bf16x2_t __attribute__((ext_vector_type(2)));
typedef _Float16 f16x2_t __attribute__((ext_vector_type(2)));

constexpr int NB = 32, SEQ = 2048, DM = 1024, MTOK = NB * SEQ;
constexpr int ATTN_IN = 2304, REC_IN = 4096;
constexpr float NORM_EPS = 1e-6f;
constexpr float LOG2E = 1.4426950408889634f;
constexpr float QSCALE = 0.125f * 1.4426950408889634f;

constexpr size_t WS_WIN0 = 0;
constexpr size_t WS_WOUT0 = WS_WIN0 + (size_t)ATTN_IN * DM * 2;
constexpr size_t WS_WIN1 = WS_WOUT0 + (size_t)DM * DM * 2;
constexpr size_t WS_WOUT1 = WS_WIN1 + (size_t)REC_IN * DM * 2;
constexpr size_t WS_ROPE = WS_WOUT1 + (size_t)DM * DM * 2;
constexpr size_t WS_LB = WS_ROPE + (size_t)MTOK * 16 * 4;
constexpr size_t WS_BAR = WS_LB + 4096;
constexpr size_t WS_PART = WS_BAR + 16384;
constexpr size_t WS_H = WS_PART + (size_t)MTOK * 16 * 4;
constexpr size_t WS_Y = WS_H + (size_t)MTOK * DM * 2;
constexpr size_t WS_G1 = WS_Y + (size_t)MTOK * DM * 2;
constexpr size_t WS_BIG = WS_G1 + (size_t)MTOK * DM * 2;
constexpr size_t WS_QKVZ = WS_BIG;
constexpr size_t WS_G0 = WS_QKVZ + (size_t)MTOK * ATTN_IN * 2;
constexpr size_t WS_VT = WS_G0 + (size_t)MTOK * DM * 2;
constexpr size_t WS_END = WS_BIG + (size_t)MTOK * REC_IN * 2;
static_assert(WS_VT + (size_t)MTOK * 128 * 2 <= WS_END, "overlay");

__device__ __forceinline__ unsigned cvtpk(float lo, float hi) { f32x2_t v = {lo, hi}; bf16x2_t b = __builtin_convertvector(v, bf16x2_t); return __builtin_bit_cast(unsigned, b); }
__device__ __forceinline__ unsigned cvtpk_h(float lo, float hi) { f32x2_t v = {lo, hi}; f16x2_t b = __builtin_convertvector(v, f16x2_t); return __builtin_bit_cast(unsigned, b); }
__device__ __forceinline__ float bf_lo(unsigned u) { return __uint_as_float(u << 16); }
__device__ __forceinline__ float bf_hi(unsigned u) { return __uint_as_float(u & 0xffff0000u); }
__device__ __forceinline__ float h_lo(unsigned u) { f16x2_t h = __builtin_bit_cast(f16x2_t, u); return (float)h[0]; }
__device__ __forceinline__ float h_hi(unsigned u) { f16x2_t h = __builtin_bit_cast(f16x2_t, u); return (float)h[1]; }
__device__ __forceinline__ float silu_f(float v) { return v * __builtin_amdgcn_rcpf(1.0f + __expf(-v)); }
__device__ __forceinline__ float wave_sum(float v) {
#pragma unroll
    for (int o = 1; o < 64; o <<= 1) v += __shfl_xor(v, o);
    return v;
}

namespace pg8 {
constexpr int BM = 256, BK = 64, HALF = 128, HTB = HALF * BK * 2, STAGE_BYTES = 8 * HTB, NXCD = 8, WGM = 8;
__host__ __device__ __forceinline__ int lds_byte(int r, int c) { const int st = (r >> 4) * 2 + (c >> 5), rr = r & 15, cc = c & 31, ob = rr * 64 + cc * 2; return st * 1024 + (ob ^ (((ob >> 9) & 1) << 5)); }
__host__ __device__ __forceinline__ void stage_rc(int b, int& R, int& C) { const int st = b / 1024, sb = b % 1024, swz = sb ^ (((sb >> 9) & 1) << 5); R = (st >> 1) * 16 + swz / 64; C = (st & 1) * 32 + (swz % 64) / 2; }
__host__ __device__ __forceinline__ int perm32(int rho) { const int n = rho >> 4, i = rho & 15; return 8 * (i >> 2) + 4 * n + (i & 3); }

struct Unit { int pm, pn; };
struct Gemm { const bf16_t* A; const bf16_t* Bt; int M, N, K; };

struct StaticOrder {
    int nM, nN, nwg, G, c;
    __host__ __device__ void init(int M, int N, int G_, int c_) { nM = M / BM; nN = N / BM; nwg = nM * nN; G = G_; c = c_; }
    __host__ __device__ bool next(int i, Unit& u) const {
        const long L = (long)i * G + c; if (L >= nwg) return false;
        int wgid = (int)L; { const int q = nwg / NXCD, r = nwg % NXCD, xcd = wgid % NXCD, off = wgid / NXCD; wgid = (xcd < r ? xcd * (q + 1) : r * (q + 1) + (xcd - r) * q) + off; }
        const int nig = WGM * nN, gid = wgid / nig, fm = gid * WGM, gsz = (nM - fm) < WGM ? (nM - fm) : WGM;
        u.pm = fm + ((wgid % nig) % gsz); u.pn = (wgid % nig) / gsz; return true;
    }
};

template <class Epi, bool ALIGN_EPI, bool SP2>
__device__ __forceinline__ void gemm_phase(LAS unsigned char* lds, const Gemm g, const StaticOrder& S, const Epi& E) {
    const int tid = threadIdx.x, wid = __builtin_amdgcn_readfirstlane(tid >> 6), lane = tid & 63, wr = wid >> 2, wc = wid & 3, fr = lane & 15, fq = lane >> 4;
    const int K = g.K, nt = K / BK;
    unsigned voffA[2], voffB[2];
#pragma unroll
    for (int i = 0; i < 2; ++i) { int R, C; stage_rc(tid * 16 + i * 8192, R, C); const int Rb = Epi::PERM ? ((R & ~31) + perm32(R & 31)) : R;
        voffA[i] = (unsigned)(R * K + C) * 2u; voffB[i] = (unsigned)(Rb * K + C) * 2u; }
    const size_t kstep = (size_t)(BK * 2);
    const size_t hstep = (size_t)HALF * K * 2;
    const size_t tstep = 2 * hstep;
    const unsigned ldsw = (unsigned)wid * 1024u;
    const int aoff = lds_byte(wr * 64 + fr, fq * 8), boff = lds_byte(wc * 32 + fr, fq * 8);
#define PG8_SA(b, h) (((b) * 2 + (h)) * HTB)
#define PG8_SB(b, h) ((4 + (b) * 2 + (h)) * HTB)
#define PG8_STAGE(bufoff, gbase, voff) do { _Pragma("unroll") for (int _i = 0; _i < 2; ++_i) \
        __builtin_amdgcn_global_load_lds((const unsigned*)((const char*)(gbase) + (voff)[_i]), (LAS unsigned*)(lds + (bufoff) + ldsw + _i * 8192), 16, 0, 0); } while (0)
#define PG8_LDA(dst, b, h) do { _Pragma("unroll") for (int m = 0; m < 4; ++m) _Pragma("unroll") for (int k = 0; k < 2; ++k) dst[m][k] = *(const LAS bf16x8*)(lds + PG8_SA(b, h) + aoff + m * 2048 + k * 1024); } while (0)
#define PG8_LDB(dst, b, h) do { _Pragma("unroll") for (int n = 0; n < 2; ++n) _Pragma("unroll") for (int k = 0; k < 2; ++k) dst[n][k] = *(const LAS bf16x8*)(lds + PG8_SB(b, h) + boff + n * 2048 + k * 1024); } while (0)
#define PG8_MMA(ai, bj, Af, Bf) do { __builtin_amdgcn_s_setprio(1); _Pragma("unroll") for (int m = 0; m < 4; ++m) _Pragma("unroll") for (int n = 0; n < 2; ++n) _Pragma("unroll") for (int k = 0; k < 2; ++k) \
        acc[ai][bj][m][n] = __builtin_amdgcn_mfma_f32_16x16x32_bf16(Bf[n][k], Af[m][k], acc[ai][bj][m][n], 0, 0, 0); __builtin_amdgcn_s_setprio(0); } while (0)
#define PG8_WAIT_V(n) asm volatile("s_waitcnt vmcnt(" #n ")" ::: "memory")
#define PG8_WAIT_L(n) asm volatile("s_waitcnt lgkmcnt(" #n ")" ::: "memory")
#define PG8_BAR __builtin_amdgcn_s_barrier()
#define PG8_SCHED __builtin_amdgcn_sched_barrier(0)
    Unit cur, nxt; int ui = 0;
    if (!S.next(0, cur)) return;
    f32x4 acc[2][2][4][2];
#pragma unroll
    for (int a = 0; a < 2; ++a)
#pragma unroll
        for (int b = 0; b < 2; ++b)
#pragma unroll
            for (int m = 0; m < 4; ++m)
#pragma unroll
                for (int n = 0; n < 2; ++n) acc[a][b][m][n] = (f32x4){0.f, 0.f, 0.f, 0.f};
    bf16x8 At[4][2], B0[2][2], B1[2][2];
    const char* cA = (const char*)g.A + (size_t)cur.pm * tstep; const char* cB = (const char*)g.Bt + (size_t)cur.pn * tstep;
    if constexpr (SP2) {
        PG8_STAGE(PG8_SB(0, 0), cB, voffB); PG8_STAGE(PG8_SB(0, 1), cB + hstep, voffB); PG8_STAGE(PG8_SA(0, 0), cA, voffA); PG8_STAGE(PG8_SA(0, 1), cA + hstep, voffA);
        if (wr == 1) PG8_BAR;
        PG8_WAIT_V(2); PG8_BAR;
        PG8_STAGE(PG8_SB(1, 0), cB + kstep, voffB); PG8_STAGE(PG8_SA(1, 0), cA + kstep, voffA); PG8_STAGE(PG8_SB(1, 1), cB + hstep + kstep, voffB);
        PG8_WAIT_V(6); PG8_BAR;
    } else {
        PG8_STAGE(PG8_SB(0, 0), cB, voffB); PG8_STAGE(PG8_SA(0, 0), cA, voffA); PG8_STAGE(PG8_SB(0, 1), cB + hstep, voffB); PG8_STAGE(PG8_SA(0, 1), cA + hstep, voffA);
        if (wr == 1) PG8_BAR;
        PG8_WAIT_V(4); PG8_BAR;
        PG8_STAGE(PG8_SB(1, 0), cB + kstep, voffB); PG8_STAGE(PG8_SA(1, 0), cA + kstep, voffA); PG8_STAGE(PG8_SB(1, 1), cB + hstep + kstep, voffB);
        PG8_WAIT_V(6); PG8_BAR;
    }
    for (;;) {
        const bool has_next = S.next(ui + 1, nxt);
        const char* nA = has_next ? (const char*)g.A + (size_t)nxt.pm * tstep : cA; const char* nB = has_next ? (const char*)g.Bt + (size_t)nxt.pn * tstep : cB;
        for (int t = 0; t < nt; t += 2) {
            const bool last = (t == nt - 2);
            const char* a1 = cA + (size_t)(t + 1) * kstep;
            const char* a2 = last ? nA : cA + (size_t)(t + 2) * kstep; const char* b2 = last ? nB : cB + (size_t)(t + 2) * kstep;
            const char* a3 = a2 + kstep; const char* b3 = b2 + kstep;
            if constexpr (SP2) {
            PG8_LDB(B0, 0, 0); PG8_LDB(B1, 0, 1); PG8_SCHED; PG8_LDA(At, 0, 0); PG8_STAGE(PG8_SA(1, 1), a1 + hstep, voffA);
            PG8_WAIT_V(8); PG8_WAIT_L(0); PG8_BAR; PG8_MMA(0, 0, At, B0); PG8_MMA(0, 1, At, B1); PG8_BAR; PG8_SCHED;
            PG8_LDA(At, 0, 1); PG8_STAGE(PG8_SB(0, 0), b2, voffB); PG8_STAGE(PG8_SB(0, 1), b2 + hstep, voffB); PG8_STAGE(PG8_SA(0, 0), a2, voffA);
            PG8_WAIT_V(8); PG8_WAIT_L(0); PG8_BAR; PG8_MMA(1, 0, At, B0); PG8_MMA(1, 1, At, B1); PG8_BAR; PG8_SCHED;
            PG8_LDB(B0, 1, 0); PG8_LDB(B1, 1, 1); PG8_SCHED; PG8_LDA(At, 1, 0); PG8_STAGE(PG8_SA(0, 1), a2 + hstep, voffA);
            PG8_WAIT_V(8); PG8_WAIT_L(0); PG8_BAR; PG8_MMA(0, 0, At, B0); PG8_MMA(0, 1, At, B1); PG8_BAR; PG8_SCHED;
            PG8_LDA(At, 1, 1); PG8_STAGE(PG8_SB(1, 0), b3, voffB); PG8_STAGE(PG8_SB(1, 1), b3 + hstep, voffB); PG8_STAGE(PG8_SA(1, 0), a3, voffA);
            PG8_WAIT_V(8); PG8_WAIT_L(0); PG8_BAR; PG8_MMA(1, 0, At, B0); PG8_MMA(1, 1, At, B1); PG8_BAR; PG8_SCHED;
            } else {
            PG8_LDB(B0, 0, 0); PG8_SCHED; PG8_LDA(At, 0, 0); PG8_STAGE(PG8_SA(1, 1), a1 + hstep, voffA);
            PG8_WAIT_L(8); PG8_BAR; PG8_WAIT_L(0); PG8_MMA(0, 0, At, B0); PG8_BAR; PG8_SCHED;
            PG8_LDB(B1, 0, 1); PG8_STAGE(PG8_SB(0, 0), b2, voffB);
            PG8_BAR; PG8_WAIT_L(0); PG8_MMA(0, 1, At, B1); PG8_BAR;
            PG8_LDA(At, 0, 1); PG8_STAGE(PG8_SA(0, 0), a2, voffA);
            PG8_BAR; PG8_WAIT_L(0); PG8_MMA(1, 0, At, B0); PG8_BAR; PG8_SCHED;
            PG8_STAGE(PG8_SB(0, 1), b2 + hstep, voffB);
            PG8_WAIT_V(6); PG8_BAR; PG8_MMA(1, 1, At, B1); PG8_BAR;
            PG8_LDB(B0, 1, 0); PG8_SCHED; PG8_LDA(At, 1, 0); PG8_STAGE(PG8_SA(0, 1), a2 + hstep, voffA);
            PG8_WAIT_L(8); PG8_BAR; PG8_WAIT_L(0); PG8_MMA(0, 0, At, B0); PG8_BAR; PG8_SCHED;
            PG8_LDB(B1, 1, 1); PG8_STAGE(PG8_SB(1, 0), b3, voffB);
            PG8_BAR; PG8_WAIT_L(0); PG8_MMA(0, 1, At, B1); PG8_BAR;
            PG8_LDA(At, 1, 1); PG8_STAGE(PG8_SA(1, 0), a3, voffA);
            PG8_BAR; PG8_WAIT_L(0); PG8_MMA(1, 0, At, B0); PG8_BAR; PG8_SCHED;
            PG8_STAGE(PG8_SB(1, 1), b3 + hstep, voffB);
            PG8_WAIT_V(6); PG8_BAR; PG8_MMA(1, 1, At, B1); PG8_BAR;
            }
        }
        if constexpr (ALIGN_EPI) { if (wr == 0) PG8_BAR; }
        E(acc, cur, wr, wc, fr, fq);
        if (!has_next) break;
#pragma unroll
        for (int a = 0; a < 2; ++a)
#pragma unroll
            for (int b = 0; b < 2; ++b)
#pragma unroll
                for (int m = 0; m < 4; ++m)
#pragma unroll
                    for (int n = 0; n < 2; ++n) acc[a][b][m][n] = (f32x4){0.f, 0.f, 0.f, 0.f};
        cur = nxt; cA = nA; cB = nB; ++ui;
        if constexpr (ALIGN_EPI) { if (wr == 1) PG8_BAR; }
    }
    PG8_WAIT_V(0);
    if constexpr (!ALIGN_EPI) { if (wr == 0) PG8_BAR; }
    PG8_BAR;
#undef PG8_SA
#undef PG8_SB
#undef PG8_STAGE
#undef PG8_LDA
#undef PG8_LDB
#undef PG8_MMA
#undef PG8_WAIT_V
#undef PG8_WAIT_L
#undef PG8_BAR
#undef PG8_SCHED
}

struct EpiAttnIn {
    static constexpr bool PERM = true;
    bf16_t* O; bf16_t* VT; const float* bias; const float* rope;
    __device__ __forceinline__ void operator()(const f32x4 (&acc)[2][2][4][2], const Unit& u, int wr, int wc, int fr, int fq) const {
        const int row0 = u.pm * BM + wr * 64 + fr;
#pragma unroll
        for (int bj = 0; bj < 2; ++bj) {
            const int cbase = u.pn * BM + bj * HALF;
            const int c0 = cbase + wc * 32 + 8 * fq;
            const f32x4 bv0 = *(const f32x4*)(bias + c0), bv1 = *(const f32x4*)(bias + c0 + 4);
            const int kind = cbase < 1024 ? 0 : (cbase < 1152 ? 1 : (cbase < 1280 ? 2 : 3));
            const bool ropew = (kind <= 1) && ((wc & 1) == 0);
#pragma unroll
            for (int ai = 0; ai < 2; ++ai)
#pragma unroll
                for (int m = 0; m < 4; ++m) {
                    const int row = row0 + ai * HALF + m * 16;
                    f32x4 v0 = acc[ai][bj][m][0] + bv0, v1 = acc[ai][bj][m][1] + bv1;
                    if (ropew) {
                        f32x4 p0, p1;
#pragma unroll
                        for (int i = 0; i < 4; ++i) { p0[i] = __shfl_xor(v0[i], 16); p1[i] = __shfl_xor(v1[i], 16); }
                        if (fq < 2) {
                            const float* rp = rope + (size_t)row * 16;
                            const f32x4 c0v = *(const f32x4*)(rp), c1v = *(const f32x4*)(rp + 4), s0v = *(const f32x4*)(rp + 8), s1v = *(const f32x4*)(rp + 12);
                            const float sg = (fq == 0) ? -1.f : 1.f;
                            v0 = v0 * c0v + sg * (p0 * s0v); v1 = v1 * c1v + sg * (p1 * s1v);
                        }
                    }
                    if (kind == 0) { v0 = v0 * QSCALE; v1 = v1 * QSCALE; }
                    if (kind == 3) {
#pragma unroll
                        for (int i = 0; i < 4; ++i) { v0[i] = silu_f(v0[i]); v1[i] = silu_f(v1[i]); }
                    }
                    if (kind == 2) {
                        const int b = row >> 11, t = row & 2047, dd = (c0 - 1152);
                        bf16_t* vp = VT + ((size_t)(b * 128 + dd)) * SEQ + t;
#pragma unroll
                        for (int i = 0; i < 4; ++i) { vp[(size_t)i * SEQ] = (bf16_t)(cvtpk(v0[i], 0.f) & 0xffffu); vp[(size_t)(i + 4) * SEQ] = (bf16_t)(cvtpk(v1[i], 0.f) & 0xffffu); }
                    } else {
                        u32x4 w; w.x = cvtpk(v0[0], v0[1]); w.y = cvtpk(v0[2], v0[3]); w.z = cvtpk(v1[0], v1[1]); w.w = cvtpk(v1[2], v1[3]);
                        *(u32x4*)(O + (size_t)row * ATTN_IN + c0) = w;
                    }
                }
        }
    }
};
struct EpiRecIn {
    static constexpr bool PERM = true;
    bf16_t* O; const float* lb;
    __device__ __forceinline__ void operator()(const f32x4 (&acc)[2][2][4][2], const Unit& u, int wr, int wc, int fr, int fq) const {
        const int row0 = u.pm * BM + wr * 64 + fr;
        const int seg = u.pn >> 2;
#pragma unroll
        for (int bj = 0; bj < 2; ++bj) {
            const int c0 = u.pn * BM + bj * HALF + wc * 32 + 8 * fq;
            f32x4 l0 = (f32x4){0.f, 0.f, 0.f, 0.f}, l1 = l0;
            if (seg == 1) { l0 = *(const f32x4*)(lb + (c0 - 1024)); l1 = *(const f32x4*)(lb + (c0 - 1024) + 4); }
#pragma unroll
            for (int ai = 0; ai < 2; ++ai)
#pragma unroll
                for (int m = 0; m < 4; ++m) {
                    const int row = row0 + ai * HALF + m * 16;
                    f32x4 v0 = acc[ai][bj][m][0], v1 = acc[ai][bj][m][1];
                    u32x4 w;
                    if (seg == 1) {
#pragma unroll
                        for (int i = 0; i < 4; ++i) {
                            const float s0 = __builtin_amdgcn_rcpf(1.0f + __expf(-v0[i])), s1 = __builtin_amdgcn_rcpf(1.0f + __expf(-v1[i]));
                            v0[i] = __log2f(l0[i] + (1.0f - l0[i]) * s0); v1[i] = __log2f(l1[i] + (1.0f - l1[i]) * s1);
                        }
                        w.x = cvtpk_h(v0[0], v0[1]); w.y = cvtpk_h(v0[2], v0[3]); w.z = cvtpk_h(v1[0], v1[1]); w.w = cvtpk_h(v1[2], v1[3]);
                    } else {
                        if (seg != 2) {
#pragma unroll
                            for (int i = 0; i < 4; ++i) { v0[i] = silu_f(v0[i]); v1[i] = silu_f(v1[i]); }
                        }
                        w.x = cvtpk(v0[0], v0[1]); w.y = cvtpk(v0[2], v0[3]); w.z = cvtpk(v1[0], v1[1]); w.w = cvtpk(v1[2], v1[3]);
                    }
                    *(u32x4*)(O + ((size_t)((row >> 11) * 8 + (u.pn & 3) * 2 + bj) * SEQ + (row & 2047)) * 512 + seg * 128 + wc * 32 + 8 * fq) = w;
                }
        }
    }
};
struct EpiOut {
    static constexpr bool PERM = true;
    bf16_t* O; const float* bias; float* part;
    __device__ __forceinline__ void operator()(const f32x4 (&acc)[2][2][4][2], const Unit& u, int wr, int wc, int fr, int fq) const {
        const int row0 = u.pm * BM + wr * 64 + fr;
        f32x4 bv[2][2];
#pragma unroll
        for (int bj = 0; bj < 2; ++bj) { const int c0 = u.pn * BM + bj * HALF + wc * 32 + 8 * fq;
            bv[bj][0] = bias ? *(const f32x4*)(bias + c0) : (f32x4){0.f, 0.f, 0.f, 0.f}; bv[bj][1] = bias ? *(const f32x4*)(bias + c0 + 4) : (f32x4){0.f, 0.f, 0.f, 0.f}; }
#pragma unroll
        for (int ai = 0; ai < 2; ++ai)
#pragma unroll
            for (int m = 0; m < 4; ++m) {
                const int row = row0 + ai * HALF + m * 16;
                float ss = 0.f;
#pragma unroll
                for (int bj = 0; bj < 2; ++bj) {
                    const int c0 = u.pn * BM + bj * HALF + wc * 32 + 8 * fq;
                    const f32x4 v0 = acc[ai][bj][m][0] + bv[bj][0], v1 = acc[ai][bj][m][1] + bv[bj][1];
                    ss += (v0[0] * v0[0] + v0[1] * v0[1]) + (v0[2] * v0[2] + v0[3] * v0[3]) + (v1[0] * v1[0] + v1[1] * v1[1]) + (v1[2] * v1[2] + v1[3] * v1[3]);
                    u32x4 w; w.x = cvtpk(v0[0], v0[1]); w.y = cvtpk(v0[2], v0[3]); w.z = cvtpk(v1[0], v1[1]); w.w = cvtpk(v1[2], v1[3]);
                    *(u32x4*)(O + (size_t)row * DM + c0) = w;
                }
                ss += __shfl_xor(ss, 16); ss += __shfl_xor(ss, 32);
                if (fq == 0) part[(size_t)row * 16 + u.pn * 4 + wc] = ss;
            }
    }
};
}

__device__ __forceinline__ void transpose_item(const float* W, int K, int N, bf16_t* WT, LAS float* scr, int item, int lane) {
    const int nblk = N / 32, kb = item / nblk, nb = item % nblk, k0 = 64 * kb, n0 = 32 * nb;
#pragma unroll 8
    for (int i = 0; i < 32; ++i) { const int kk = 2 * i + (lane >> 5); scr[kk * 33 + (lane & 31)] = W[(size_t)(k0 + kk) * N + n0 + (lane & 31)]; }
    asm volatile("s_waitcnt lgkmcnt(0)" ::: "memory");
    const int c = lane & 7;
#pragma unroll
    for (int j = 0; j < 4; ++j) { const int n = (lane >> 3) + 8 * j; const LAS float* s = scr + (8 * c) * 33 + n;
        u32x4 o; o.x = cvtpk(s[0 * 33], s[1 * 33]); o.y = cvtpk(s[2 * 33], s[3 * 33]); o.z = cvtpk(s[4 * 33], s[5 * 33]); o.w = cvtpk(s[6 * 33], s[7 * 33]);
        *(u32x4*)(WT + (size_t)(n0 + n) * K + k0 + 8 * c) = o; }
    asm volatile("s_waitcnt lgkmcnt(0)" ::: "memory");
}

struct Args {
    const float* x; const int* pos; const float* pre_w; const float* post_w; const float* a_win; const float* a_bin; const float* a_sinks;
    const float* a_wout; const float* a_bout; const float* r_win; const float* r_lbl; const float* r_gw; const float* r_wout;
    float* out; unsigned char* ws; int ph_lo, ph_hi;
};

__device__ __forceinline__ void load_w16(const float* w, int lane, f32x4 (&r)[2][2]) {
#pragma unroll
    for (int j = 0; j < 2; ++j)
#pragma unroll
        for (int h = 0; h < 2; ++h) r[j][h] = *(const f32x4*)(w + 512 * j + 8 * lane + 4 * h);
}

__device__ __forceinline__ void p_prologue(const Args& a, LAS unsigned char* lds, int G) {
    const int tid = threadIdx.x, lane = tid & 63, wid = __builtin_amdgcn_readfirstlane(tid >> 6);
    LAS float* scr = (LAS float*)(lds + wid * 16384);
    const int gw = blockIdx.x * 8 + wid, NGW = G * 8;
    constexpr int I_A = (DM / 64) * (ATTN_IN / 32), I_O = (DM / 64) * (DM / 32), I_R = (DM / 64) * (REC_IN / 32);
    constexpr int NITEMS = I_A + I_O + I_R + I_O;
    for (int it = gw; it < NITEMS; it += NGW) {
        int r = it;
        if (r < I_A) { transpose_item(a.a_win, DM, ATTN_IN, (bf16_t*)(a.ws + WS_WIN0), scr, r, lane); continue; } r -= I_A;
        if (r < I_O) { transpose_item(a.a_wout, DM, DM, (bf16_t*)(a.ws + WS_WOUT0), scr, r, lane); continue; } r -= I_O;
        if (r < I_R) { transpose_item(a.r_win, DM, REC_IN, (bf16_t*)(a.ws + WS_WIN1), scr, r, lane); continue; } r -= I_R;
        transpose_item(a.r_wout, DM, DM, (bf16_t*)(a.ws + WS_WOUT1), scr, r, lane);
    }
    {
        float* rope = (float*)(a.ws + WS_ROPE);
        const int gt = blockIdx.x * 512 + tid, NGT = G * 512;
        for (int e = gt; e < MTOK * 8; e += NGT) {
            const int row = e >> 3, i = e & 7;
            const float invf = (i == 0) ? 1.0f : (i == 1) ? 0.19392274474868576f : (i == 2) ? 0.03760603093086393f : (i == 3) ? 0.007292664737217109f :
                               (i == 4) ? 0.001414213562373095f : (i == 5) ? 0.0002742481756762073f : (i == 6) ? 5.318295896944988e-05f : 1.031338537721246e-05f;
            const float ang = (float)a.pos[row] * invf;
            rope[(size_t)row * 16 + i] = cosf(ang); rope[(size_t)row * 16 + 8 + i] = sinf(ang);
        }
        float* lb = (float*)(a.ws + WS_LB);
        for (int e = gt; e < DM; e += NGT) { const float l0 = a.r_lbl[e], l1 = a.r_lbl[DM + e]; lb[e] = 1.0f / (1.0f + expf(l0 - l1)); }
    }
    {
        f32x4 wv[2][2]; load_w16(a.pre_w, lane, wv);
        bf16_t* H = (bf16_t*)(a.ws + WS_H);
        for (int row = gw; row < MTOK; row += NGW) {
            const float* xr = a.x + (size_t)row * DM;
            f32x4 xv[2][2]; float ss = 0.f;
#pragma unroll
            for (int j = 0; j < 2; ++j)
#pragma unroll
                for (int h = 0; h < 2; ++h) { xv[j][h] = *(const f32x4*)(xr + 512 * j + 8 * lane + 4 * h); const f32x4 t = xv[j][h]; ss += (t[0] * t[0] + t[1] * t[1]) + (t[2] * t[2] + t[3] * t[3]); }
            const float rstd = rsqrtf(wave_sum(ss) * (1.0f / DM) + NORM_EPS);
#pragma unroll
            for (int j = 0; j < 2; ++j) {
                const f32x4 h0 = xv[j][0] * rstd * wv[j][0], h1 = xv[j][1] * rstd * wv[j][1];
                u32x4 w; w.x = cvtpk(h0[0], h0[1]); w.y = cvtpk(h0[2], h0[3]); w.z = cvtpk(h1[0], h1[1]); w.w = cvtpk(h1[2], h1[3]);
                *(u32x4*)(H + (size_t)row * DM + 512 * j + 8 * lane) = w;
            }
        }
    }
}

template <bool WITH_H>
__device__ __forceinline__ void p_residual(const bf16_t* Y, const float* part, const float* xin, const float* post_w, const float* pre_w_next, float* xout, bf16_t* Hout, int G) {
    const int tid = threadIdx.x, lane = tid & 63, wid = __builtin_amdgcn_readfirstlane(tid >> 6);
    const int gw = blockIdx.x * 8 + wid, NGW = G * 8;
    f32x4 wp[2][2], wn[2][2]; load_w16(post_w, lane, wp);
    if (WITH_H) load_w16(pre_w_next, lane, wn);
    for (int row = gw; row < MTOK; row += NGW) {
        const float ps = (lane < 16) ? part[(size_t)row * 16 + lane] : 0.f;
        u32x4 yv[2]; f32x4 xv[2][2];
#pragma unroll
        for (int j = 0; j < 2; ++j) { yv[j] = *(const u32x4*)(Y + (size_t)row * DM + 512 * j + 8 * lane);
#pragma unroll
            for (int h = 0; h < 2; ++h) xv[j][h] = *(const f32x4*)(xin + (size_t)row * DM + 512 * j + 8 * lane + 4 * h); }
        const float rstd = rsqrtf(wave_sum(ps) * (1.0f / DM) + NORM_EPS);
        float ss = 0.f;
#pragma unroll
        for (int j = 0; j < 2; ++j) {
            const f32x4 y0 = (f32x4){bf_lo(yv[j].x), bf_hi(yv[j].x), bf_lo(yv[j].y), bf_hi(yv[j].y)}, y1 = (f32x4){bf_lo(yv[j].z), bf_hi(yv[j].z), bf_lo(yv[j].w), bf_hi(yv[j].w)};
            xv[j][0] = xv[j][0] + y0 * rstd * wp[j][0]; xv[j][1] = xv[j][1] + y1 * rstd * wp[j][1];
#pragma unroll
            for (int h = 0; h < 2; ++h) { const f32x4 t = xv[j][h]; ss += (t[0] * t[0] + t[1] * t[1]) + (t[2] * t[2] + t[3] * t[3]); *(f32x4*)(xout + (size_t)row * DM + 512 * j + 8 * lane + 4 * h) = t; }
        }
        if (WITH_H) {
            const float r2 = rsqrtf(wave_sum(ss) * (1.0f / DM) + NORM_EPS);
#pragma unroll
            for (int j = 0; j < 2; ++j) {
                const f32x4 h0 = xv[j][0] * r2 * wn[j][0], h1 = xv[j][1] * r2 * wn[j][1];
                u32x4 w; w.x = cvtpk(h0[0], h0[1]); w.y = cvtpk(h0[2], h0[3]); w.z = cvtpk(h1[0], h1[1]); w.w = cvtpk(h1[2], h1[3]);
                *(u32x4*)(Hout + (size_t)row * DM + 512 * j + 8 * lane) = w;
            }
        }
    }
}

constexpr int AK_STRIDE = 144, AV_STRIDE = 520, AK_BYTES = 256 * AK_STRIDE, AV_BYTES = 64 * AV_STRIDE;
__device__ __forceinline__ void p_attention(LAS unsigned char* lds, const bf16_t* QKVZ, const bf16_t* VT, const float* sinks, bf16_t* G0, int G) {
    const int tid = threadIdx.x, lane = tid & 63, wid = __builtin_amdgcn_readfirstlane(tid >> 6), r32 = lane & 31, hi = lane >> 5;
    LAS unsigned char* Ks = lds; LAS unsigned char* Vs = lds + AK_BYTES;
    const float NEG = -INFINITY;
    for (int u = blockIdx.x; u < NB * 16 * 2; u += G) {
        const int kvh = u & 1, n = (u >> 1) & 15, b = u >> 5;
        const size_t rowb = (size_t)b * SEQ;
        const int kstart = n * 128 - 128;
#pragma unroll
        for (int i = 0; i < 4; ++i) {
            const int idx = tid + 512 * i, kr = idx >> 3, ch = idx & 7, tok = kstart + kr;
            u32x4 v = (u32x4){0u, 0u, 0u, 0u};
            if (tok >= 0) v = *(const u32x4*)(QKVZ + (rowb + tok) * ATTN_IN + 1024 + kvh * 64 + ch * 8);
            *(LAS u32x4*)(Ks + kr * AK_STRIDE + ch * 16) = v;
        }
#pragma unroll
        for (int i = 0; i < 4; ++i) {
            const int idx = tid + 512 * i, d = idx >> 5, ch = idx & 31, tok = kstart + ch * 8;
            u32x4 v = (u32x4){0u, 0u, 0u, 0u};
            if (tok >= 0) v = *(const u32x4*)(VT + ((size_t)(b * 128 + kvh * 64 + d)) * SEQ + tok);
            *(LAS u32x2*)(Vs + d * AV_STRIDE + ch * 16) = (u32x2){v.x, v.y};
            *(LAS u32x2*)(Vs + d * AV_STRIDE + ch * 16 + 8) = (u32x2){v.z, v.w};
        }
        __syncthreads();
        const int hq = kvh * 8 + wid;
        const float sink2 = sinks[hq] * LOG2E;
        for (int j = 0; j < 4; ++j) {
            const size_t row = rowb + n * 128 + 32 * j + r32;
            bf16x8 qf[4];
#pragma unroll
            for (int d0 = 0; d0 < 4; ++d0) qf[d0] = *(const bf16x8*)(QKVZ + row * ATTN_IN + hq * 64 + d0 * 16 + hi * 8);
            f32x16 st[5];
#pragma unroll
            for (int tt = 0; tt < 5; ++tt) {
                const bool tv = (n > 0) || (j + tt >= 4);
                if (tv) {
#pragma unroll
                    for (int r = 0; r < 16; ++r) st[tt][r] = 0.f;
#pragma unroll
                    for (int d0 = 0; d0 < 4; ++d0) {
                        const bf16x8 kf = *(const LAS bf16x8*)(Ks + (32 * (j + tt) + r32) * AK_STRIDE + d0 * 32 + hi * 16);
                        st[tt] = __builtin_amdgcn_mfma_f32_32x32x16_bf16(kf, qf[d0], st[tt], 0, 0, 0);
                    }
                } else {
#pragma unroll
                    for (int r = 0; r < 16; ++r) st[tt][r] = NEG;
                }
            }
            float mx = sink2;
#pragma unroll
            for (int r = 0; r < 16; ++r) {
                const int kk = (r & 3) + 8 * (r >> 2) + 4 * hi;
                if (!(kk > r32)) st[0][r] = NEG;
                if (!(kk <= r32)) st[4][r] = NEG;
            }
#pragma unroll
            for (int tt = 0; tt < 5; ++tt)
#pragma unroll
                for (int r = 0; r < 16; ++r) mx = fmaxf(mx, st[tt][r]);
            mx = fmaxf(mx, __shfl_xor(mx, 32));
            float l = 0.f;
#pragma unroll
            for (int tt = 0; tt < 5; ++tt)
#pragma unroll
                for (int r = 0; r < 16; ++r) { const float p = __builtin_amdgcn_exp2f(st[tt][r] - mx); st[tt][r] = p; l += p; }
            l += __shfl_xor(l, 32);
            l += __builtin_amdgcn_exp2f(sink2 - mx);
            const float inv = 1.0f / l;
            f32x16 ot[2];
#pragma unroll
            for (int r = 0; r < 16; ++r) { ot[0][r] = 0.f; ot[1][r] = 0.f; }
#pragma unroll
            for (int tt = 0; tt < 5; ++tt) {
                const bool tv = (n > 0) || (j + tt >= 4);
                if (tv) {
#pragma unroll
                    for (int ks = 0; ks < 2; ++ks) {
                        u32x4 pw; pw.x = cvtpk(st[tt][8 * ks + 0], st[tt][8 * ks + 1]); pw.y = cvtpk(st[tt][8 * ks + 2], st[tt][8 * ks + 3]);
                        pw.z = cvtpk(st[tt][8 * ks + 4], st[tt][8 * ks + 5]); pw.w = cvtpk(st[tt][8 * ks + 6], st[tt][8 * ks + 7]);
                        const bf16x8 pf = __builtin_bit_cast(bf16x8, pw);
#pragma unroll
                        for (int blk = 0; blk < 2; ++blk) {
                            const LAS unsigned char* vp = Vs + (32 * blk + r32) * AV_STRIDE + (32 * (j + tt) + 16 * ks + 4 * hi) * 2;
                            const u32x2 lo = *(const LAS u32x2*)vp, hh = *(const LAS u32x2*)(vp + 16);
                            const bf16x8 vf = __builtin_bit_cast(bf16x8, (u32x4){lo.x, lo.y, hh.x, hh.y});
                            ot[blk] = __builtin_amdgcn_mfma_f32_32x32x16_bf16(vf, pf, ot[blk], 0, 0, 0);
                        }
                    }
                }
            }
#pragma unroll
            for (int blk = 0; blk < 2; ++blk)
#pragma unroll
                for (int rq = 0; rq < 4; ++rq) {
                    const int d = 32 * blk + 8 * rq + 4 * hi;
                    const u32x2 z = *(const u32x2*)(QKVZ + row * ATTN_IN + 1280 + hq * 64 + d);
                    const float o0 = ot[blk][4 * rq + 0] * inv * bf_lo(z.x), o1 = ot[blk][4 * rq + 1] * inv * bf_hi(z.x);
                    const float o2 = ot[blk][4 * rq + 2] * inv * bf_lo(z.y), o3 = ot[blk][4 * rq + 3] * inv * bf_hi(z.y);
                    *(u32x2*)(G0 + row * DM + hq * 64 + d) = (u32x2){cvtpk(o0, o1), cvtpk(o2, o3)};
                }
        }
        __syncthreads();
    }
}

constexpr int RC = 32, RQ_STRIDE = 272, R_OSTRIDE = 528;
constexpr int R_QD = 0, R_QR = R_QD + RC * RQ_STRIDE, R_KR = R_QR + RC * RQ_STRIDE, R_KD = R_KR + RC * RQ_STRIDE, R_V = R_KD + RC * RQ_STRIDE, R_PS = R_V + RC * RQ_STRIDE,
              R_DEC = R_PS + 8 * 128 * 4, R_O = R_DEC + 512, R_END = R_O + RC * R_OSTRIDE;
#define LDS_BAR() do { asm volatile("s_waitcnt lgkmcnt(0)" ::: "memory"); __builtin_amdgcn_s_barrier(); asm volatile("" ::: "memory"); } while (0)
typedef short v4i16_t __attribute__((ext_vector_type(4)));
__device__ __forceinline__ u32x2 tr4(const LAS unsigned char* p) { return __builtin_bit_cast(u32x2, __builtin_amdgcn_ds_read_tr16_b64_v4i16((LAS v4i16_t*)p)); }
__device__ __forceinline__ bf16x8 tr8(const LAS unsigned char* p0, const LAS unsigned char* p1) { const u32x2 a = tr4(p0), b = tr4(p1); return __builtin_bit_cast(bf16x8, (u32x4){a.x, a.y, b.x, b.y}); }
struct RecRegs { unsigned q[4], g[4], v[4]; u32x4 z; };
__device__ __forceinline__ void rec_load(RecRegs& R, const bf16_t* REC, size_t crow, int wid, int lane, int tid) {
#pragma unroll
    for (int i = 0; i < 4; ++i) {
        const bf16_t* rp = REC + (crow + 4 * wid + i) * 512 + 2 * lane;
        R.q[i] = *(const unsigned*)(rp); R.g[i] = *(const unsigned*)(rp + 128); R.v[i] = *(const unsigned*)(rp + 256);
    }
}
__device__ __forceinline__ void rec_load_z(RecRegs& R, const bf16_t* REC, size_t crow, int tid) {
    R.z = *(const u32x4*)(REC + (crow + (tid >> 4)) * 512 + 384 + 8 * (tid & 15));
}
__device__ __forceinline__ void rec_finalize(LAS unsigned char* lds, const u32x4& z, const f32x4& gw0, const f32x4& gw1, bf16_t* G1row, int tid) {
    const LAS unsigned char* op = lds + R_O + (tid >> 4) * R_OSTRIDE + (tid & 15) * 32;
    const f32x4 a = *(const LAS f32x4*)op, b = *(const LAS f32x4*)(op + 16);
    float ss = (a[0] * a[0] + a[1] * a[1]) + (a[2] * a[2] + a[3] * a[3]) + (b[0] * b[0] + b[1] * b[1]) + (b[2] * b[2] + b[3] * b[3]);
#pragma unroll
    for (int o = 1; o < 16; o <<= 1) ss += __shfl_xor(ss, o);
    const float rs = rsqrtf(ss * (1.0f / 128.0f) + NORM_EPS);
    const f32x4 x = a * rs * gw0, y = b * rs * gw1;
    u32x4 w;
    w.x = cvtpk(x[0] * bf_lo(z.x), x[1] * bf_hi(z.x)); w.y = cvtpk(x[2] * bf_lo(z.y), x[3] * bf_hi(z.y));
    w.z = cvtpk(y[0] * bf_lo(z.z), y[1] * bf_hi(z.z)); w.w = cvtpk(y[2] * bf_lo(z.w), y[3] * bf_hi(z.w));
    *(u32x4*)G1row = w;
}
__device__ __forceinline__ void rec_chunk(LAS unsigned char* lds, const bf16_t* REC, size_t hrow, bf16_t* G1t, int c, RecRegs& cur, RecRegs& P, f32x4 (&S)[8],
                                          const f32x4& gw0, const f32x4& gw1, int tid, int lane, int wid, int c16, int quad) {
    constexpr int NC = SEQ / RC;
    const int cn = (c + 2 < NC) ? c + 2 : NC - 1;
    const int tr_row = (c16 >> 2), tr_col = 4 * (c16 & 3);
    rec_load(P, REC, hrow + (size_t)cn * RC, wid, lane, tid);
    float g0[4], g1[4], c0 = 0.f, c1 = 0.f, cs0[4], cs1[4];
#pragma unroll
    for (int i = 0; i < 4; ++i) { g0[i] = h_lo(cur.g[i]); g1[i] = h_hi(cur.g[i]); c0 += g0[i]; c1 += g1[i]; cs0[i] = c0; cs1[i] = c1; }
    *(LAS f32x2_t*)(lds + R_PS + (wid * 128 + 2 * lane) * 4) = (f32x2_t){c0, c1};
    LDS_BAR();
    if (c > 0) rec_finalize(lds, P.z, gw0, gw1, G1t + (size_t)(c - 1) * RC * DM, tid);
    rec_load_z(P, REC, hrow + (size_t)cn * RC, tid);
    float pre0 = 0.f, pre1 = 0.f, ref0 = 0.f, ref1 = 0.f, tot0 = 0.f, tot1 = 0.f;
#pragma unroll
    for (int p = 0; p < 8; ++p) {
        const f32x2_t s = *(const LAS f32x2_t*)(lds + R_PS + (p * 128 + 2 * lane) * 4);
        if (p < wid) { pre0 += s.x; pre1 += s.y; }
        if (p < 4) { ref0 += s.x; ref1 += s.y; }
        tot0 += s.x; tot1 += s.y;
    }
    const float er0 = __builtin_amdgcn_exp2f(ref0), er1 = __builtin_amdgcn_exp2f(ref1);
    const float et0 = __builtin_amdgcn_exp2f(tot0 - ref0), et1 = __builtin_amdgcn_exp2f(tot1 - ref1);
    pre0 -= ref0; pre1 -= ref1;
#pragma unroll
    for (int i = 0; i < 4; ++i) {
        const int t = 4 * wid + i;
        const float d0 = pre0 + cs0[i], d1 = pre1 + cs1[i];
        const float qr0 = bf_lo(cur.q[i]) * __builtin_amdgcn_exp2f(fminf(d0, 100.f)), qr1 = bf_hi(cur.q[i]) * __builtin_amdgcn_exp2f(fminf(d1, 100.f));
        const float kr0 = (1.0f - __builtin_amdgcn_exp2f(g0[i])) * __builtin_amdgcn_exp2f(fminf(-d0, 100.f)), kr1 = (1.0f - __builtin_amdgcn_exp2f(g1[i])) * __builtin_amdgcn_exp2f(fminf(-d1, 100.f));
        *(LAS unsigned*)(lds + R_QR + t * RQ_STRIDE + lane * 4) = cvtpk(qr0, qr1);
        *(LAS unsigned*)(lds + R_KR + t * RQ_STRIDE + lane * 4) = cvtpk(kr0, kr1);
        *(LAS unsigned*)(lds + R_QD + t * RQ_STRIDE + lane * 4) = cvtpk(qr0 * er0, qr1 * er1);
        *(LAS unsigned*)(lds + R_KD + t * RQ_STRIDE + lane * 4) = cvtpk(kr0 * et0, kr1 * et1);
        *(LAS unsigned*)(lds + R_V + t * RQ_STRIDE + lane * 4) = cur.v[i];
    }
    if (wid == 0) *(LAS f32x2_t*)(lds + R_DEC + 2 * lane * 4) = (f32x2_t){__builtin_amdgcn_exp2f(tot0), __builtin_amdgcn_exp2f(tot1)};
    LDS_BAR();
    f32x4 s00 = (f32x4){0.f, 0.f, 0.f, 0.f}, s01 = s00, s11 = s00;
#pragma unroll
    for (int kk = 0; kk < 4; ++kk) {
        const bf16x8 ka0 = *(const LAS bf16x8*)(lds + R_KR + (c16) * RQ_STRIDE + kk * 64 + quad * 16);
        const bf16x8 ka1 = *(const LAS bf16x8*)(lds + R_KR + (16 + c16) * RQ_STRIDE + kk * 64 + quad * 16);
        const bf16x8 qb0 = *(const LAS bf16x8*)(lds + R_QR + (c16) * RQ_STRIDE + kk * 64 + quad * 16);
        const bf16x8 qb1 = *(const LAS bf16x8*)(lds + R_QR + (16 + c16) * RQ_STRIDE + kk * 64 + quad * 16);
        s00 = __builtin_amdgcn_mfma_f32_16x16x32_bf16(ka0, qb0, s00, 0, 0, 0);
        s01 = __builtin_amdgcn_mfma_f32_16x16x32_bf16(ka0, qb1, s01, 0, 0, 0);
        s11 = __builtin_amdgcn_mfma_f32_16x16x32_bf16(ka1, qb1, s11, 0, 0, 0);
    }
#pragma unroll
    for (int r = 0; r < 4; ++r) { if (4 * quad + r > c16) { s00[r] = 0.f; s11[r] = 0.f; } }
    u32x4 pw0, pw1;
    pw0.x = cvtpk(s00[0], s00[1]); pw0.y = cvtpk(s00[2], s00[3]); pw0.z = 0u; pw0.w = 0u;
    pw1.x = cvtpk(s01[0], s01[1]); pw1.y = cvtpk(s01[2], s01[3]); pw1.z = cvtpk(s11[0], s11[1]); pw1.w = cvtpk(s11[2], s11[3]);
    f32x4 o0 = (f32x4){0.f, 0.f, 0.f, 0.f}, o1 = o0;
#pragma unroll
    for (int jj = 0; jj < 4; ++jj) {
        u32x4 sw; sw.x = cvtpk(S[2 * jj][0], S[2 * jj][1]); sw.y = cvtpk(S[2 * jj][2], S[2 * jj][3]); sw.z = cvtpk(S[2 * jj + 1][0], S[2 * jj + 1][1]); sw.w = cvtpk(S[2 * jj + 1][2], S[2 * jj + 1][3]);
        const bf16x8 sb = __builtin_bit_cast(bf16x8, sw);
        const LAS unsigned char* qp0 = lds + R_QD + (c16) * RQ_STRIDE + (32 * jj + 4 * quad) * 2;
        const LAS unsigned char* qp1 = lds + R_QD + (16 + c16) * RQ_STRIDE + (32 * jj + 4 * quad) * 2;
        const u32x2 a0 = *(const LAS u32x2*)qp0, a1 = *(const LAS u32x2*)(qp0 + 32), a2 = *(const LAS u32x2*)qp1, a3 = *(const LAS u32x2*)(qp1 + 32);
        o0 = __builtin_amdgcn_mfma_f32_16x16x32_bf16(__builtin_bit_cast(bf16x8, (u32x4){a0.x, a0.y, a1.x, a1.y}), sb, o0, 0, 0, 0);
        o1 = __builtin_amdgcn_mfma_f32_16x16x32_bf16(__builtin_bit_cast(bf16x8, (u32x4){a2.x, a2.y, a3.x, a3.y}), sb, o1, 0, 0, 0);
    }
    {
        const LAS unsigned char* vp = lds + R_V + (4 * quad + tr_row) * RQ_STRIDE + (16 * wid + tr_col) * 2;
        const bf16x8 vb = tr8(vp, vp + 16 * RQ_STRIDE);
        o0 = __builtin_amdgcn_mfma_f32_16x16x32_bf16(__builtin_bit_cast(bf16x8, pw0), vb, o0, 0, 0, 0);
        o1 = __builtin_amdgcn_mfma_f32_16x16x32_bf16(__builtin_bit_cast(bf16x8, pw1), vb, o1, 0, 0, 0);
    }
#pragma unroll
    for (int r = 0; r < 4; ++r) {
        *(LAS float*)(lds + R_O + (4 * quad + r) * R_OSTRIDE + (16 * wid + c16) * 4) = o0[r];
        *(LAS float*)(lds + R_O + (16 + 4 * quad + r) * R_OSTRIDE + (16 * wid + c16) * 4) = o1[r];
    }
    {
        const LAS unsigned char* vp = lds + R_V + (8 * quad + tr_row) * RQ_STRIDE + (16 * wid + tr_col) * 2;
        const bf16x8 vb = tr8(vp, vp + 4 * RQ_STRIDE);
        const LAS unsigned char* kp = lds + R_KD + (8 * quad + tr_row) * RQ_STRIDE + tr_col * 2;
#pragma unroll
        for (int kt = 0; kt < 8; ++kt) {
            const f32x4 dv = *(const LAS f32x4*)(lds + R_DEC + (16 * kt + 4 * quad) * 4);
            const bf16x8 ka = tr8(kp + kt * 32, kp + kt * 32 + 4 * RQ_STRIDE);
            S[kt] = __builtin_amdgcn_mfma_f32_16x16x32_bf16(ka, vb, S[kt] * dv, 0, 0, 0);
        }
    }
}
__device__ __forceinline__ void p_recurrence(LAS unsigned char* lds, const bf16_t* REC, const float* gnw, bf16_t* G1, int G) {
    const int tid = threadIdx.x, lane = tid & 63, wid = __builtin_amdgcn_readfirstlane(tid >> 6), c16 = lane & 15, quad = lane >> 4;
    constexpr int NC = SEQ / RC;
    static_assert(NC % 3 == 1, "chunk loop is unrolled by 3 with one tail chunk");
    for (int u = blockIdx.x; u < NB * 8; u += G) {
        const int b = u >> 3, h = u & 7;
        const size_t hrow = (size_t)u * SEQ;
        const f32x4 gw0 = *(const f32x4*)(gnw + 8 * (tid & 15)), gw1 = *(const f32x4*)(gnw + 8 * (tid & 15) + 4);
        bf16_t* G1t = G1 + ((size_t)b * SEQ + (tid >> 4)) * DM + h * 128 + 8 * (tid & 15);
        f32x4 S[8];
#pragma unroll
        for (int kt = 0; kt < 8; ++kt) S[kt] = (f32x4){0.f, 0.f, 0.f, 0.f};
        RecRegs A, B, C;
        rec_load(A, REC, hrow, wid, lane, tid); rec_load_z(A, REC, hrow, tid);
        rec_load(B, REC, hrow + RC, wid, lane, tid); rec_load_z(B, REC, hrow + RC, tid);
        C.z = (u32x4){0u, 0u, 0u, 0u};
        for (int c = 0; c < NC - 1; c += 3) {
            rec_chunk(lds, REC, hrow, G1t, c, A, C, S, gw0, gw1, tid, lane, wid, c16, quad);
            rec_chunk(lds, REC, hrow, G1t, c + 1, B, A, S, gw0, gw1, tid, lane, wid, c16, quad);
            rec_chunk(lds, REC, hrow, G1t, c + 2, C, B, S, gw0, gw1, tid, lane, wid, c16, quad);
        }
        rec_chunk(lds, REC, hrow, G1t, NC - 1, A, C, S, gw0, gw1, tid, lane, wid, c16, quad);
        LDS_BAR();
        rec_finalize(lds, A.z, gw0, gw1, G1t + (size_t)(NC - 1) * RC * DM, tid);
        LDS_BAR();
    }
}

#define XB_TMO      128
#define XB_XCNT(j)  (256  + 64 * (j))
#define XB_XSUB(j)  (1280 + 64 * (j))
#define XB_XGEN(j)  (2304 + 64 * (j))
#define XB_TOP      3328
#define XB_TOPGEN   3392
#define XCD_BAR_WORDS 3456
#define XB_SPIN_CAP (1u << 18)
__device__ __forceinline__ unsigned xb_ld(unsigned* p)              { return __hip_atomic_load(p, __ATOMIC_RELAXED, __HIP_MEMORY_SCOPE_AGENT); }
__device__ __forceinline__ unsigned xb_add(unsigned* p, unsigned v) { return __hip_atomic_fetch_add(p, v, __ATOMIC_RELAXED, __HIP_MEMORY_SCOPE_AGENT); }
__device__ __forceinline__ unsigned xb_xcc_id() { return (unsigned)__builtin_amdgcn_s_getreg((3 << 11) | 20) & 0xFu; }
#define XB_SPIN(cond, bar) do { unsigned _sp = 0; while (cond) { __builtin_amdgcn_s_sleep(1); \
    if ((++_sp & 255u) == 0u) { if (xb_ld(&(bar)[XB_TMO])) break; if (_sp > XB_SPIN_CAP) { atomicAdd(&(bar)[XB_TMO], 1u); break; } } } } while (0)
struct XcdBarrier { unsigned* bar; unsigned x; volatile LAS unsigned* st; };
__device__ __forceinline__ XcdBarrier xcd_barrier_post(unsigned* bar, volatile LAS unsigned* st) {
    XcdBarrier b; b.bar = bar; b.x = xb_xcc_id(); b.st = st;
    if (threadIdx.x == 0) (void)xb_add(&bar[XB_XCNT(b.x)], 1u);
    return b;
}
__device__ __forceinline__ void xcd_barrier_complete(unsigned* bar, unsigned x, unsigned& nloc, unsigned& nx) {
    const unsigned G = gridDim.x * gridDim.y * gridDim.z;
    unsigned sum, cnt, mine, sp = 0u;
    for (;;) {
        sum = 0u; cnt = 0u; mine = 0u;
#pragma unroll
        for (unsigned j = 0; j < 16; ++j) { const unsigned c = xb_ld(&bar[XB_XCNT(j)]); sum += c; cnt += (c > 0u) ? 1u : 0u; mine = (j == x) ? c : mine; }
        if (sum == G) break;
        __builtin_amdgcn_s_sleep(1);
        if ((++sp & 255u) == 0u) { if (xb_ld(&bar[XB_TMO])) break; if (sp > XB_SPIN_CAP) { atomicAdd(&bar[XB_TMO], 1u); break; } }
    }
    nloc = mine > 0u ? mine : 1u; nx = cnt > 0u ? cnt : 1u;
}
__device__ __forceinline__ void xcd_barrier(const XcdBarrier& b) {
    asm volatile("s_waitcnt vmcnt(0)" ::: "memory");
    __syncthreads();
    if (threadIdx.x == 0) {
        unsigned* bar = b.bar;
        __builtin_amdgcn_s_waitcnt(0);
        unsigned nloc = b.st[0], nx = b.st[1];
        if (nloc == 0u) { xcd_barrier_complete(bar, b.x, nloc, nx); b.st[0] = nloc; b.st[1] = nx; }
        const unsigned old = xb_add(&bar[XB_XSUB(b.x)], 1u);
        const unsigned gen = old / nloc;
        if (old + 1u == (gen + 1u) * nloc) {
            __builtin_amdgcn_fence(__ATOMIC_RELEASE, "agent");
            asm volatile("s_waitcnt vmcnt(0)" ::: "memory");
            const unsigned og = xb_add(&bar[XB_TOP], 1u);
            const unsigned tg = og / nx;
            if (og + 1u == (tg + 1u) * nx) xb_add(&bar[XB_TOPGEN], 1u);
            else XB_SPIN(xb_ld(&bar[XB_TOPGEN]) == tg, bar);
            __builtin_amdgcn_fence(__ATOMIC_ACQUIRE, "agent");
            xb_add(&bar[XB_XGEN(b.x)], 1u);
            asm volatile("s_waitcnt vmcnt(0)" ::: "memory");
        } else {
            XB_SPIN(xb_ld(&bar[XB_XGEN(b.x)]) == gen, bar);
            __builtin_amdgcn_fence(__ATOMIC_ACQUIRE, "agent");
            asm volatile("s_waitcnt vmcnt(0)" ::: "memory");
        }
    }
    __syncthreads();
}

constexpr int MISC_OFF = 131072 + 320;
constexpr int LDS_BYTES = 147456;
static_assert(pg8::STAGE_BYTES <= LDS_BYTES && AK_BYTES + AV_BYTES <= LDS_BYTES && R_END <= LDS_BYTES, "LDS map");
constexpr int N_PHASES = 9;
#define PROBE_LO -1
#define PROBE_HI 6

__global__ void __launch_bounds__(512, 2) hybrid_fwd(Args a) {
    extern __shared__ __attribute__((aligned(16))) unsigned char lds_raw[];
    LAS unsigned char* lds = (LAS unsigned char*)lds_raw;
    cg::grid_group grid = cg::this_grid();
    const int G = gridDim.x;
    const int lo = a.ph_lo, hi = a.ph_hi;
    unsigned char* ws = a.ws;
#define IN(k) (lo <= (k) && (k) < hi)
#define SEAM(k) do { if (IN(k) && IN((k) + 1)) xcd_barrier(xbar); } while (0)
    unsigned* barw = (unsigned*)(ws + WS_BAR);
    volatile LAS unsigned* misc = (volatile LAS unsigned*)(lds + MISC_OFF);
    if (blockIdx.x == 0) for (int i = threadIdx.x; i < XCD_BAR_WORDS; i += 512) __hip_atomic_store(barw + i, 0u, __ATOMIC_RELAXED, __HIP_MEMORY_SCOPE_AGENT);
    if (threadIdx.x < 2) misc[threadIdx.x] = 0u;
    __syncthreads();
    if (IN(0)) { p_prologue(a, lds, G); __syncthreads(); }
    grid.sync();
    XcdBarrier xbar = xcd_barrier_post(barw, misc);
    if (IN(1)) {
        pg8::Gemm g{(const bf16_t*)(ws + WS_H), (const bf16_t*)(ws + WS_WIN0), MTOK, ATTN_IN, DM}; pg8::StaticOrder S; S.init(MTOK, ATTN_IN, G, (int)blockIdx.x);
        pg8::EpiAttnIn E{(bf16_t*)(ws + WS_QKVZ), (bf16_t*)(ws + WS_VT), a.a_bin, (const float*)(ws + WS_ROPE)};
        pg8::gemm_phase<pg8::EpiAttnIn, true, true>(lds, g, S, E);
    }
    SEAM(1);
    if (IN(2)) p_attention(lds, (const bf16_t*)(ws + WS_QKVZ), (const bf16_t*)(ws + WS_VT), a.a_sinks, (bf16_t*)(ws + WS_G0), G);
    SEAM(2);
    if (IN(3)) {
        pg8::Gemm g{(const bf16_t*)(ws + WS_G0), (const bf16_t*)(ws + WS_WOUT0), MTOK, DM, DM}; pg8::StaticOrder S; S.init(MTOK, DM, G, (int)blockIdx.x);
        pg8::EpiOut E{(bf16_t*)(ws + WS_Y), a.a_bout, (float*)(ws + WS_PART)};
        pg8::gemm_phase<pg8::EpiOut, true, true>(lds, g, S, E);
    }
    SEAM(3);
    if (IN(4)) p_residual<true>((const bf16_t*)(ws + WS_Y), (const float*)(ws + WS_PART), a.x, a.post_w, a.pre_w + DM, a.out, (bf16_t*)(ws + WS_H), G);
    SEAM(4);
    if (IN(5)) {
        pg8::Gemm g{(const bf16_t*)(ws + WS_H), (const bf16_t*)(ws + WS_WIN1), MTOK, REC_IN, DM}; pg8::StaticOrder S; S.init(MTOK, REC_IN, G, (int)blockIdx.x);
        pg8::EpiRecIn E{(bf16_t*)(ws + WS_BIG), (const float*)(ws + WS_LB)};
        pg8::gemm_phase<pg8::EpiRecIn, true, true>(lds, g, S, E);
    }
    SEAM(5);
    if (IN(6)) p_recurrence(lds, (const bf16_t*)(ws + WS_BIG), a.r_gw, (bf16_t*)(ws + WS_G1), G);
    SEAM(6);
    if (IN(7)) {
        pg8::Gemm g{(const bf16_t*)(ws + WS_G1), (const bf16_t*)(ws + WS_WOUT1), MTOK, DM, DM}; pg8::StaticOrder S; S.init(MTOK, DM, G, (int)blockIdx.x);
        pg8::EpiOut E{(bf16_t*)(ws + WS_Y), nullptr, (float*)(ws + WS_PART)};
        pg8::gemm_phase<pg8::EpiOut, true, true>(lds, g, S, E);
    }
    SEAM(7);
    if (IN(8)) p_residual<false>((const bf16_t*)(ws + WS_Y), (const float*)(ws + WS_PART), a.out, a.post_w + DM, nullptr, a.out, nullptr, G);
#undef IN
#undef SEAM
}

extern "C" void kernel_launch(void* const* d_in, const int* in_sizes, int n_in, void* d_out, int out_size, void* d_ws, size_t ws_size, hipStream_t stream) {
    static int grid = 0;
    if (grid == 0) {
        if (n_in != 13 || in_sizes[0] != MTOK * DM || out_size != MTOK * DM || ws_size < WS_END) { fprintf(stderr, "kernel_launch: unexpected shapes (n_in %d, ws %zu < %zu)\n", n_in, ws_size, (size_t)WS_END); grid = -1; return; }
        int dev = 0, cus = 0, per_cu = 0;
        hipGetDevice(&dev); hipDeviceGetAttribute(&cus, hipDeviceAttributeMultiprocessorCount, dev);
        if (hipFuncSetAttribute((const void*)hybrid_fwd, hipFuncAttributeMaxDynamicSharedMemorySize, LDS_BYTES) != hipSuccess) { fprintf(stderr, "kernel_launch: hipFuncSetAttribute failed\n"); grid = -1; return; }
        if (hipOccupancyMaxActiveBlocksPerMultiprocessor(&per_cu, (const void*)hybrid_fwd, 512, LDS_BYTES) != hipSuccess || per_cu < 1) { fprintf(stderr, "kernel_launch: occupancy query says %d\n", per_cu); per_cu = 1; }
        (void)hipGetLastError();
        grid = cus * 1;
    }
    if (grid < 0) return;
    Args a{};
    a.x = (const float*)d_in[0]; a.pos = (const int*)d_in[1]; a.pre_w = (const float*)d_in[2]; a.post_w = (const float*)d_in[3];
    a.a_win = (const float*)d_in[4]; a.a_bin = (const float*)d_in[5]; a.a_sinks = (const float*)d_in[6]; a.a_wout = (const float*)d_in[7]; a.a_bout = (const float*)d_in[8];
    a.r_win = (const float*)d_in[9]; a.r_lbl = (const float*)d_in[10]; a.r_gw = (const float*)d_in[11]; a.r_wout = (const float*)d_in[12];
    a.out = (float*)d_out; a.ws = (unsigned char*)d_ws;
    void* args[] = {&a};
#if PROBE_LO >= 0
    a.ph_lo = 0; a.ph_hi = PROBE_HI;
    (void)hipLaunchCooperativeKernel((const void*)hybrid_fwd, dim3(grid), dim3(512), args, LDS_BYTES, stream);
    a.ph_lo = PROBE_LO; a.ph_hi = N_PHASES;
#else
    a.ph_lo = 0; a.ph_hi = N_PHASES;
#endif
    hipError_t e = hipLaunchCooperativeKernel((const void*)hybrid_fwd, dim3(grid), dim3(512), args, LDS_BYTES, stream);
    if (e != hipSuccess) fprintf(stderr, "kernel_launch: cooperative launch failed: %s (grid %d)\n", hipGetErrorString(e), grid);
}
```

```cpp
#include <hip/hip_runtime.h>
#include <hip/hip_cooperative_groups.h>
#include <cstdio>
#include <cstdint>
namespace cg = cooperative_groups;

#define LAS __attribute__((address_space(3)))
typedef unsigned short bf16_t;
typedef short bf16x8 __attribute__((ext_vector_type(8)));
typedef float f32x4 __attribute__((ext_vector_type(4)));
typedef float f32x16 __attribute__((ext_vector_type(16)));
typedef unsigned u32x4 __attribute__((ext_vector_type(4)));
typedef unsigned u32x2 __attribute__((ext_vector_type(2)));
typedef float f32x2_t __attribute__((ext_vector_type(2)));
typedef __bf16 bf16x2_t __attribute__((ext_vector_type(2)));
typedef _Float16 f16x2_t __attribute__((ext_vector_type(2)));

constexpr int NB = 32, SEQ = 2048, DM = 1024, MTOK = NB * SEQ;
constexpr int ATTN_IN = 2304, REC_IN = 4096;
constexpr float NORM_EPS = 1e-6f;
constexpr float LOG2E = 1.4426950408889634f;
constexpr float QSCALE = 0.125f * 1.4426950408889634f;

constexpr size_t WS_WIN0 = 0;
constexpr size_t WS_WOUT0 = WS_WIN0 + (size_t)ATTN_IN * DM * 2;
constexpr size_t WS_WIN1 = WS_WOUT0 + (size_t)DM * DM * 2;
constexpr size_t WS_WOUT1 = WS_WIN1 + (size_t)REC_IN * DM * 2;
constexpr size_t WS_ROPE = WS_WOUT1 + (size_t)DM * DM * 2;
constexpr size_t WS_LB = WS_ROPE + (size_t)MTOK * 16 * 4;
constexpr size_t WS_BIASP = WS_LB + 4096;
constexpr size_t WS_BAR = WS_BIASP + 12288;
constexpr size_t WS_PART = WS_BAR + 16384;
constexpr size_t WS_H = WS_PART + (size_t)MTOK * 16 * 4;
constexpr size_t WS_Y = WS_H + (size_t)MTOK * DM * 2;
constexpr size_t WS_G1 = WS_Y + (size_t)MTOK * DM * 2;
constexpr size_t WS_BIG = WS_G1 + (size_t)MTOK * DM * 2;
constexpr size_t WS_QKVZ = WS_BIG;
constexpr size_t WS_G0 = WS_QKVZ + (size_t)MTOK * ATTN_IN * 2;
constexpr size_t WS_VT = WS_G0 + (size_t)MTOK * DM * 2;
constexpr size_t WS_END = WS_BIG + (size_t)MTOK * REC_IN * 2;
static_assert(WS_VT + (size_t)MTOK * 128 * 2 <= WS_END, "overlay");

__device__ __forceinline__ unsigned cvtpk(float lo, float hi) { f32x2_t v = {lo, hi}; bf16x2_t b = __builtin_convertvector(v, bf16x2_t); return __builtin_bit_cast(unsigned, b); }
__device__ __forceinline__ unsigned cvtpk_h(float lo, float hi) { f32x2_t v = {lo, hi}; f16x2_t b = __builtin_convertvector(v, f16x2_t); return __builtin_bit_cast(unsigned, b); }
__device__ __forceinline__ float bf_lo(unsigned u) { return __uint_as_float(u << 16); }
__device__ __forceinline__ float bf_hi(unsigned u) { return __uint_as_float(u & 0xffff0000u); }
__device__ __forceinline__ float h_lo(unsigned u) { f16x2_t h = __builtin_bit_cast(f16x2_t, u); return (float)h[0]; }
__device__ __forceinline__ float h_hi(unsigned u) { f16x2_t h = __builtin_bit_cast(f16x2_t, u); return (float)h[1]; }
__device__ __forceinline__ float silu_f(float v) { return v * __builtin_amdgcn_rcpf(1.0f + __expf(-v)); }
__device__ __forceinline__ float wave_sum(float v) {
#pragma unroll
    for (int o = 1; o < 64; o <<= 1) v += __shfl_xor(v, o);
    return v;
}

__host__ __device__ __forceinline__ int rope_src_col(int c) { return (c < 1152 && (c & 63) < 16) ? ((c & ~15) | (((c & 15) >> 1) + 8 * (c & 1))) : c; }

namespace pg8 {
constexpr int BM = 256, BK = 64, HALF = 128, HTB = HALF * BK * 2, STAGE_BYTES = 8 * HTB, NXCD = 8, WGM = 8;
__host__ __device__ __forceinline__ int lds_byte(int r, int c) { const int st = (r >> 4) * 2 + (c >> 5), rr = r & 15, cc = c & 31, ob = rr * 64 + cc * 2; return st * 1024 + (ob ^ (((ob >> 9) & 1) << 5)); }
__host__ __device__ __forceinline__ void stage_rc(int b, int& R, int& C) { const int st = b / 1024, sb = b % 1024, swz = sb ^ (((sb >> 9) & 1) << 5); R = (st >> 1) * 16 + swz / 64; C = (st & 1) * 32 + (swz % 64) / 2; }
__host__ __device__ __forceinline__ int perm32(int rho) { const int n = rho >> 4, i = rho & 15; return 8 * (i >> 2) + 4 * n + (i & 3); }

struct Unit { int pm, pn; };
struct Gemm { const bf16_t* A; const bf16_t* Bt; int M, N, K; };

struct StaticOrder {
    int nM, nN, nwg, G, c;
    __host__ __device__ void init(int M, int N, int G_, int c_) { nM = M / BM; nN = N / BM; nwg = nM * nN; G = G_; c = c_; }
    __host__ __device__ bool next(int i, Unit& u) const {
        const long L = (long)i * G + c; if (L >= nwg) return false;
        int wgid = (int)L; { const int q = nwg / NXCD, r = nwg % NXCD, xcd = wgid % NXCD, off = wgid / NXCD; wgid = (xcd < r ? xcd * (q + 1) : r * (q + 1) + (xcd - r) * q) + off; }
        const int nig = WGM * nN, gid = wgid / nig, fm = gid * WGM, gsz = (nM - fm) < WGM ? (nM - fm) : WGM;
        u.pm = fm + ((wgid % nig) % gsz); u.pn = (wgid % nig) / gsz; return true;
    }
};

template <class Epi, bool ALIGN_EPI, bool SP2>
__device__ __forceinline__ void gemm_phase(LAS unsigned char* lds, const Gemm g, const StaticOrder& S, const Epi& E) {
    const int tid = threadIdx.x, wid = __builtin_amdgcn_readfirstlane(tid >> 6), lane = tid & 63, wr = wid >> 2, wc = wid & 3, fr = lane & 15, fq = lane >> 4;
    const int K = g.K, nt = K / BK;
    unsigned voffA[2], voffB[2];
#pragma unroll
    for (int i = 0; i < 2; ++i) { int R, C; stage_rc(tid * 16 + i * 8192, R, C); const int Rb = Epi::PERM ? ((R & ~31) + perm32(R & 31)) : R;
        voffA[i] = (unsigned)(R * K + C) * 2u; voffB[i] = (unsigned)(Rb * K + C) * 2u; }
    const size_t kstep = (size_t)(BK * 2);
    const size_t hstep = (size_t)HALF * K * 2;
    const size_t tstep = 2 * hstep;
    const unsigned ldsw = (unsigned)wid * 1024u;
    const int aoff = lds_byte(wr * 64 + fr, fq * 8), boff = lds_byte(wc * 32 + fr, fq * 8);
#define PG8_SA(b, h) (((b) * 2 + (h)) * HTB)
#define PG8_SB(b, h) ((4 + (b) * 2 + (h)) * HTB)
#define PG8_STAGE(bufoff, gbase, voff) do { _Pragma("unroll") for (int _i = 0; _i < 2; ++_i) \
        __builtin_amdgcn_global_load_lds((const unsigned*)((const char*)(gbase) + (voff)[_i]), (LAS unsigned*)(lds + (bufoff) + ldsw + _i * 8192), 16, 0, 0); } while (0)
#define PG8_LDA(dst, b, h) do { _Pragma("unroll") for (int m = 0; m < 4; ++m) _Pragma("unroll") for (int k = 0; k < 2; ++k) dst[m][k] = *(const LAS bf16x8*)(lds + PG8_SA(b, h) + aoff + m * 2048 + k * 1024); } while (0)
#define PG8_LDB(dst, b, h) do { _Pragma("unroll") for (int n = 0; n < 2; ++n) _Pragma("unroll") for (int k = 0; k < 2; ++k) dst[n][k] = *(const LAS bf16x8*)(lds + PG8_SB(b, h) + boff + n * 2048 + k * 1024); } while (0)
#define PG8_MMA(ai, bj, Af, Bf) do { __builtin_amdgcn_s_setprio(1); _Pragma("unroll") for (int m = 0; m < 4; ++m) _Pragma("unroll") for (int n = 0; n < 2; ++n) _Pragma("unroll") for (int k = 0; k < 2; ++k) \
        acc[ai][bj][m][n] = __builtin_amdgcn_mfma_f32_16x16x32_bf16(Bf[n][k], Af[m][k], acc[ai][bj][m][n], 0, 0, 0); __builtin_amdgcn_s_setprio(0); } while (0)
#define PG8_WAIT_V(n) asm volatile("s_waitcnt vmcnt(" #n ")" ::: "memory")
#define PG8_WAIT_L(n) asm volatile("s_waitcnt lgkmcnt(" #n ")" ::: "memory")
#define PG8_BAR __builtin_amdgcn_s_barrier()
#define PG8_SCHED __builtin_amdgcn_sched_barrier(0)
    Unit cur, nxt; int ui = 0;
    if (!S.next(0, cur)) return;
    f32x4 acc[2][2][4][2];
#pragma unroll
    for (int a = 0; a < 2; ++a)
#pragma unroll
        for (int b = 0; b < 2; ++b)
#pragma unroll
            for (int m = 0; m < 4; ++m)
#pragma unroll
                for (int n = 0; n < 2; ++n) acc[a][b][m][n] = (f32x4){0.f, 0.f, 0.f, 0.f};
    bf16x8 At[4][2], B0[2][2], B1[2][2];
    const char* cA = (const char*)g.A + (size_t)cur.pm * tstep; const char* cB = (const char*)g.Bt + (size_t)cur.pn * tstep;
    if constexpr (SP2) {
        PG8_STAGE(PG8_SB(0, 0), cB, voffB); PG8_STAGE(PG8_SB(0, 1), cB + hstep, voffB); PG8_STAGE(PG8_SA(0, 0), cA, voffA); PG8_STAGE(PG8_SA(0, 1), cA + hstep, voffA);
        if (wr == 1) PG8_BAR;
        PG8_WAIT_V(2); PG8_BAR;
        PG8_STAGE(PG8_SB(1, 0), cB + kstep, voffB); PG8_STAGE(PG8_SA(1, 0), cA + kstep, voffA); PG8_STAGE(PG8_SB(1, 1), cB + hstep + kstep, voffB);
        PG8_WAIT_V(6); PG8_BAR;
    } else {
        PG8_STAGE(PG8_SB(0, 0), cB, voffB); PG8_STAGE(PG8_SA(0, 0), cA, voffA); PG8_STAGE(PG8_SB(0, 1), cB + hstep, voffB); PG8_STAGE(PG8_SA(0, 1), cA + hstep, voffA);
        if (wr == 1) PG8_BAR;
        PG8_WAIT_V(4); PG8_BAR;
        PG8_STAGE(PG8_SB(1, 0), cB + kstep, voffB); PG8_STAGE(PG8_SA(1, 0), cA + kstep, voffA); PG8_STAGE(PG8_SB(1, 1), cB + hstep + kstep, voffB);
        PG8_WAIT_V(6); PG8_BAR;
    }
    for (;;) {
        const bool has_next = S.next(ui + 1, nxt);
        const char* nA = has_next ? (const char*)g.A + (size_t)nxt.pm * tstep : cA; const char* nB = has_next ? (const char*)g.Bt + (size_t)nxt.pn * tstep : cB;
        for (int t = 0; t < nt; t += 2) {
            const bool last = (t == nt - 2);
            const char* a1 = cA + (size_t)(t + 1) * kstep;
            const char* a2 = last ? nA : cA + (size_t)(t + 2) * kstep; const char* b2 = last ? nB : cB + (size_t)(t + 2) * kstep;
            const char* a3 = a2 + kstep; const char* b3 = b2 + kstep;
            if constexpr (SP2) {
            PG8_LDB(B0, 0, 0); PG8_LDB(B1, 0, 1); PG8_SCHED; PG8_LDA(At, 0, 0); PG8_STAGE(PG8_SA(1, 1), a1 + hstep, voffA);
            PG8_WAIT_V(8); PG8_WAIT_L(0); PG8_BAR; PG8_MMA(0, 0, At, B0); PG8_MMA(0, 1, At, B1); PG8_BAR; PG8_SCHED;
            PG8_LDA(At, 0, 1); PG8_STAGE(PG8_SB(0, 0), b2, voffB); PG8_STAGE(PG8_SB(0, 1), b2 + hstep, voffB); PG8_STAGE(PG8_SA(0, 0), a2, voffA);
            PG8_WAIT_V(8); PG8_WAIT_L(0); PG8_BAR; PG8_MMA(1, 0, At, B0); PG8_MMA(1, 1, At, B1); PG8_BAR; PG8_SCHED;
            PG8_LDB(B0, 1, 0); PG8_LDB(B1, 1, 1); PG8_SCHED; PG8_LDA(At, 1, 0); PG8_STAGE(PG8_SA(0, 1), a2 + hstep, voffA);
            PG8_WAIT_V(8); PG8_WAIT_L(0); PG8_BAR; PG8_MMA(0, 0, At, B0); PG8_MMA(0, 1, At, B1); PG8_BAR; PG8_SCHED;
            PG8_LDA(At, 1, 1); PG8_STAGE(PG8_SB(1, 0), b3, voffB); PG8_STAGE(PG8_SB(1, 1), b3 + hstep, voffB); PG8_STAGE(PG8_SA(1, 0), a3, voffA);
            PG8_WAIT_V(8); PG8_WAIT_L(0); PG8_BAR; PG8_MMA(1, 0, At, B0); PG8_MMA(1, 1, At, B1); PG8_BAR; PG8_SCHED;
            } else {
            PG8_LDB(B0, 0, 0); PG8_SCHED; PG8_LDA(At, 0, 0); PG8_STAGE(PG8_SA(1, 1), a1 + hstep, voffA);
            PG8_WAIT_L(8); PG8_BAR; PG8_WAIT_L(0); PG8_MMA(0, 0, At, B0); PG8_BAR; PG8_SCHED;
            PG8_LDB(B1, 0, 1); PG8_STAGE(PG8_SB(0, 0), b2, voffB);
            PG8_BAR; PG8_WAIT_L(0); PG8_MMA(0, 1, At, B1); PG8_BAR;
            PG8_LDA(At, 0, 1); PG8_STAGE(PG8_SA(0, 0), a2, voffA);
            PG8_BAR; PG8_WAIT_L(0); PG8_MMA(1, 0, At, B0); PG8_BAR; PG8_SCHED;
            PG8_STAGE(PG8_SB(0, 1), b2 + hstep, voffB);
            PG8_WAIT_V(6); PG8_BAR; PG8_MMA(1, 1, At, B1); PG8_BAR;
            PG8_LDB(B0, 1, 0); PG8_SCHED; PG8_LDA(At, 1, 0); PG8_STAGE(PG8_SA(0, 1), a2 + hstep, voffA);
            PG8_WAIT_L(8); PG8_BAR; PG8_WAIT_L(0); PG8_MMA(0, 0, At, B0); PG8_BAR; PG8_SCHED;
            PG8_LDB(B1, 1, 1); PG8_STAGE(PG8_SB(1, 0), b3, voffB);
            PG8_BAR; PG8_WAIT_L(0); PG8_MMA(0, 1, At, B1); PG8_BAR;
            PG8_LDA(At, 1, 1); PG8_STAGE(PG8_SA(1, 0), a3, voffA);
            PG8_BAR; PG8_WAIT_L(0); PG8_MMA(1, 0, At, B0); PG8_BAR; PG8_SCHED;
            PG8_STAGE(PG8_SB(1, 1), b3 + hstep, voffB);
            PG8_WAIT_V(6); PG8_BAR; PG8_MMA(1, 1, At, B1); PG8_BAR;
            }
        }
        if constexpr (ALIGN_EPI) { if (wr == 0) PG8_BAR; }
        E(acc, cur, wr, wc, fr, fq);
        if (!has_next) break;
#pragma unroll
        for (int a = 0; a < 2; ++a)
#pragma unroll
            for (int b = 0; b < 2; ++b)
#pragma unroll
                for (int m = 0; m < 4; ++m)
#pragma unroll
                    for (int n = 0; n < 2; ++n) acc[a][b][m][n] = (f32x4){0.f, 0.f, 0.f, 0.f};
        cur = nxt; cA = nA; cB = nB; ++ui;
        if constexpr (ALIGN_EPI) { if (wr == 1) PG8_BAR; }
    }
    PG8_WAIT_V(0);
    if constexpr (!ALIGN_EPI) { if (wr == 0) PG8_BAR; }
    PG8_BAR;
#undef PG8_SA
#undef PG8_SB
#undef PG8_STAGE
#undef PG8_LDA
#undef PG8_LDB
#undef PG8_MMA
#undef PG8_WAIT_V
#undef PG8_WAIT_L
#undef PG8_BAR
#undef PG8_SCHED
}

struct EpiAttnIn {
    static constexpr bool PERM = true;
    bf16_t* O; const float* bias; const unsigned* rope;
    __device__ __forceinline__ void operator()(const f32x4 (&acc)[2][2][4][2], const Unit& u, int wr, int wc, int fr, int fq) const {
        const int row0 = u.pm * BM + wr * 64 + fr;
        const int cb0 = u.pn * BM, cb1 = u.pn * BM + HALF;
        const int kind0 = cb0 < 1024 ? 0 : (cb0 < 1152 ? 1 : (cb0 < 1280 ? 2 : 3)), kind1 = cb1 < 1024 ? 0 : (cb1 < 1152 ? 1 : (cb1 < 1280 ? 2 : 3));
        const bool ropew = (kind0 <= 1) && ((wc & 1) == 0);
        f32x4 bv[2][2];
#pragma unroll
        for (int bj = 0; bj < 2; ++bj) { const int c0 = u.pn * BM + bj * HALF + wc * 32 + 8 * fq; bv[bj][0] = *(const f32x4*)(bias + c0); bv[bj][1] = *(const f32x4*)(bias + c0 + 4); }
#pragma unroll
        for (int ai = 0; ai < 2; ++ai)
#pragma unroll
            for (int m = 0; m < 4; ++m) {
                const int row = row0 + ai * HALF + m * 16;
                u32x4 cs = (u32x4){0u, 0u, 0u, 0u};
                if (ropew && fq < 2) cs = *(const u32x4*)(rope + (size_t)row * 8 + 4 * fq);
#pragma unroll
                for (int bj = 0; bj < 2; ++bj) {
                    const int kind = bj ? kind1 : kind0;
                    const int c0 = u.pn * BM + bj * HALF + wc * 32 + 8 * fq;
                    f32x4 v0 = acc[ai][bj][m][0] + bv[bj][0], v1 = acc[ai][bj][m][1] + bv[bj][1];
                    if (ropew && kind <= 1 && fq < 2) {
                        const float c0f = h_lo(cs.x), s0f = h_hi(cs.x), c1f = h_lo(cs.y), s1f = h_hi(cs.y), c2f = h_lo(cs.z), s2f = h_hi(cs.z), c3f = h_lo(cs.w), s3f = h_hi(cs.w);
                        const f32x4 t0 = v0, t1 = v1;
                        v0[0] = t0[0] * c0f - t0[1] * s0f; v0[1] = t0[1] * c0f + t0[0] * s0f; v0[2] = t0[2] * c1f - t0[3] * s1f; v0[3] = t0[3] * c1f + t0[2] * s1f;
                        v1[0] = t1[0] * c2f - t1[1] * s2f; v1[1] = t1[1] * c2f + t1[0] * s2f; v1[2] = t1[2] * c3f - t1[3] * s3f; v1[3] = t1[3] * c3f + t1[2] * s3f;
                    }
                    if (kind == 0) { v0 = v0 * QSCALE; v1 = v1 * QSCALE; }
                    if (kind == 3) {
#pragma unroll
                        for (int i = 0; i < 4; ++i) { v0[i] = silu_f(v0[i]); v1[i] = silu_f(v1[i]); }
                    }
                    u32x4 w; w.x = cvtpk(v0[0], v0[1]); w.y = cvtpk(v0[2], v0[3]); w.z = cvtpk(v1[0], v1[1]); w.w = cvtpk(v1[2], v1[3]);
                    *(u32x4*)(O + (size_t)row * ATTN_IN + c0) = w;
                }
            }
    }
};
template <bool NOSTORE> struct EpiRecInT {
    static constexpr bool PERM = true;
    bf16_t* O; const float* lb;
    __device__ __forceinline__ void operator()(const f32x4 (&acc)[2][2][4][2], const Unit& u, int wr, int wc, int fr, int fq) const {
        const int row0 = u.pm * BM + wr * 64 + fr;
        const int seg = u.pn >> 2;
#pragma unroll
        for (int bj = 0; bj < 2; ++bj) {
            const int c0 = u.pn * BM + bj * HALF + wc * 32 + 8 * fq;
            f32x4 l0 = (f32x4){0.f, 0.f, 0.f, 0.f}, l1 = l0;
            if (seg == 1) { l0 = *(const f32x4*)(lb + (c0 - 1024)); l1 = *(const f32x4*)(lb + (c0 - 1024) + 4); }
#pragma unroll
            for (int ai = 0; ai < 2; ++ai)
#pragma unroll
                for (int m = 0; m < 4; ++m) {
                    const int row = row0 + ai * HALF + m * 16;
                    f32x4 v0 = acc[ai][bj][m][0], v1 = acc[ai][bj][m][1];
                    u32x4 w;
                    if (seg == 1) {
#pragma unroll
                        for (int i = 0; i < 4; ++i) {
                            const float s0 = __builtin_amdgcn_rcpf(1.0f + __expf(-v0[i])), s1 = __builtin_amdgcn_rcpf(1.0f + __expf(-v1[i]));
                            v0[i] = __log2f(l0[i] + (1.0f - l0[i]) * s0); v1[i] = __log2f(l1[i] + (1.0f - l1[i]) * s1);
                        }
                        w.x = cvtpk_h(v0[0], v0[1]); w.y = cvtpk_h(v0[2], v0[3]); w.z = cvtpk_h(v1[0], v1[1]); w.w = cvtpk_h(v1[2], v1[3]);
                    } else {
                        if (seg != 2) {
#pragma unroll
                            for (int i = 0; i < 4; ++i) { v0[i] = silu_f(v0[i]); v1[i] = silu_f(v1[i]); }
                        }
                        w.x = cvtpk(v0[0], v0[1]); w.y = cvtpk(v0[2], v0[3]); w.z = cvtpk(v1[0], v1[1]); w.w = cvtpk(v1[2], v1[3]);
                    }
                    if (!NOSTORE || (w.x == 0x12345678u && w.y == 0x9abcdef0u))
                    *(u32x4*)(O + ((size_t)((row >> 11) * 8 + (u.pn & 3) * 2 + bj) * SEQ + (row & 2047)) * 512 + seg * 128 + wc * 32 + 8 * fq) = w;
                }
        }
    }
};
struct EpiOut {
    static constexpr bool PERM = true;
    bf16_t* O; const float* bias; float* part;
    __device__ __forceinline__ void operator()(const f32x4 (&acc)[2][2][4][2], const Unit& u, int wr, int wc, int fr, int fq) const {
        const int row0 = u.pm * BM + wr * 64 + fr;
        f32x4 bv[2][2];
#pragma unroll
        for (int bj = 0; bj < 2; ++bj) { const int c0 = u.pn * BM + bj * HALF + wc * 32 + 8 * fq;
            bv[bj][0] = bias ? *(const f32x4*)(bias + c0) : (f32x4){0.f, 0.f, 0.f, 0.f}; bv[bj][1] = bias ? *(const f32x4*)(bias + c0 + 4) : (f32x4){0.f, 0.f, 0.f, 0.f}; }
#pragma unroll
        for (int ai = 0; ai < 2; ++ai)
#pragma unroll
            for (int m = 0; m < 4; ++m) {
                const int row = row0 + ai * HALF + m * 16;
                float ss = 0.f;
#pragma unroll
                for (int bj = 0; bj < 2; ++bj) {
                    const int c0 = u.pn * BM + bj * HALF + wc * 32 + 8 * fq;
                    const f32x4 v0 = acc[ai][bj][m][0] + bv[bj][0], v1 = acc[ai][bj][m][1] + bv[bj][1];
                    ss += (v0[0] * v0[0] + v0[1] * v0[1]) + (v0[2] * v0[2] + v0[3] * v0[3]) + (v1[0] * v1[0] + v1[1] * v1[1]) + (v1[2] * v1[2] + v1[3] * v1[3]);
                    u32x4 w; w.x = cvtpk(v0[0], v0[1]); w.y = cvtpk(v0[2], v0[3]); w.z = cvtpk(v1[0], v1[1]); w.w = cvtpk(v1[2], v1[3]);
                    *(u32x4*)(O + (size_t)row * DM + c0) = w;
                }
                ss += __shfl_xor(ss, 16); ss += __shfl_xor(ss, 32);
                if (fq == 0) part[(size_t)row * 16 + u.pn * 4 + wc] = ss;
            }
    }
};
struct EpiNull {
    static constexpr bool PERM = true;
    float* sink;
    __device__ __forceinline__ void operator()(const f32x4 (&acc)[2][2][4][2], const Unit& u, int wr, int wc, int fr, int fq) const {
        f32x4 s = (f32x4){0.f, 0.f, 0.f, 0.f};
#pragma unroll
        for (int ai = 0; ai < 2; ++ai)
#pragma unroll
            for (int bj = 0; bj < 2; ++bj)
#pragma unroll
                for (int m = 0; m < 4; ++m) { s += acc[ai][bj][m][0]; s += acc[ai][bj][m][1]; }
        if (s[0] + s[1] + s[2] + s[3] == 123456.789f) sink[u.pm] = s[0];
    }
};
typedef EpiRecInT<false> EpiRecIn;
}

template <bool ROPE_PERM>
__device__ __forceinline__ void transpose_item(const float* W, int K, int N, bf16_t* WT, LAS float* scr, int item, int lane) {
    const int nblk = N / 32, kb = item / nblk, nb = item % nblk, k0 = 64 * kb, n0 = 32 * nb;
    const int ncol = ROPE_PERM ? rope_src_col(n0 + (lane & 31)) : n0 + (lane & 31);
#pragma unroll 8
    for (int i = 0; i < 32; ++i) { const int kk = 2 * i + (lane >> 5); scr[kk * 33 + (lane & 31)] = W[(size_t)(k0 + kk) * N + ncol]; }
    asm volatile("s_waitcnt lgkmcnt(0)" ::: "memory");
    const int c = lane & 7;
#pragma unroll
    for (int j = 0; j < 4; ++j) { const int n = (lane >> 3) + 8 * j; const LAS float* s = scr + (8 * c) * 33 + n;
        u32x4 o; o.x = cvtpk(s[0 * 33], s[1 * 33]); o.y = cvtpk(s[2 * 33], s[3 * 33]); o.z = cvtpk(s[4 * 33], s[5 * 33]); o.w = cvtpk(s[6 * 33], s[7 * 33]);
        *(u32x4*)(WT + (size_t)(n0 + n) * K + k0 + 8 * c) = o; }
    asm volatile("s_waitcnt lgkmcnt(0)" ::: "memory");
}

struct Args {
    const float* x; const int* pos; const float* pre_w; const float* post_w; const float* a_win; const float* a_bin; const float* a_sinks;
    const float* a_wout; const float* a_bout; const float* r_win; const float* r_lbl; const float* r_gw; const float* r_wout;
    float* out; unsigned char* ws; int ph_lo, ph_hi, flags, pad;
};

__device__ __forceinline__ void load_w16(const float* w, int lane, f32x4 (&r)[2][2]) {
#pragma unroll
    for (int j = 0; j < 2; ++j)
#pragma unroll
        for (int h = 0; h < 2; ++h) r[j][h] = *(const f32x4*)(w + 512 * j + 8 * lane + 4 * h);
}

__device__ __forceinline__ void p_prologue(const Args& a, LAS unsigned char* lds, int G) {
    const int tid = threadIdx.x, lane = tid & 63, wid = __builtin_amdgcn_readfirstlane(tid >> 6);
    LAS float* scr = (LAS float*)(lds + wid * 16384);
    const int gw = blockIdx.x * 8 + wid, NGW = G * 8;
    constexpr int I_A = (DM / 64) * (ATTN_IN / 32), I_O = (DM / 64) * (DM / 32), I_R = (DM / 64) * (REC_IN / 32);
    constexpr int NITEMS = I_A + I_O + I_R + I_O;
    for (int it = gw; it < NITEMS; it += NGW) {
        int r = it;
        if (r < I_A) { transpose_item<true>(a.a_win, DM, ATTN_IN, (bf16_t*)(a.ws + WS_WIN0), scr, r, lane); continue; } r -= I_A;
        if (r < I_O) { transpose_item<false>(a.a_wout, DM, DM, (bf16_t*)(a.ws + WS_WOUT0), scr, r, lane); continue; } r -= I_O;
        if (r < I_R) { transpose_item<false>(a.r_win, DM, REC_IN, (bf16_t*)(a.ws + WS_WIN1), scr, r, lane); continue; } r -= I_R;
        transpose_item<false>(a.r_wout, DM, DM, (bf16_t*)(a.ws + WS_WOUT1), scr, r, lane);
    }
    {
        unsigned* rope = (unsigned*)(a.ws + WS_ROPE);
        const int gt = blockIdx.x * 512 + tid, NGT = G * 512;
        for (int e = gt; e < MTOK * 8; e += NGT) {
            const int row = e >> 3, i = e & 7;
            const float invf = (i == 0) ? 1.0f : (i == 1) ? 0.19392274474868576f : (i == 2) ? 0.03760603093086393f : (i == 3) ? 0.007292664737217109f :
                               (i == 4) ? 0.001414213562373095f : (i == 5) ? 0.0002742481756762073f : (i == 6) ? 5.318295896944988e-05f : 1.031338537721246e-05f;
            const float ang = (float)a.pos[row] * invf;
            rope[e] = cvtpk_h(cosf(ang), sinf(ang));
        }
        float* biasp = (float*)(a.ws + WS_BIASP);
        for (int e = gt; e < ATTN_IN; e += NGT) biasp[e] = a.a_bin[rope_src_col(e)];
        float* lb = (float*)(a.ws + WS_LB);
        for (int e = gt; e < DM; e += NGT) { const float l0 = a.r_lbl[e], l1 = a.r_lbl[DM + e]; lb[e] = 1.0f / (1.0f + expf(l0 - l1)); }
    }
    {
        f32x4 wv[2][2]; load_w16(a.pre_w, lane, wv);
        bf16_t* H = (bf16_t*)(a.ws + WS_H);
        for (int row = gw; row < MTOK; row += NGW) {
            const float* xr = a.x + (size_t)row * DM;
            f32x4 xv[2][2]; float ss = 0.f;
#pragma unroll
            for (int j = 0; j < 2; ++j)
#pragma unroll
                for (int h = 0; h < 2; ++h) { xv[j][h] = *(const f32x4*)(xr + 512 * j + 8 * lane + 4 * h); const f32x4 t = xv[j][h]; ss += (t[0] * t[0] + t[1] * t[1]) + (t[2] * t[2] + t[3] * t[3]); }
            const float rstd = rsqrtf(wave_sum(ss) * (1.0f / DM) + NORM_EPS);
#pragma unroll
            for (int j = 0; j < 2; ++j) {
                const f32x4 h0 = xv[j][0] * rstd * wv[j][0], h1 = xv[j][1] * rstd * wv[j][1];
                u32x4 w; w.x = cvtpk(h0[0], h0[1]); w.y = cvtpk(h0[2], h0[3]); w.z = cvtpk(h1[0], h1[1]); w.w = cvtpk(h1[2], h1[3]);
                *(u32x4*)(H + (size_t)row * DM + 512 * j + 8 * lane) = w;
            }
        }
    }
}

template <bool WITH_H>
__device__ __forceinline__ void p_residual(const bf16_t* Y, const float* part, const float* xin, const float* post_w, const float* pre_w_next, float* xout, bf16_t* Hout, int G) {
    const int tid = threadIdx.x, lane = tid & 63, wid = __builtin_amdgcn_readfirstlane(tid >> 6);
    const int gw = blockIdx.x * 8 + wid, NGW = G * 8;
    f32x4 wp[2][2], wn[2][2]; load_w16(post_w, lane, wp);
    if (WITH_H) load_w16(pre_w_next, lane, wn);
    for (int row = gw; row < MTOK; row += NGW) {
        const float ps = (lane < 16) ? part[(size_t)row * 16 + lane] : 0.f;
        u32x4 yv[2]; f32x4 xv[2][2];
#pragma unroll
        for (int j = 0; j < 2; ++j) { yv[j] = *(const u32x4*)(Y + (size_t)row * DM + 512 * j + 8 * lane);
#pragma unroll
            for (int h = 0; h < 2; ++h) xv[j][h] = *(const f32x4*)(xin + (size_t)row * DM + 512 * j + 8 * lane + 4 * h); }
        const float rstd = rsqrtf(wave_sum(ps) * (1.0f / DM) + NORM_EPS);
        float ss = 0.f;
#pragma unroll
        for (int j = 0; j < 2; ++j) {
            const f32x4 y0 = (f32x4){bf_lo(yv[j].x), bf_hi(yv[j].x), bf_lo(yv[j].y), bf_hi(yv[j].y)}, y1 = (f32x4){bf_lo(yv[j].z), bf_hi(yv[j].z), bf_lo(yv[j].w), bf_hi(yv[j].w)};
            xv[j][0] = xv[j][0] + y0 * rstd * wp[j][0]; xv[j][1] = xv[j][1] + y1 * rstd * wp[j][1];
#pragma unroll
            for (int h = 0; h < 2; ++h) { const f32x4 t = xv[j][h]; ss += (t[0] * t[0] + t[1] * t[1]) + (t[2] * t[2] + t[3] * t[3]); *(f32x4*)(xout + (size_t)row * DM + 512 * j + 8 * lane + 4 * h) = t; }
        }
        if (WITH_H) {
            const float r2 = rsqrtf(wave_sum(ss) * (1.0f / DM) + NORM_EPS);
#pragma unroll
            for (int j = 0; j < 2; ++j) {
                const f32x4 h0 = xv[j][0] * r2 * wn[j][0], h1 = xv[j][1] * r2 * wn[j][1];
                u32x4 w; w.x = cvtpk(h0[0], h0[1]); w.y = cvtpk(h0[2], h0[3]); w.z = cvtpk(h1[0], h1[1]); w.w = cvtpk(h1[2], h1[3]);
                *(u32x4*)(Hout + (size_t)row * DM + 512 * j + 8 * lane) = w;
            }
        }
    }
}

typedef short v4i16_t __attribute__((ext_vector_type(4)));
__device__ __forceinline__ u32x2 tr4(const LAS unsigned char* p) { return __builtin_bit_cast(u32x2, __builtin_amdgcn_ds_read_tr16_b64_v4i16((LAS v4i16_t*)p)); }
__device__ __forceinline__ bf16x8 tr8(const LAS unsigned char* p0, const LAS unsigned char* p1) { const u32x2 a = tr4(p0), b = tr4(p1); return __builtin_bit_cast(bf16x8, (u32x4){a.x, a.y, b.x, b.y}); }
constexpr int AK_STRIDE = 144, AK_BYTES = 256 * AK_STRIDE, AV_BYTES = AK_BYTES, AO_STRIDE = 272, AO_BYTES = 32 * AO_STRIDE;
constexpr int ATTN_LDS = AK_BYTES + AV_BYTES + 8 * AO_BYTES;
__device__ __forceinline__ void p_attention(LAS unsigned char* lds, const bf16_t* QKVZ, const float* sinks, bf16_t* G0, int G) {
    const int tid = threadIdx.x, lane = tid & 63, wid = __builtin_amdgcn_readfirstlane(tid >> 6), r32 = lane & 31, hi = lane >> 5;
    LAS unsigned char* Ks = lds; LAS unsigned char* Vs = lds + AK_BYTES; LAS unsigned char* Os = lds + AK_BYTES + AV_BYTES + wid * AO_BYTES;
    const float NEG = -INFINITY;
    const int orow = lane >> 3, oc8 = (lane & 7) * 8;
    for (int u = blockIdx.x; u < NB * 16 * 2; u += G) {
        const int kvh = u & 1, n = (u >> 1) & 15, b = u >> 5;
        const size_t rowb = (size_t)b * SEQ;
        const int kstart = n * 128 - 128;
#pragma unroll
        for (int i = 0; i < 4; ++i) {
            const int idx = tid + 512 * i, kr = idx >> 3, ch = idx & 7, tok = kstart + kr;
            u32x4 v = (u32x4){0u, 0u, 0u, 0u};
            if (tok >= 0) v = *(const u32x4*)(QKVZ + (rowb + tok) * ATTN_IN + 1024 + kvh * 64 + ch * 8);
            *(LAS u32x4*)(Ks + kr * AK_STRIDE + ch * 16) = v;
        }
#pragma unroll
        for (int i = 0; i < 4; ++i) {
            const int idx = tid + 512 * i, kr = idx >> 3, ch = idx & 7, tok = kstart + kr;
            u32x4 v = (u32x4){0u, 0u, 0u, 0u};
            if (tok >= 0) v = *(const u32x4*)(QKVZ + (rowb + tok) * ATTN_IN + 1152 + kvh * 64 + ch * 8);
            *(LAS u32x4*)(Vs + kr * AK_STRIDE + ch * 16) = v;
        }
        const int hq = kvh * 8 + wid;
        const float sink2 = sinks[hq] * LOG2E;
        const size_t row0 = rowb + n * 128;
        bf16x8 qn[4];
#pragma unroll
        for (int d0 = 0; d0 < 4; ++d0) qn[d0] = *(const bf16x8*)(QKVZ + (row0 + r32) * ATTN_IN + hq * 64 + d0 * 16 + hi * 8);
        __syncthreads();
        for (int j = 0; j < 4; ++j) {
            bf16x8 qf[4];
#pragma unroll
            for (int d0 = 0; d0 < 4; ++d0) qf[d0] = qn[d0];
            {
                const int jn = (j < 3) ? j + 1 : 3;
#pragma unroll
                for (int d0 = 0; d0 < 4; ++d0) qn[d0] = *(const bf16x8*)(QKVZ + (row0 + 32 * jn + r32) * ATTN_IN + hq * 64 + d0 * 16 + hi * 8);
            }
            u32x4 zv[4];
#pragma unroll
            for (int i = 0; i < 4; ++i) zv[i] = *(const u32x4*)(QKVZ + (row0 + 32 * j + 8 * i + orow) * ATTN_IN + 1280 + hq * 64 + oc8);
            f32x16 st[5];
#pragma unroll
            for (int tt = 0; tt < 5; ++tt) {
                const bool tv = (n > 0) || (j + tt >= 4);
                if (tv) {
#pragma unroll
                    for (int r = 0; r < 16; ++r) st[tt][r] = 0.f;
#pragma unroll
                    for (int d0 = 0; d0 < 4; ++d0) {
                        const bf16x8 kf = *(const LAS bf16x8*)(Ks + (32 * (j + tt) + r32) * AK_STRIDE + d0 * 32 + hi * 16);
                        st[tt] = __builtin_amdgcn_mfma_f32_32x32x16_bf16(kf, qf[d0], st[tt], 0, 0, 0);
                    }
                } else {
#pragma unroll
                    for (int r = 0; r < 16; ++r) st[tt][r] = NEG;
                }
            }
            float mx = sink2;
#pragma unroll
            for (int r = 0; r < 16; ++r) {
                const int kk = (r & 3) + 8 * (r >> 2) + 4 * hi;
                if (!(kk > r32)) st[0][r] = NEG;
                if (!(kk <= r32)) st[4][r] = NEG;
            }
#pragma unroll
            for (int tt = 0; tt < 5; ++tt)
#pragma unroll
                for (int r = 0; r < 16; ++r) mx = fmaxf(mx, st[tt][r]);
            mx = fmaxf(mx, __shfl_xor(mx, 32));
            float l = 0.f;
#pragma unroll
            for (int tt = 0; tt < 5; ++tt)
#pragma unroll
                for (int r = 0; r < 16; ++r) { const float p = __builtin_amdgcn_exp2f(st[tt][r] - mx); st[tt][r] = p; l += p; }
            l += __shfl_xor(l, 32);
            l += __builtin_amdgcn_exp2f(sink2 - mx);
            const float inv = 1.0f / l;
            f32x16 ot[2];
#pragma unroll
            for (int r = 0; r < 16; ++r) { ot[0][r] = 0.f; ot[1][r] = 0.f; }
#pragma unroll
            for (int tt = 0; tt < 5; ++tt) {
                const bool tv = (n > 0) || (j + tt >= 4);
                if (tv) {
#pragma unroll
                    for (int ks = 0; ks < 2; ++ks) {
                        u32x4 pw; pw.x = cvtpk(st[tt][8 * ks + 0], st[tt][8 * ks + 1]); pw.y = cvtpk(st[tt][8 * ks + 2], st[tt][8 * ks + 3]);
                        pw.z = cvtpk(st[tt][8 * ks + 4], st[tt][8 * ks + 5]); pw.w = cvtpk(st[tt][8 * ks + 6], st[tt][8 * ks + 7]);
                        const bf16x8 pf = __builtin_bit_cast(bf16x8, pw);
#pragma unroll
                        for (int blk = 0; blk < 2; ++blk) {
                            const LAS unsigned char* vp = Vs + (32 * (j + tt) + 16 * ks + 4 * hi + ((lane & 15) >> 2)) * AK_STRIDE + (32 * blk + 16 * ((lane >> 4) & 1) + 4 * (lane & 3)) * 2;
                            const bf16x8 vf = tr8(vp, vp + 8 * AK_STRIDE);
                            ot[blk] = __builtin_amdgcn_mfma_f32_32x32x16_bf16(vf, pf, ot[blk], 0, 0, 0);
                        }
                    }
                }
            }
#pragma unroll
            for (int blk = 0; blk < 2; ++blk)
#pragma unroll
                for (int rq = 0; rq < 4; ++rq)
                    *(LAS f32x4*)(Os + r32 * AO_STRIDE + (32 * blk + 8 * rq + 4 * hi) * 4) = (f32x4){ot[blk][4 * rq + 0] * inv, ot[blk][4 * rq + 1] * inv, ot[blk][4 * rq + 2] * inv, ot[blk][4 * rq + 3] * inv};
            asm volatile("s_waitcnt lgkmcnt(0)" ::: "memory");
#pragma unroll
            for (int i = 0; i < 4; ++i) {
                const LAS unsigned char* op = Os + (8 * i + orow) * AO_STRIDE + oc8 * 4;
                const f32x4 a = *(const LAS f32x4*)op, c = *(const LAS f32x4*)(op + 16);
                u32x4 w; const u32x4 z = zv[i];
                w.x = cvtpk(a[0] * bf_lo(z.x), a[1] * bf_hi(z.x)); w.y = cvtpk(a[2] * bf_lo(z.y), a[3] * bf_hi(z.y));
                w.z = cvtpk(c[0] * bf_lo(z.z), c[1] * bf_hi(z.z)); w.w = cvtpk(c[2] * bf_lo(z.w), c[3] * bf_hi(z.w));
                *(u32x4*)(G0 + (row0 + 32 * j + 8 * i + orow) * DM + hq * 64 + oc8) = w;
            }
            asm volatile("s_waitcnt lgkmcnt(0)" ::: "memory");
        }
        __syncthreads();
    }
}

constexpr int RC = 32, RQ_STRIDE = 272, R_OSTRIDE = 528;
constexpr int R_QD = 0, R_QR = R_QD + RC * RQ_STRIDE, R_KR = R_QR + RC * RQ_STRIDE, R_KD = R_KR + RC * RQ_STRIDE, R_V = R_KD + RC * RQ_STRIDE, R_PS = R_V + RC * RQ_STRIDE,
              R_DEC = R_PS + 8 * 128 * 4, R_O = R_DEC + 512, R_END = R_O + RC * R_OSTRIDE;
#define LDS_BAR() do { asm volatile("s_waitcnt lgkmcnt(0)" ::: "memory"); __builtin_amdgcn_s_barrier(); asm volatile("" ::: "memory"); } while (0)
struct RecRegs { unsigned q[4], g[4], v[4]; u32x4 z; };
__device__ __forceinline__ void rec_load(RecRegs& R, const bf16_t* REC, size_t crow, int wid, int lane, int tid) {
#pragma unroll
    for (int i = 0; i < 4; ++i) {
        const bf16_t* rp = REC + (crow + 4 * wid + i) * 512 + 2 * lane;
        R.q[i] = *(const unsigned*)(rp); R.g[i] = *(const unsigned*)(rp + 128); R.v[i] = *(const unsigned*)(rp + 256);
    }
}
__device__ __forceinline__ void rec_load_z(RecRegs& R, const bf16_t* REC, size_t crow, int tid) {
    R.z = *(const u32x4*)(REC + (crow + (tid >> 4)) * 512 + 384 + 8 * (tid & 15));
}
__device__ __forceinline__ void rec_finalize(LAS unsigned char* lds, const u32x4& z, const f32x4& gw0, const f32x4& gw1, bf16_t* G1row, int tid) {
    const LAS unsigned char* op = lds + R_O + (tid >> 4) * R_OSTRIDE + (tid & 15) * 32;
    const f32x4 a = *(const LAS f32x4*)op, b = *(const LAS f32x4*)(op + 16);
    float ss = (a[0] * a[0] + a[1] * a[1]) + (a[2] * a[2] + a[3] * a[3]) + (b[0] * b[0] + b[1] * b[1]) + (b[2] * b[2] + b[3] * b[3]);
#pragma unroll
    for (int o = 1; o < 16; o <<= 1) ss += __shfl_xor(ss, o);
    const float rs = rsqrtf(ss * (1.0f / 128.0f) + NORM_EPS);
    const f32x4 x = a * rs * gw0, y = b * rs * gw1;
    u32x4 w;
    w.x = cvtpk(x[0] * bf_lo(z.x), x[1] * bf_hi(z.x)); w.y = cvtpk(x[2] * bf_lo(z.y), x[3] * bf_hi(z.y));
    w.z = cvtpk(y[0] * bf_lo(z.z), y[1] * bf_hi(z.z)); w.w = cvtpk(y[2] * bf_lo(z.w), y[3] * bf_hi(z.w));
    *(u32x4*)G1row = w;
}
__device__ __forceinline__ void rec_chunk(LAS unsigned char* lds, const bf16_t* REC, size_t hrow, bf16_t* G1t, int c, RecRegs& cur, RecRegs& P, f32x4 (&S)[8],
                                          const f32x4& gw0, const f32x4& gw1, int tid, int lane, int wid, int c16, int quad) {
    constexpr int NC = SEQ / RC;
    const int cn = (c + 2 < NC) ? c + 2 : NC - 1;
    const int tr_row = (c16 >> 2), tr_col = 4 * (c16 & 3);
    rec_load(P, REC, hrow + (size_t)cn * RC, wid, lane, tid);
    float g0[4], g1[4], c0 = 0.f, c1 = 0.f, cs0[4], cs1[4];
#pragma unroll
    for (int i = 0; i < 4; ++i) { g0[i] = h_lo(cur.g[i]); g1[i] = h_hi(cur.g[i]); c0 += g0[i]; c1 += g1[i]; cs0[i] = c0; cs1[i] = c1; }
    *(LAS f32x2_t*)(lds + R_PS + (wid * 128 + 2 * lane) * 4) = (f32x2_t){c0, c1};
    LDS_BAR();
    if (c > 0) rec_finalize(lds, P.z, gw0, gw1, G1t + (size_t)(c - 1) * RC * DM, tid);
    rec_load_z(P, REC, hrow + (size_t)cn * RC, tid);
    float pre0 = 0.f, pre1 = 0.f, ref0 = 0.f, ref1 = 0.f, tot0 = 0.f, tot1 = 0.f;
#pragma unroll
    for (int p = 0; p < 8; ++p) {
        const f32x2_t s = *(const LAS f32x2_t*)(lds + R_PS + (p * 128 + 2 * lane) * 4);
        if (p < wid) { pre0 += s.x; pre1 += s.y; }
        if (p < 4) { ref0 += s.x; ref1 += s.y; }
        tot0 += s.x; tot1 += s.y;
    }
    const float er0 = __builtin_amdgcn_exp2f(ref0), er1 = __builtin_amdgcn_exp2f(ref1);
    const float et0 = __builtin_amdgcn_exp2f(tot0 - ref0), et1 = __builtin_amdgcn_exp2f(tot1 - ref1);
    pre0 -= ref0; pre1 -= ref1;
#pragma unroll
    for (int i = 0; i < 4; ++i) {
        const int t = 4 * wid + i;
        const float d0 = pre0 + cs0[i], d1 = pre1 + cs1[i];
        const float qr0 = bf_lo(cur.q[i]) * __builtin_amdgcn_exp2f(fminf(d0, 100.f)), qr1 = bf_hi(cur.q[i]) * __builtin_amdgcn_exp2f(fminf(d1, 100.f));
        const float kr0 = (1.0f - __builtin_amdgcn_exp2f(g0[i])) * __builtin_amdgcn_exp2f(fminf(-d0, 100.f)), kr1 = (1.0f - __builtin_amdgcn_exp2f(g1[i])) * __builtin_amdgcn_exp2f(fminf(-d1, 100.f));
        *(LAS unsigned*)(lds + R_QR + t * RQ_STRIDE + lane * 4) = cvtpk(qr0, qr1);
        *(LAS unsigned*)(lds + R_KR + t * RQ_STRIDE + lane * 4) = cvtpk(kr0, kr1);
        *(LAS unsigned*)(lds + R_QD + t * RQ_STRIDE + lane * 4) = cvtpk(qr0 * er0, qr1 * er1);
        *(LAS unsigned*)(lds + R_KD + t * RQ_STRIDE + lane * 4) = cvtpk(kr0 * et0, kr1 * et1);
        *(LAS unsigned*)(lds + R_V + t * RQ_STRIDE + lane * 4) = cur.v[i];
    }
    if (wid == 0) *(LAS f32x2_t*)(lds + R_DEC + 2 * lane * 4) = (f32x2_t){__builtin_amdgcn_exp2f(tot0), __builtin_amdgcn_exp2f(tot1)};
    LDS_BAR();
    f32x4 s00 = (f32x4){0.f, 0.f, 0.f, 0.f}, s01 = s00, s11 = s00;
#pragma unroll
    for (int kk = 0; kk < 4; ++kk) {
        const bf16x8 ka0 = *(const LAS bf16x8*)(lds + R_KR + (c16) * RQ_STRIDE + kk * 64 + quad * 16);
        const bf16x8 ka1 = *(const LAS bf16x8*)(lds + R_KR + (16 + c16) * RQ_STRIDE + kk * 64 + quad * 16);
        const bf16x8 qb0 = *(const LAS bf16x8*)(lds + R_QR + (c16) * RQ_STRIDE + kk * 64 + quad * 16);
        const bf16x8 qb1 = *(const LAS bf16x8*)(lds + R_QR + (16 + c16) * RQ_STRIDE + kk * 64 + quad * 16);
        s00 = __builtin_amdgcn_mfma_f32_16x16x32_bf16(ka0, qb0, s00, 0, 0, 0);
        s01 = __builtin_amdgcn_mfma_f32_16x16x32_bf16(ka0, qb1, s01, 0, 0, 0);
        s11 = __builtin_amdgcn_mfma_f32_16x16x32_bf16(ka1, qb1, s11, 0, 0, 0);
    }
#pragma unroll
    for (int r = 0; r < 4; ++r) { if (4 * quad + r > c16) { s00[r] = 0.f; s11[r] = 0.f; } }
    u32x4 pw0, pw1;
    pw0.x = cvtpk(s00[0], s00[1]); pw0.y = cvtpk(s00[2], s00[3]); pw0.z = 0u; pw0.w = 0u;
    pw1.x = cvtpk(s01[0], s01[1]); pw1.y = cvtpk(s01[2], s01[3]); pw1.z = cvtpk(s11[0], s11[1]); pw1.w = cvtpk(s11[2], s11[3]);
    f32x4 o0 = (f32x4){0.f, 0.f, 0.f, 0.f}, o1 = o0;
#pragma unroll
    for (int jj = 0; jj < 4; ++jj) {
        u32x4 sw; sw.x = cvtpk(S[2 * jj][0], S[2 * jj][1]); sw.y = cvtpk(S[2 * jj][2], S[2 * jj][3]); sw.z = cvtpk(S[2 * jj + 1][0], S[2 * jj + 1][1]); sw.w = cvtpk(S[2 * jj + 1][2], S[2 * jj + 1][3]);
        const bf16x8 sb = __builtin_bit_cast(bf16x8, sw);
        const LAS unsigned char* qp0 = lds + R_QD + (c16) * RQ_STRIDE + (32 * jj + 4 * quad) * 2;
        const LAS unsigned char* qp1 = lds + R_QD + (16 + c16) * RQ_STRIDE + (32 * jj + 4 * quad) * 2;
        const u32x2 a0 = *(const LAS u32x2*)qp0, a1 = *(const LAS u32x2*)(qp0 + 32), a2 = *(const LAS u32x2*)qp1, a3 = *(const LAS u32x2*)(qp1 + 32);
        o0 = __builtin_amdgcn_mfma_f32_16x16x32_bf16(__builtin_bit_cast(bf16x8, (u32x4){a0.x, a0.y, a1.x, a1.y}), sb, o0, 0, 0, 0);
        o1 = __builtin_amdgcn_mfma_f32_16x16x32_bf16(__builtin_bit_cast(bf16x8, (u32x4){a2.x, a2.y, a3.x, a3.y}), sb, o1, 0, 0, 0);
    }
    {
        const LAS unsigned char* vp = lds + R_V + (4 * quad + tr_row) * RQ_STRIDE + (16 * wid + tr_col) * 2;
        const bf16x8 vb = tr8(vp, vp + 16 * RQ_STRIDE);
        o0 = __builtin_amdgcn_mfma_f32_16x16x32_bf16(__builtin_bit_cast(bf16x8, pw0), vb, o0, 0, 0, 0);
        o1 = __builtin_amdgcn_mfma_f32_16x16x32_bf16(__builtin_bit_cast(bf16x8, pw1), vb, o1, 0, 0, 0);
    }
#pragma unroll
    for (int r = 0; r < 4; ++r) {
        *(LAS float*)(lds + R_O + (4 * quad + r) * R_OSTRIDE + (16 * wid + c16) * 4) = o0[r];
        *(LAS float*)(lds + R_O + (16 + 4 * quad + r) * R_OSTRIDE + (16 * wid + c16) * 4) = o1[r];
    }
    {
        const LAS unsigned char* vp = lds + R_V + (8 * quad + tr_row) * RQ_STRIDE + (16 * wid + tr_col) * 2;
        const bf16x8 vb = tr8(vp, vp + 4 * RQ_STRIDE);
        const LAS unsigned char* kp = lds + R_KD + (8 * quad + tr_row) * RQ_STRIDE + tr_col * 2;
#pragma unroll
        for (int kt = 0; kt < 8; ++kt) {
            const f32x4 dv = *(const LAS f32x4*)(lds + R_DEC + (16 * kt + 4 * quad) * 4);
            const bf16x8 ka = tr8(kp + kt * 32, kp + kt * 32 + 4 * RQ_STRIDE);
            S[kt] = __builtin_amdgcn_mfma_f32_16x16x32_bf16(ka, vb, S[kt] * dv, 0, 0, 0);
        }
    }
}
__device__ __forceinline__ void p_recurrence(LAS unsigned char* lds, const bf16_t* REC, const float* gnw, bf16_t* G1, int G) {
    const int tid = threadIdx.x, lane = tid & 63, wid = __builtin_amdgcn_readfirstlane(tid >> 6), c16 = lane & 15, quad = lane >> 4;
    constexpr int NC = SEQ / RC;
    static_assert(NC % 3 == 1, "chunk loop is unrolled by 3 with one tail chunk");
    for (int u = blockIdx.x; u < NB * 8; u += G) {
        const int b = u >> 3, h = u & 7;
        const size_t hrow = (size_t)u * SEQ;
        const f32x4 gw0 = *(const f32x4*)(gnw + 8 * (tid & 15)), gw1 = *(const f32x4*)(gnw + 8 * (tid & 15) + 4);
        bf16_t* G1t = G1 + ((size_t)b * SEQ + (tid >> 4)) * DM + h * 128 + 8 * (tid & 15);
        f32x4 S[8];
#pragma unroll
        for (int kt = 0; kt < 8; ++kt) S[kt] = (f32x4){0.f, 0.f, 0.f, 0.f};
        RecRegs A, B, C;
        rec_load(A, REC, hrow, wid, lane, tid); rec_load_z(A, REC, hrow, tid);
        rec_load(B, REC, hrow + RC, wid, lane, tid); rec_load_z(B, REC, hrow + RC, tid);
        C.z = (u32x4){0u, 0u, 0u, 0u};
        for (int c = 0; c < NC - 1; c += 3) {
            rec_chunk(lds, REC, hrow, G1t, c, A, C, S, gw0, gw1, tid, lane, wid, c16, quad);
            rec_chunk(lds, REC, hrow, G1t, c + 1, B, A, S, gw0, gw1, tid, lane, wid, c16, quad);
            rec_chunk(lds, REC, hrow, G1t, c + 2, C, B, S, gw0, gw1, tid, lane, wid, c16, quad);
        }
        rec_chunk(lds, REC, hrow, G1t, NC - 1, A, C, S, gw0, gw1, tid, lane, wid, c16, quad);
        LDS_BAR();
        rec_finalize(lds, A.z, gw0, gw1, G1t + (size_t)(NC - 1) * RC * DM, tid);
        LDS_BAR();
    }
}

#define XB_TMO      128
#define XB_XCNT(j)  (256  + 64 * (j))
#define XB_XSUB(j)  (1280 + 64 * (j))
#define XB_XGEN(j)  (2304 + 64 * (j))
#define XB_TOP      3328
#define XB_TOPGEN   3392
#define XCD_BAR_WORDS 3456
#define XB_SPIN_CAP (1u << 18)
__device__ __forceinline__ unsigned xb_ld(unsigned* p)              { return __hip_atomic_load(p, __ATOMIC_RELAXED, __HIP_MEMORY_SCOPE_AGENT); }
__device__ __forceinline__ unsigned xb_add(unsigned* p, unsigned v) { return __hip_atomic_fetch_add(p, v, __ATOMIC_RELAXED, __HIP_MEMORY_SCOPE_AGENT); }
__device__ __forceinline__ unsigned xb_xcc_id() { return (unsigned)__builtin_amdgcn_s_getreg((3 << 11) | 20) & 0xFu; }
#define XB_SPIN(cond, bar) do { unsigned _sp = 0; while (cond) { __builtin_amdgcn_s_sleep(1); \
    if ((++_sp & 255u) == 0u) { if (xb_ld(&(bar)[XB_TMO])) break; if (_sp > XB_SPIN_CAP) { atomicAdd(&(bar)[XB_TMO], 1u); break; } } } } while (0)
struct XcdBarrier { unsigned* bar; unsigned x; volatile LAS unsigned* st; };
__device__ __forceinline__ XcdBarrier xcd_barrier_post(unsigned* bar, volatile LAS unsigned* st) {
    XcdBarrier b; b.bar = bar; b.x = xb_xcc_id(); b.st = st;
    if (threadIdx.x == 0) (void)xb_add(&bar[XB_XCNT(b.x)], 1u);
    return b;
}
__device__ __forceinline__ void xcd_barrier_complete(unsigned* bar, unsigned x, unsigned& nloc, unsigned& nx) {
    const unsigned G = gridDim.x * gridDim.y * gridDim.z;
    unsigned sum, cnt, mine, sp = 0u;
    for (;;) {
        sum = 0u; cnt = 0u; mine = 0u;
#pragma unroll
        for (unsigned j = 0; j < 16; ++j) { const unsigned c = xb_ld(&bar[XB_XCNT(j)]); sum += c; cnt += (c > 0u) ? 1u : 0u; mine = (j == x) ? c : mine; }
        if (sum == G) break;
        __builtin_amdgcn_s_sleep(1);
        if ((++sp & 255u) == 0u) { if (xb_ld(&bar[XB_TMO])) break; if (sp > XB_SPIN_CAP) { atomicAdd(&bar[XB_TMO], 1u); break; } }
    }
    nloc = mine > 0u ? mine : 1u; nx = cnt > 0u ? cnt : 1u;
}
__device__ __forceinline__ void xcd_barrier(const XcdBarrier& b) {
    asm volatile("s_waitcnt vmcnt(0)" ::: "memory");
    __syncthreads();
    if (threadIdx.x == 0) {
        unsigned* bar = b.bar;
        __builtin_amdgcn_s_waitcnt(0);
        unsigned nloc = b.st[0], nx = b.st[1];
        if (nloc == 0u) { xcd_barrier_complete(bar, b.x, nloc, nx); b.st[0] = nloc; b.st[1] = nx; }
        const unsigned old = xb_add(&bar[XB_XSUB(b.x)], 1u);
        const unsigned gen = old / nloc;
        if (old + 1u == (gen + 1u) * nloc) {
            __builtin_amdgcn_fence(__ATOMIC_RELEASE, "agent");
            asm volatile("s_waitcnt vmcnt(0)" ::: "memory");
            const unsigned og = xb_add(&bar[XB_TOP], 1u);
            const unsigned tg = og / nx;
            if (og + 1u == (tg + 1u) * nx) xb_add(&bar[XB_TOPGEN], 1u);
            else XB_SPIN(xb_ld(&bar[XB_TOPGEN]) == tg, bar);
            __builtin_amdgcn_fence(__ATOMIC_ACQUIRE, "agent");
            xb_add(&bar[XB_XGEN(b.x)], 1u);
            asm volatile("s_waitcnt vmcnt(0)" ::: "memory");
        } else {
            XB_SPIN(xb_ld(&bar[XB_XGEN(b.x)]) == gen, bar);
            __builtin_amdgcn_fence(__ATOMIC_ACQUIRE, "agent");
            asm volatile("s_waitcnt vmcnt(0)" ::: "memory");
        }
    }
    __syncthreads();
}

constexpr int MISC_OFF = 147456 - 64;
constexpr int LDS_BYTES = 147456;
static_assert(pg8::STAGE_BYTES <= LDS_BYTES && ATTN_LDS <= MISC_OFF && R_END <= LDS_BYTES, "LDS map");
constexpr int N_PHASES = 9;
#define PROBE_LO -1
#define PROBE_HI 6
#define PROBE_NULL 0

__global__ void __launch_bounds__(512, 2) hybrid_fwd(Args a) {
    extern __shared__ __attribute__((aligned(16))) unsigned char lds_raw[];
    LAS unsigned char* lds = (LAS unsigned char*)lds_raw;
    cg::grid_group grid = cg::this_grid();
    const int G = gridDim.x;
    const int lo = a.ph_lo, hi = a.ph_hi;
    unsigned char* ws = a.ws;
#define IN(k) (lo <= (k) && (k) < hi)
#define SEAM(k) do { if (IN(k) && IN((k) + 1)) xcd_barrier(xbar); } while (0)
    unsigned* barw = (unsigned*)(ws + WS_BAR);
    volatile LAS unsigned* misc = (volatile LAS unsigned*)(lds + MISC_OFF);
    if (blockIdx.x == 0) for (int i = threadIdx.x; i < XCD_BAR_WORDS; i += 512) __hip_atomic_store(barw + i, 0u, __ATOMIC_RELAXED, __HIP_MEMORY_SCOPE_AGENT);
    if (threadIdx.x < 2) misc[threadIdx.x] = 0u;
    __syncthreads();
    if (IN(0)) { p_prologue(a, lds, G); __syncthreads(); }
    grid.sync();
    XcdBarrier xbar = xcd_barrier_post(barw, misc);
    if (IN(1)) {
        pg8::Gemm g{(const bf16_t*)(ws + WS_H), (const bf16_t*)(ws + WS_WIN0), MTOK, ATTN_IN, DM}; pg8::StaticOrder S; S.init(MTOK, ATTN_IN, G, (int)blockIdx.x);
        pg8::EpiAttnIn E{(bf16_t*)(ws + WS_QKVZ), (const float*)(ws + WS_BIASP), (const unsigned*)(ws + WS_ROPE)};
#if PROBE_NULL
        if (a.flags) { pg8::EpiNull EN{(float*)(ws + WS_PART)}; pg8::gemm_phase<pg8::EpiNull, true, true>(lds, g, S, EN); } else
#endif
        pg8::gemm_phase<pg8::EpiAttnIn, true, true>(lds, g, S, E);
    }
    SEAM(1);
    if (IN(2)) p_attention(lds, (const bf16_t*)(ws + WS_QKVZ), a.a_sinks, (bf16_t*)(ws + WS_G0), G);
    SEAM(2);
    if (IN(3)) {
        pg8::Gemm g{(const bf16_t*)(ws + WS_G0), (const bf16_t*)(ws + WS_WOUT0), MTOK, DM, DM}; pg8::StaticOrder S; S.init(MTOK, DM, G, (int)blockIdx.x);
        pg8::EpiOut E{(bf16_t*)(ws + WS_Y), a.a_bout, (float*)(ws + WS_PART)};
#if PROBE_NULL
        if (a.flags) { pg8::EpiNull EN{(float*)(ws + WS_PART)}; pg8::gemm_phase<pg8::EpiNull, true, true>(lds, g, S, EN); } else
#endif
        pg8::gemm_phase<pg8::EpiOut, true, true>(lds, g, S, E);
    }
    SEAM(3);
    if (IN(4)) p_residual<true>((const bf16_t*)(ws + WS_Y), (const float*)(ws + WS_PART), a.x, a.post_w, a.pre_w + DM, a.out, (bf16_t*)(ws + WS_H), G);
    SEAM(4);
    if (IN(5)) {
        pg8::Gemm g{(const bf16_t*)(ws + WS_H), (const bf16_t*)(ws + WS_WIN1), MTOK, REC_IN, DM}; pg8::StaticOrder S; S.init(MTOK, REC_IN, G, (int)blockIdx.x);
        pg8::EpiRecIn E{(bf16_t*)(ws + WS_BIG), (const float*)(ws + WS_LB)};
#if PROBE_NULL
        if (a.flags) { pg8::EpiRecInT<true> EN{(bf16_t*)(ws + WS_BIG), (const float*)(ws + WS_LB)}; pg8::gemm_phase<pg8::EpiRecInT<true>, true, true>(lds, g, S, EN); } else
#endif
        pg8::gemm_phase<pg8::EpiRecIn, true, true>(lds, g, S, E);
    }
    SEAM(5);
    if (IN(6)) p_recurrence(lds, (const bf16_t*)(ws + WS_BIG), a.r_gw, (bf16_t*)(ws + WS_G1), G);
    SEAM(6);
    if (IN(7)) {
        pg8::Gemm g{(const bf16_t*)(ws + WS_G1), (const bf16_t*)(ws + WS_WOUT1), MTOK, DM, DM}; pg8::StaticOrder S; S.init(MTOK, DM, G, (int)blockIdx.x);
        pg8::EpiOut E{(bf16_t*)(ws + WS_Y), nullptr, (float*)(ws + WS_PART)};
        pg8::gemm_phase<pg8::EpiOut, true, true>(lds, g, S, E);
    }
    SEAM(7);
    if (IN(8)) p_residual<false>((const bf16_t*)(ws + WS_Y), (const float*)(ws + WS_PART), a.out, a.post_w + DM, nullptr, a.out, nullptr, G);
#undef IN
#undef SEAM
}

extern "C" void kernel_launch(void* const* d_in, const int* in_sizes, int n_in, void* d_out, int out_size, void* d_ws, size_t ws_size, hipStream_t stream) {
    static int grid = 0;
    if (grid == 0) {
        if (n_in != 13 || in_sizes[0] != MTOK * DM || out_size != MTOK * DM || ws_size < WS_END) { fprintf(stderr, "kernel_launch: unexpected shapes (n_in %d, ws %zu < %zu)\n", n_in, ws_size, (size_t)WS_END); grid = -1; return; }
        int dev = 0, cus = 0, per_cu = 0;
        hipGetDevice(&dev); hipDeviceGetAttribute(&cus, hipDeviceAttributeMultiprocessorCount, dev);
        if (hipFuncSetAttribute((const void*)hybrid_fwd, hipFuncAttributeMaxDynamicSharedMemorySize, LDS_BYTES) != hipSuccess) { fprintf(stderr, "kernel_launch: hipFuncSetAttribute failed\n"); grid = -1; return; }
        if (hipOccupancyMaxActiveBlocksPerMultiprocessor(&per_cu, (const void*)hybrid_fwd, 512, LDS_BYTES) != hipSuccess || per_cu < 1) { fprintf(stderr, "kernel_launch: occupancy query says %d\n", per_cu); per_cu = 1; }
        (void)hipGetLastError();
        grid = cus * 1;
    }
    if (grid < 0) return;
    Args a{};
    a.x = (const float*)d_in[0]; a.pos = (const int*)d_in[1]; a.pre_w = (const float*)d_in[2]; a.post_w = (const float*)d_in[3];
    a.a_win = (const float*)d_in[4]; a.a_bin = (const float*)d_in[5]; a.a_sinks = (const float*)d_in[6]; a.a_wout = (const float*)d_in[7]; a.a_bout = (const float*)d_in[8];
    a.r_win = (const float*)d_in[9]; a.r_lbl = (const float*)d_in[10]; a.r_gw = (const float*)d_in[11]; a.r_wout = (const float*)d_in[12];
    a.out = (float*)d_out; a.ws = (unsigned char*)d_ws;
    void* args[] = {&a};
#if PROBE_LO >= 0
#if PROBE_NULL
    a.ph_lo = 0; a.ph_hi = PROBE_LO;
    if (PROBE_LO > 0) (void)hipLaunchCooperativeKernel((const void*)hybrid_fwd, dim3(grid), dim3(512), args, LDS_BYTES, stream);
    a.ph_lo = PROBE_LO; a.ph_hi = PROBE_HI; a.flags = 1;
    (void)hipLaunchCooperativeKernel((const void*)hybrid_fwd, dim3(grid), dim3(512), args, LDS_BYTES, stream);
    a.flags = 0;
#else
    a.ph_lo = 0; a.ph_hi = PROBE_HI;
    (void)hipLaunchCooperativeKernel((const void*)hybrid_fwd, dim3(grid), dim3(512), args, LDS_BYTES, stream);
#endif
    a.ph_lo = PROBE_LO; a.ph_hi = N_PHASES;
#else
    a.ph_lo = 0; a.ph_hi = N_PHASES;
#endif
    hipError_t e = hipLaunchCooperativeKernel((const void*)hybrid_fwd, dim3(grid), dim3(512), args, LDS_BYTES, stream);
    if (e != hipSuccess) fprintf(stderr, "kernel_launch: cooperative launch failed: %s (grid %d)\n", hipGetErrorString(e), grid);
}
```

```cpp
#include <hip/hip_runtime.h>
#include <hip/hip_cooperative_groups.h>
#include <cstdio>
#include <cstdint>
namespace cg = cooperative_groups;

#define LAS __attribute__((address_space(3)))
typedef unsigned short bf16_t;
typedef short bf16x8 __attribute__((ext_vector_type(8)));
typedef float f32x4 __attribute__((ext_vector_type(4)));
typedef float f32x16 __attribute__((ext_vector_type(16)));
typedef unsigned u32x4 __attribute__((ext_vector_type(4)));
typedef unsigned u32x2 __attribute__((ext_vector_type(2)));
typedef float f32x2_t __attribute__((ext_vector_type(2)));
typedef __bf16 bf16x2_t __attribute__((ext_vector_type(2)));
typedef _Float16 f16x2_t __attribute__((ext_vector_type(2)));

constexpr int NB = 32, SEQ = 2048, DM = 1024, MTOK = NB * SEQ;
constexpr int ATTN_IN = 2304, REC_IN = 4096;
constexpr float NORM_EPS = 1e-6f;
constexpr float LOG2E = 1.4426950408889634f;
constexpr float QSCALE = 0.125f * 1.4426950408889634f;

constexpr size_t WS_WIN0 = 0;
constexpr size_t WS_WOUT0 = WS_WIN0 + (size_t)ATTN_IN * DM * 2;
constexpr size_t WS_WIN1 = WS_WOUT0 + (size_t)DM * DM * 2;
constexpr size_t WS_WOUT1 = WS_WIN1 + (size_t)REC_IN * DM * 2;
constexpr size_t WS_ROPE = WS_WOUT1 + (size_t)DM * DM * 2;
constexpr size_t WS_LB = WS_ROPE + (size_t)MTOK * 16 * 4;
constexpr size_t WS_BIASP = WS_LB + 4096;
constexpr size_t WS_BAR = WS_BIASP + 12288;
constexpr size_t WS_PART = WS_BAR + 16384;
constexpr size_t WS_PART1 = WS_PART + (size_t)MTOK * 16 * 4;
constexpr size_t WS_H = WS_PART1 + (size_t)MTOK * 16 * 4;
constexpr size_t WS_Y = WS_H + (size_t)MTOK * DM * 2;
constexpr size_t WS_G1 = WS_Y + (size_t)MTOK * DM * 2;
constexpr size_t WS_BIG = WS_G1 + (size_t)MTOK * DM * 2;
constexpr size_t WS_QKVZ = WS_BIG;
constexpr size_t WS_G0 = WS_QKVZ + (size_t)MTOK * ATTN_IN * 2;
constexpr size_t WS_VT = WS_G0 + (size_t)MTOK * DM * 2;
constexpr size_t WS_END = WS_BIG + (size_t)MTOK * REC_IN * 2;
static_assert(WS_VT + (size_t)MTOK * 128 * 2 <= WS_END, "overlay");

#define LDS_BAR() do { asm volatile("s_waitcnt lgkmcnt(0)" ::: "memory"); __builtin_amdgcn_s_barrier(); asm volatile("" ::: "memory"); } while (0)
__device__ __forceinline__ unsigned cvtpk(float lo, float hi) { f32x2_t v = {lo, hi}; bf16x2_t b = __builtin_convertvector(v, bf16x2_t); return __builtin_bit_cast(unsigned, b); }
__device__ __forceinline__ unsigned cvtpk_h(float lo, float hi) { f32x2_t v = {lo, hi}; f16x2_t b = __builtin_convertvector(v, f16x2_t); return __builtin_bit_cast(unsigned, b); }
__device__ __forceinline__ float bf_lo(unsigned u) { return __uint_as_float(u << 16); }
__device__ __forceinline__ float bf_hi(unsigned u) { return __uint_as_float(u & 0xffff0000u); }
__device__ __forceinline__ float h_lo(unsigned u) { f16x2_t h = __builtin_bit_cast(f16x2_t, u); return (float)h[0]; }
__device__ __forceinline__ float h_hi(unsigned u) { f16x2_t h = __builtin_bit_cast(f16x2_t, u); return (float)h[1]; }
__device__ __forceinline__ float silu_f(float v) { return v * __builtin_amdgcn_rcpf(1.0f + __expf(-v)); }
__device__ __forceinline__ float wave_sum(float v) {
#pragma unroll
    for (int o = 1; o < 64; o <<= 1) v += __shfl_xor(v, o);
    return v;
}

__host__ __device__ __forceinline__ int rope_src_col(int c) { return (c < 1152 && (c & 63) < 16) ? ((c & ~15) | (((c & 15) >> 1) + 8 * (c & 1))) : c; }

#ifndef SKEW_TICKS
#define SKEW_TICKS 0
#endif
namespace pg8 {
constexpr int BM = 256, BK = 64, HALF = 128, HTB = HALF * BK * 2, STAGE_BYTES = 8 * HTB, NXCD = 8, WGM = 8;
__host__ __device__ __forceinline__ int lds_byte(int r, int c) { const int st = (r >> 4) * 2 + (c >> 5), rr = r & 15, cc = c & 31, ob = rr * 64 + cc * 2; return st * 1024 + (ob ^ (((ob >> 9) & 1) << 5)); }
__host__ __device__ __forceinline__ void stage_rc(int b, int& R, int& C) { const int st = b / 1024, sb = b % 1024, swz = sb ^ (((sb >> 9) & 1) << 5); R = (st >> 1) * 16 + swz / 64; C = (st & 1) * 32 + (swz % 64) / 2; }
__host__ __device__ __forceinline__ int perm32(int rho) { const int n = rho >> 4, i = rho & 15; return 8 * (i >> 2) + 4 * n + (i & 3); }

struct Unit { int pm, pn; };
struct Gemm { const bf16_t* A; const bf16_t* Bt; int M, N, K; };

struct StaticOrder {
    int nM, nN, nwg, G, c;
    __host__ __device__ void init(int M, int N, int G_, int c_) { nM = M / BM; nN = N / BM; nwg = nM * nN; G = G_; c = c_; }
    __host__ __device__ bool next(int i, Unit& u) const {
        const long L = (long)i * G + c; if (L >= nwg) return false;
        int wgid = (int)L; { const int q = nwg / NXCD, r = nwg % NXCD, xcd = wgid % NXCD, off = wgid / NXCD; wgid = (xcd < r ? xcd * (q + 1) : r * (q + 1) + (xcd - r) * q) + off; }
        const int nig = WGM * nN, gid = wgid / nig, fm = gid * WGM, gsz = (nM - fm) < WGM ? (nM - fm) : WGM;
        u.pm = fm + ((wgid % nig) % gsz); u.pn = (wgid % nig) / gsz; return true;
    }
};

template <class Epi, bool ALIGN_EPI, bool SP2>
__device__ __forceinline__ void gemm_phase(LAS unsigned char* lds, const Gemm g, const StaticOrder& S, const Epi& E) {
    const int tid = threadIdx.x, wid = __builtin_amdgcn_readfirstlane(tid >> 6), lane = tid & 63, wr = wid >> 2, wc = wid & 3, fr = lane & 15, fq = lane >> 4;
    const int K = g.K, nt = K / BK;
    unsigned voffA[2], voffB[2];
#pragma unroll
    for (int i = 0; i < 2; ++i) { int R, C; stage_rc(tid * 16 + i * 8192, R, C); const int Rb = Epi::PERM ? ((R & ~31) + perm32(R & 31)) : R;
        voffA[i] = (unsigned)(R * K + C) * 2u; voffB[i] = (unsigned)(Rb * K + C) * 2u; }
    const size_t kstep = (size_t)(BK * 2);
    const size_t hstep = (size_t)HALF * K * 2;
    const size_t tstep = 2 * hstep;
    const unsigned ldsw = (unsigned)wid * 1024u;
    const int aoff = lds_byte(wr * 64 + fr, fq * 8), boff = lds_byte(wc * 32 + fr, fq * 8);
#define PG8_SA(b, h) (((b) * 2 + (h)) * HTB)
#define PG8_SB(b, h) ((4 + (b) * 2 + (h)) * HTB)
#define PG8_STAGE(bufoff, gbase, voff) do { _Pragma("unroll") for (int _i = 0; _i < 2; ++_i) \
        __builtin_amdgcn_global_load_lds((const unsigned*)((const char*)(gbase) + (voff)[_i]), (LAS unsigned*)(lds + (bufoff) + ldsw + _i * 8192), 16, 0, 0); } while (0)
#define PG8_LDA(dst, b, h) do { _Pragma("unroll") for (int m = 0; m < 4; ++m) _Pragma("unroll") for (int k = 0; k < 2; ++k) dst[m][k] = *(const LAS bf16x8*)(lds + PG8_SA(b, h) + aoff + m * 2048 + k * 1024); } while (0)
#define PG8_LDB(dst, b, h) do { _Pragma("unroll") for (int n = 0; n < 2; ++n) _Pragma("unroll") for (int k = 0; k < 2; ++k) dst[n][k] = *(const LAS bf16x8*)(lds + PG8_SB(b, h) + boff + n * 2048 + k * 1024); } while (0)
#define PG8_MMA(ai, bj, Af, Bf) do { __builtin_amdgcn_s_setprio(1); _Pragma("unroll") for (int m = 0; m < 4; ++m) _Pragma("unroll") for (int n = 0; n < 2; ++n) _Pragma("unroll") for (int k = 0; k < 2; ++k) \
        acc[ai][bj][m][n] = __builtin_amdgcn_mfma_f32_16x16x32_bf16(Bf[n][k], Af[m][k], acc[ai][bj][m][n], 0, 0, 0); __builtin_amdgcn_s_setprio(0); } while (0)
#define PG8_WAIT_V(n) asm volatile("s_waitcnt vmcnt(" #n ")" ::: "memory")
#define PG8_WAIT_L(n) asm volatile("s_waitcnt lgkmcnt(" #n ")" ::: "memory")
#define PG8_BAR __builtin_amdgcn_s_barrier()
#define PG8_SCHED __builtin_amdgcn_sched_barrier(0)
    Unit cur, nxt; int ui = 0;
    if (!S.next(0, cur)) return;
    if (SKEW_TICKS > 0) {
        const unsigned long long t0 = __builtin_amdgcn_s_memrealtime(), dl = (unsigned long long)(((unsigned)blockIdx.x >> 3) & 3u) * SKEW_TICKS;
        while (__builtin_amdgcn_s_memrealtime() - t0 < dl) __builtin_amdgcn_s_sleep(8);
    }
    f32x4 acc[2][2][4][2];
#pragma unroll
    for (int a = 0; a < 2; ++a)
#pragma unroll
        for (int b = 0; b < 2; ++b)
#pragma unroll
            for (int m = 0; m < 4; ++m)
#pragma unroll
                for (int n = 0; n < 2; ++n) acc[a][b][m][n] = (f32x4){0.f, 0.f, 0.f, 0.f};
    bf16x8 At[4][2], B0[2][2], B1[2][2];
    const char* cA = (const char*)g.A + (size_t)cur.pm * tstep; const char* cB = (const char*)g.Bt + (size_t)cur.pn * tstep;
    if constexpr (SP2) {
        PG8_STAGE(PG8_SB(0, 0), cB, voffB); PG8_STAGE(PG8_SB(0, 1), cB + hstep, voffB); PG8_STAGE(PG8_SA(0, 0), cA, voffA); PG8_STAGE(PG8_SA(0, 1), cA + hstep, voffA);
        if (wr == 1) PG8_BAR;
        PG8_WAIT_V(2); PG8_BAR;
        PG8_STAGE(PG8_SB(1, 0), cB + kstep, voffB); PG8_STAGE(PG8_SA(1, 0), cA + kstep, voffA); PG8_STAGE(PG8_SB(1, 1), cB + hstep + kstep, voffB);
        PG8_WAIT_V(6); PG8_BAR;
    } else {
        PG8_STAGE(PG8_SB(0, 0), cB, voffB); PG8_STAGE(PG8_SA(0, 0), cA, voffA); PG8_STAGE(PG8_SB(0, 1), cB + hstep, voffB); PG8_STAGE(PG8_SA(0, 1), cA + hstep, voffA);
        if (wr == 1) PG8_BAR;
        PG8_WAIT_V(4); PG8_BAR;
        PG8_STAGE(PG8_SB(1, 0), cB + kstep, voffB); PG8_STAGE(PG8_SA(1, 0), cA + kstep, voffA); PG8_STAGE(PG8_SB(1, 1), cB + hstep + kstep, voffB);
        PG8_WAIT_V(6); PG8_BAR;
    }
    for (;;) {
        const bool has_next = S.next(ui + 1, nxt);
        const char* nA = has_next ? (const char*)g.A + (size_t)nxt.pm * tstep : cA; const char* nB = has_next ? (const char*)g.Bt + (size_t)nxt.pn * tstep : cB;
        for (int t = 0; t < nt; t += 2) {
            const bool last = (t == nt - 2);
            const char* a1 = cA + (size_t)(t + 1) * kstep;
            const char* a2 = last ? nA : cA + (size_t)(t + 2) * kstep; const char* b2 = last ? nB : cB + (size_t)(t + 2) * kstep;
            const char* a3 = a2 + kstep; const char* b3 = b2 + kstep;
            if constexpr (SP2) {
            PG8_LDB(B0, 0, 0); PG8_LDB(B1, 0, 1); PG8_SCHED; PG8_LDA(At, 0, 0); PG8_STAGE(PG8_SA(1, 1), a1 + hstep, voffA);
            PG8_WAIT_V(8); PG8_WAIT_L(0); PG8_BAR; PG8_MMA(0, 0, At, B0); PG8_MMA(0, 1, At, B1); PG8_BAR; PG8_SCHED;
            PG8_LDA(At, 0, 1); PG8_STAGE(PG8_SB(0, 0), b2, voffB); PG8_STAGE(PG8_SB(0, 1), b2 + hstep, voffB); PG8_STAGE(PG8_SA(0, 0), a2, voffA);
            PG8_WAIT_V(8); PG8_WAIT_L(0); PG8_BAR; PG8_MMA(1, 0, At, B0); PG8_MMA(1, 1, At, B1); PG8_BAR; PG8_SCHED;
            PG8_LDB(B0, 1, 0); PG8_LDB(B1, 1, 1); PG8_SCHED; PG8_LDA(At, 1, 0); PG8_STAGE(PG8_SA(0, 1), a2 + hstep, voffA);
            PG8_WAIT_V(8); PG8_WAIT_L(0); PG8_BAR; PG8_MMA(0, 0, At, B0); PG8_MMA(0, 1, At, B1); PG8_BAR; PG8_SCHED;
            PG8_LDA(At, 1, 1); PG8_STAGE(PG8_SB(1, 0), b3, voffB); PG8_STAGE(PG8_SB(1, 1), b3 + hstep, voffB); PG8_STAGE(PG8_SA(1, 0), a3, voffA);
            PG8_WAIT_V(8); PG8_WAIT_L(0); PG8_BAR; PG8_MMA(1, 0, At, B0); PG8_MMA(1, 1, At, B1); PG8_BAR; PG8_SCHED;
            } else {
            PG8_LDB(B0, 0, 0); PG8_SCHED; PG8_LDA(At, 0, 0); PG8_STAGE(PG8_SA(1, 1), a1 + hstep, voffA);
            PG8_WAIT_L(8); PG8_BAR; PG8_WAIT_L(0); PG8_MMA(0, 0, At, B0); PG8_BAR; PG8_SCHED;
            PG8_LDB(B1, 0, 1); PG8_STAGE(PG8_SB(0, 0), b2, voffB);
            PG8_BAR; PG8_WAIT_L(0); PG8_MMA(0, 1, At, B1); PG8_BAR;
            PG8_LDA(At, 0, 1); PG8_STAGE(PG8_SA(0, 0), a2, voffA);
            PG8_BAR; PG8_WAIT_L(0); PG8_MMA(1, 0, At, B0); PG8_BAR; PG8_SCHED;
            PG8_STAGE(PG8_SB(0, 1), b2 + hstep, voffB);
            PG8_WAIT_V(6); PG8_BAR; PG8_MMA(1, 1, At, B1); PG8_BAR;
            PG8_LDB(B0, 1, 0); PG8_SCHED; PG8_LDA(At, 1, 0); PG8_STAGE(PG8_SA(0, 1), a2 + hstep, voffA);
            PG8_WAIT_L(8); PG8_BAR; PG8_WAIT_L(0); PG8_MMA(0, 0, At, B0); PG8_BAR; PG8_SCHED;
            PG8_LDB(B1, 1, 1); PG8_STAGE(PG8_SB(1, 0), b3, voffB);
            PG8_BAR; PG8_WAIT_L(0); PG8_MMA(0, 1, At, B1); PG8_BAR;
            PG8_LDA(At, 1, 1); PG8_STAGE(PG8_SA(1, 0), a3, voffA);
            PG8_BAR; PG8_WAIT_L(0); PG8_MMA(1, 0, At, B0); PG8_BAR; PG8_SCHED;
            PG8_STAGE(PG8_SB(1, 1), b3 + hstep, voffB);
            PG8_WAIT_V(6); PG8_BAR; PG8_MMA(1, 1, At, B1); PG8_BAR;
            }
        }
        if constexpr (ALIGN_EPI) { if (wr == 0) PG8_BAR; }
        E(acc, cur, wr, wc, fr, fq);
        if (!has_next) break;
#pragma unroll
        for (int a = 0; a < 2; ++a)
#pragma unroll
            for (int b = 0; b < 2; ++b)
#pragma unroll
                for (int m = 0; m < 4; ++m)
#pragma unroll
                    for (int n = 0; n < 2; ++n) acc[a][b][m][n] = (f32x4){0.f, 0.f, 0.f, 0.f};
        cur = nxt; cA = nA; cB = nB; ++ui;
        if constexpr (ALIGN_EPI) { if (wr == 1) PG8_BAR; }
    }
    PG8_WAIT_V(0);
    if constexpr (!ALIGN_EPI) { if (wr == 0) PG8_BAR; }
    PG8_BAR;
#undef PG8_SA
#undef PG8_SB
#undef PG8_STAGE
#undef PG8_LDA
#undef PG8_LDB
#undef PG8_MMA
#undef PG8_WAIT_V
#undef PG8_WAIT_L
#undef PG8_BAR
#undef PG8_SCHED
}

template <bool NOSTORE> struct EpiAttnInT {
    static constexpr bool PERM = true;
    bf16_t* O; const float* bias; const unsigned* rope;
    template <int K0, int K1>
    __device__ __forceinline__ void body(const f32x4 (&acc)[2][2][4][2], const Unit& u, int wr, int wc, int fr, int fq) const {
        const int row0 = u.pm * BM + wr * 64 + fr;
        const bool ropew = (K0 <= 1) && ((wc & 1) == 0);
        const bool ropel = ropew && fq < 2;
        f32x4 bv[2][2];
#pragma unroll
        for (int bj = 0; bj < 2; ++bj) { const int c0 = u.pn * BM + bj * HALF + wc * 32 + 8 * fq; bv[bj][0] = *(const f32x4*)(bias + c0); bv[bj][1] = *(const f32x4*)(bias + c0 + 4); }
        u32x4 csv[2][4];
#pragma unroll
        for (int ai = 0; ai < 2; ++ai)
#pragma unroll
            for (int m = 0; m < 4; ++m) csv[ai][m] = (u32x4){0u, 0u, 0u, 0u};
        if (K0 <= 1 && ropew) {
#pragma unroll
            for (int ai = 0; ai < 2; ++ai)
#pragma unroll
                for (int m = 0; m < 4; ++m) csv[ai][m] = *(const u32x4*)(rope + (size_t)(row0 + ai * HALF + m * 16) * 8 + 4 * (fq & 1));
        }
#pragma unroll
        for (int ai = 0; ai < 2; ++ai)
#pragma unroll
            for (int m = 0; m < 4; ++m) {
                const int row = row0 + ai * HALF + m * 16;
                const u32x4 cs = csv[ai][m];
#pragma unroll
                for (int bj = 0; bj < 2; ++bj) {
                    constexpr int kind0 = K0, kind1 = K1;
                    const int kind = bj ? kind1 : kind0;
                    const int c0 = u.pn * BM + bj * HALF + wc * 32 + 8 * fq;
                    f32x4 v0 = acc[ai][bj][m][0] + bv[bj][0], v1 = acc[ai][bj][m][1] + bv[bj][1];
                    if ((bj ? K1 : K0) <= 1) {
                        const float c0f = h_lo(cs.x), s0f = h_hi(cs.x), c1f = h_lo(cs.y), s1f = h_hi(cs.y), c2f = h_lo(cs.z), s2f = h_hi(cs.z), c3f = h_lo(cs.w), s3f = h_hi(cs.w);
                        const f32x4 t0 = v0, t1 = v1;
                        f32x4 r0, r1;
                        r0[0] = t0[0] * c0f - t0[1] * s0f; r0[1] = t0[1] * c0f + t0[0] * s0f; r0[2] = t0[2] * c1f - t0[3] * s1f; r0[3] = t0[3] * c1f + t0[2] * s1f;
                        r1[0] = t1[0] * c2f - t1[1] * s2f; r1[1] = t1[1] * c2f + t1[0] * s2f; r1[2] = t1[2] * c3f - t1[3] * s3f; r1[3] = t1[3] * c3f + t1[2] * s3f;
#pragma unroll
                        for (int i = 0; i < 4; ++i) { v0[i] = ropel ? r0[i] : v0[i]; v1[i] = ropel ? r1[i] : v1[i]; }
                    }
                    if (kind == 0) { v0 = v0 * QSCALE; v1 = v1 * QSCALE; }
                    if (kind == 3) {
#pragma unroll
                        for (int i = 0; i < 4; ++i) { v0[i] = silu_f(v0[i]); v1[i] = silu_f(v1[i]); }
                    }
                    u32x4 w; w.x = cvtpk(v0[0], v0[1]); w.y = cvtpk(v0[2], v0[3]); w.z = cvtpk(v1[0], v1[1]); w.w = cvtpk(v1[2], v1[3]);
                    if (!NOSTORE || (w.x == 0x12345678u && w.y == 0x9abcdef0u))
                    *(u32x4*)(O + (size_t)row * ATTN_IN + c0) = w;
                }
            }
    }
    __device__ __forceinline__ void operator()(const f32x4 (&acc)[2][2][4][2], const Unit& u, int wr, int wc, int fr, int fq) const {
        if (u.pn < 4) body<0, 0>(acc, u, wr, wc, fr, fq);
        else if (u.pn == 4) body<1, 2>(acc, u, wr, wc, fr, fq);
        else body<3, 3>(acc, u, wr, wc, fr, fq);
    }
};
template <bool NOSTORE> struct EpiRecInT {
    static constexpr bool PERM = true;
    bf16_t* O; const float* lb;
    template <int SEG>
    __device__ __forceinline__ void body(const f32x4 (&acc)[2][2][4][2], const Unit& u, int wr, int wc, int fr, int fq) const {
        const int row0 = u.pm * BM + wr * 64 + fr;
        constexpr int seg = SEG;
#pragma unroll
        for (int bj = 0; bj < 2; ++bj) {
            const int c0 = u.pn * BM + bj * HALF + wc * 32 + 8 * fq;
            f32x4 l0 = (f32x4){0.f, 0.f, 0.f, 0.f}, l1 = l0;
            if (seg == 1) { l0 = *(const f32x4*)(lb + (c0 - 1024)); l1 = *(const f32x4*)(lb + (c0 - 1024) + 4); }
#pragma unroll
            for (int ai = 0; ai < 2; ++ai)
#pragma unroll
                for (int m = 0; m < 4; ++m) {
                    const int row = row0 + ai * HALF + m * 16;
                    f32x4 v0 = acc[ai][bj][m][0], v1 = acc[ai][bj][m][1];
                    u32x4 w;
                    if (seg == 1) {
#pragma unroll
                        for (int i = 0; i < 4; ++i) {
                            const float s0 = __builtin_amdgcn_rcpf(1.0f + __expf(-v0[i])), s1 = __builtin_amdgcn_rcpf(1.0f + __expf(-v1[i]));
                            v0[i] = __log2f(l0[i] + (1.0f - l0[i]) * s0); v1[i] = __log2f(l1[i] + (1.0f - l1[i]) * s1);
                        }
                        w.x = cvtpk_h(v0[0], v0[1]); w.y = cvtpk_h(v0[2], v0[3]); w.z = cvtpk_h(v1[0], v1[1]); w.w = cvtpk_h(v1[2], v1[3]);
                    } else {
                        if (seg != 2) {
#pragma unroll
                            for (int i = 0; i < 4; ++i) { v0[i] = silu_f(v0[i]); v1[i] = silu_f(v1[i]); }
                        }
                        w.x = cvtpk(v0[0], v0[1]); w.y = cvtpk(v0[2], v0[3]); w.z = cvtpk(v1[0], v1[1]); w.w = cvtpk(v1[2], v1[3]);
                    }
                    if (!NOSTORE || (w.x == 0x12345678u && w.y == 0x9abcdef0u))
                    *(u32x4*)(O + ((size_t)((row >> 11) * 8 + (u.pn & 3) * 2 + bj) * SEQ + (row & 2047)) * 512 + seg * 128 + wc * 32 + 8 * fq) = w;
                }
        }
    }
    __device__ __forceinline__ void operator()(const f32x4 (&acc)[2][2][4][2], const Unit& u, int wr, int wc, int fr, int fq) const {
        const int sg = u.pn >> 2;
        if (sg == 0) body<0>(acc, u, wr, wc, fr, fq); else if (sg == 1) body<1>(acc, u, wr, wc, fr, fq); else if (sg == 2) body<2>(acc, u, wr, wc, fr, fq); else body<3>(acc, u, wr, wc, fr, fq);
    }
};
struct EpiOut {
    static constexpr bool PERM = true;
    bf16_t* O; const float* bias; float* part; LAS float* xch;
    __device__ __forceinline__ void operator()(const f32x4 (&acc)[2][2][4][2], const Unit& u, int wr, int wc, int fr, int fq) const {
        const int row0 = u.pm * BM + wr * 64 + fr;
        f32x4 bv[2][2];
#pragma unroll
        for (int bj = 0; bj < 2; ++bj) { const int c0 = u.pn * BM + bj * HALF + wc * 32 + 8 * fq;
            bv[bj][0] = bias ? *(const f32x4*)(bias + c0) : (f32x4){0.f, 0.f, 0.f, 0.f}; bv[bj][1] = bias ? *(const f32x4*)(bias + c0 + 4) : (f32x4){0.f, 0.f, 0.f, 0.f}; }
#pragma unroll
        for (int ai = 0; ai < 2; ++ai)
#pragma unroll
            for (int m = 0; m < 4; ++m) {
                const int row = row0 + ai * HALF + m * 16;
                float ss = 0.f;
#pragma unroll
                for (int bj = 0; bj < 2; ++bj) {
                    const int c0 = u.pn * BM + bj * HALF + wc * 32 + 8 * fq;
                    const f32x4 v0 = acc[ai][bj][m][0] + bv[bj][0], v1 = acc[ai][bj][m][1] + bv[bj][1];
                    ss += (v0[0] * v0[0] + v0[1] * v0[1]) + (v0[2] * v0[2] + v0[3] * v0[3]) + (v1[0] * v1[0] + v1[1] * v1[1]) + (v1[2] * v1[2] + v1[3] * v1[3]);
                    u32x4 w; w.x = cvtpk(v0[0], v0[1]); w.y = cvtpk(v0[2], v0[3]); w.z = cvtpk(v1[0], v1[1]); w.w = cvtpk(v1[2], v1[3]);
                    *(u32x4*)(O + (size_t)row * DM + c0) = w;
                }
                ss += __shfl_xor(ss, 16); ss += __shfl_xor(ss, 32);
                if (fq == 0) xch[(ai * HALF + wr * 64 + m * 16 + fr) * 4 + wc] = ss;
            }
        asm volatile("s_waitcnt lgkmcnt(0)" ::: "memory"); __builtin_amdgcn_s_barrier(); asm volatile("" ::: "memory");
        if (threadIdx.x < 256) { const f32x4 p = *(const LAS f32x4*)(xch + threadIdx.x * 4); part[(size_t)(u.pm * BM + threadIdx.x) * 4 + u.pn] = (p[0] + p[1]) + (p[2] + p[3]); }
    }
};
struct EpiNull {
    static constexpr bool PERM = true;
    float* sink;
    __device__ __forceinline__ void operator()(const f32x4 (&acc)[2][2][4][2], const Unit& u, int wr, int wc, int fr, int fq) const {
        f32x4 s = (f32x4){0.f, 0.f, 0.f, 0.f};
#pragma unroll
        for (int ai = 0; ai < 2; ++ai)
#pragma unroll
            for (int bj = 0; bj < 2; ++bj)
#pragma unroll
                for (int m = 0; m < 4; ++m) { s += acc[ai][bj][m][0]; s += acc[ai][bj][m][1]; }
        if (s[0] + s[1] + s[2] + s[3] == 123456.789f) sink[u.pm] = s[0];
    }
};
typedef EpiRecInT<false> EpiRecIn;
typedef EpiAttnInT<false> EpiAttnIn;
}

template <bool ROPE_PERM>
__device__ __forceinline__ void transpose_item(const float* W, int K, int N, bf16_t* WT, LAS float* scr, int item, int lane) {
    const int nblk = N / 32, kb = item / nblk, nb = item % nblk, k0 = 64 * kb, n0 = 32 * nb;
    const int ncol = ROPE_PERM ? rope_src_col(n0 + (lane & 31)) : n0 + (lane & 31);
#pragma unroll 8
    for (int i = 0; i < 32; ++i) { const int kk = 2 * i + (lane >> 5); scr[kk * 33 + (lane & 31)] = W[(size_t)(k0 + kk) * N + ncol]; }
    asm volatile("s_waitcnt lgkmcnt(0)" ::: "memory");
    const int c = lane & 7;
#pragma unroll
    for (int j = 0; j < 4; ++j) { const int n = (lane >> 3) + 8 * j; const LAS float* s = scr + (8 * c) * 33 + n;
        u32x4 o; o.x = cvtpk(s[0 * 33], s[1 * 33]); o.y = cvtpk(s[2 * 33], s[3 * 33]); o.z = cvtpk(s[4 * 33], s[5 * 33]); o.w = cvtpk(s[6 * 33], s[7 * 33]);
        *(u32x4*)(WT + (size_t)(n0 + n) * K + k0 + 8 * c) = o; }
    asm volatile("s_waitcnt lgkmcnt(0)" ::: "memory");
}

struct Args {
    const float* x; const int* pos; const float* pre_w; const float* post_w; const float* a_win; const float* a_bin; const float* a_sinks;
    const float* a_wout; const float* a_bout; const float* r_win; const float* r_lbl; const float* r_gw; const float* r_wout;
    float* out; unsigned char* ws; int ph_lo, ph_hi, flags, pad;
};

__device__ __forceinline__ void load_w16(const float* w, int lane, f32x4 (&r)[2][2]) {
#pragma unroll
    for (int j = 0; j < 2; ++j)
#pragma unroll
        for (int h = 0; h < 2; ++h) r[j][h] = *(const f32x4*)(w + 512 * j + 8 * lane + 4 * h);
}

__device__ __forceinline__ void p_prologue(const Args& a, LAS unsigned char* lds, int G) {
    const int tid = threadIdx.x, lane = tid & 63, wid = __builtin_amdgcn_readfirstlane(tid >> 6);
    LAS float* scr = (LAS float*)(lds + wid * 16384);
    const int gw = blockIdx.x * 8 + wid, NGW = G * 8;
    constexpr int I_A = (DM / 64) * (ATTN_IN / 32), I_O = (DM / 64) * (DM / 32), I_R = (DM / 64) * (REC_IN / 32);
    constexpr int NITEMS = I_A + I_O + I_R + I_O;
    for (int it = gw; it < NITEMS; it += NGW) {
        int r = it;
        if (r < I_A) { transpose_item<true>(a.a_win, DM, ATTN_IN, (bf16_t*)(a.ws + WS_WIN0), scr, r, lane); continue; } r -= I_A;
        if (r < I_O) { transpose_item<false>(a.a_wout, DM, DM, (bf16_t*)(a.ws + WS_WOUT0), scr, r, lane); continue; } r -= I_O;
        if (r < I_R) { transpose_item<false>(a.r_win, DM, REC_IN, (bf16_t*)(a.ws + WS_WIN1), scr, r, lane); continue; } r -= I_R;
        transpose_item<false>(a.r_wout, DM, DM, (bf16_t*)(a.ws + WS_WOUT1), scr, r, lane);
    }
    {
        unsigned* rope = (unsigned*)(a.ws + WS_ROPE);
        const int gt = blockIdx.x * 512 + tid, NGT = G * 512;
        for (int e = gt; e < MTOK * 8; e += NGT) {
            const int row = e >> 3, i = e & 7;
            const float invf = (i == 0) ? 1.0f : (i == 1) ? 0.19392274474868576f : (i == 2) ? 0.03760603093086393f : (i == 3) ? 0.007292664737217109f :
                               (i == 4) ? 0.001414213562373095f : (i == 5) ? 0.0002742481756762073f : (i == 6) ? 5.318295896944988e-05f : 1.031338537721246e-05f;
            const float ang = (float)a.pos[row] * invf;
            rope[e] = cvtpk_h(cosf(ang), sinf(ang));
        }
        float* biasp = (float*)(a.ws + WS_BIASP);
        for (int e = gt; e < ATTN_IN; e += NGT) biasp[e] = a.a_bin[rope_src_col(e)];
        float* lb = (float*)(a.ws + WS_LB);
        for (int e = gt; e < DM; e += NGT) { const float l0 = a.r_lbl[e], l1 = a.r_lbl[DM + e]; lb[e] = 1.0f / (1.0f + expf(l0 - l1)); }
    }
    {
        f32x4 wv[2][2]; load_w16(a.pre_w, lane, wv);
        bf16_t* H = (bf16_t*)(a.ws + WS_H);
        for (int row = gw; row < MTOK; row += 2 * NGW) {
            f32x4 xv[2][2][2]; float ss[2] = {0.f, 0.f}; int rr[2]; bool ok[2];
#pragma unroll
            for (int r = 0; r < 2; ++r) { ok[r] = row + r * NGW < MTOK; rr[r] = ok[r] ? row + r * NGW : row;
#pragma unroll
                for (int j = 0; j < 2; ++j)
#pragma unroll
                    for (int h = 0; h < 2; ++h) xv[r][j][h] = *(const f32x4*)(a.x + (size_t)rr[r] * DM + 512 * j + 8 * lane + 4 * h); }
#pragma unroll
            for (int r = 0; r < 2; ++r)
#pragma unroll
                for (int j = 0; j < 2; ++j)
#pragma unroll
                    for (int h = 0; h < 2; ++h) { const f32x4 t = xv[r][j][h]; ss[r] += (t[0] * t[0] + t[1] * t[1]) + (t[2] * t[2] + t[3] * t[3]); }
#pragma unroll
            for (int r = 0; r < 2; ++r) {
                const float rstd = rsqrtf(wave_sum(ss[r]) * (1.0f / DM) + NORM_EPS);
#pragma unroll
                for (int j = 0; j < 2; ++j) {
                    const f32x4 h0 = xv[r][j][0] * rstd * wv[j][0], h1 = xv[r][j][1] * rstd * wv[j][1];
                    u32x4 w; w.x = cvtpk(h0[0], h0[1]); w.y = cvtpk(h0[2], h0[3]); w.z = cvtpk(h1[0], h1[1]); w.w = cvtpk(h1[2], h1[3]);
                    if (ok[r]) *(u32x4*)(H + (size_t)rr[r] * DM + 512 * j + 8 * lane) = w;
                }
            }
        }
    }
}

__device__ __forceinline__ void unpack_bf16x8(const u32x4& v, f32x4& lo, f32x4& hi) {
    lo = (f32x4){bf_lo(v.x), bf_hi(v.x), bf_lo(v.y), bf_hi(v.y)}; hi = (f32x4){bf_lo(v.z), bf_hi(v.z), bf_lo(v.w), bf_hi(v.w)};
}
__device__ __forceinline__ void p_mid(const bf16_t* Y0, const float* part0, const float* x, const float* post_w0, const float* pre_w1, bf16_t* Hout, int G) {
    const int tid = threadIdx.x, lane = tid & 63, wid = __builtin_amdgcn_readfirstlane(tid >> 6);
    const int gw = blockIdx.x * 8 + wid, NGW = G * 8;
    f32x4 wp[2][2], wn[2][2]; load_w16(post_w0, lane, wp); load_w16(pre_w1, lane, wn);
    for (int row = gw; row < MTOK; row += 2 * NGW) {
        float ps[2]; u32x4 yv[2][2]; f32x4 xv[2][2][2]; int rr[2]; bool ok[2];
#pragma unroll
        for (int r = 0; r < 2; ++r) { ok[r] = row + r * NGW < MTOK; rr[r] = ok[r] ? row + r * NGW : row;
            ps[r] = (lane < 4) ? part0[(size_t)rr[r] * 4 + lane] : 0.f;
#pragma unroll
            for (int j = 0; j < 2; ++j) { yv[r][j] = *(const u32x4*)(Y0 + (size_t)rr[r] * DM + 512 * j + 8 * lane);
#pragma unroll
                for (int h = 0; h < 2; ++h) xv[r][j][h] = *(const f32x4*)(x + (size_t)rr[r] * DM + 512 * j + 8 * lane + 4 * h); } }
#pragma unroll
        for (int r = 0; r < 2; ++r) {
            const float rstd = rsqrtf(wave_sum(ps[r]) * (1.0f / DM) + NORM_EPS);
            float ss = 0.f;
#pragma unroll
            for (int j = 0; j < 2; ++j) {
                f32x4 y0, y1; unpack_bf16x8(yv[r][j], y0, y1);
                xv[r][j][0] = xv[r][j][0] + y0 * rstd * wp[j][0]; xv[r][j][1] = xv[r][j][1] + y1 * rstd * wp[j][1];
#pragma unroll
                for (int h = 0; h < 2; ++h) { const f32x4 t = xv[r][j][h]; ss += (t[0] * t[0] + t[1] * t[1]) + (t[2] * t[2] + t[3] * t[3]); }
            }
            const float r2 = rsqrtf(wave_sum(ss) * (1.0f / DM) + NORM_EPS);
#pragma unroll
            for (int j = 0; j < 2; ++j) {
                const f32x4 h0 = xv[r][j][0] * r2 * wn[j][0], h1 = xv[r][j][1] * r2 * wn[j][1];
                u32x4 w; w.x = cvtpk(h0[0], h0[1]); w.y = cvtpk(h0[2], h0[3]); w.z = cvtpk(h1[0], h1[1]); w.w = cvtpk(h1[2], h1[3]);
                if (ok[r]) *(u32x4*)(Hout + (size_t)rr[r] * DM + 512 * j + 8 * lane) = w;
            }
        }
    }
}
__device__ __forceinline__ void p_final(const bf16_t* Y0, const float* part0, const bf16_t* Y1, const float* part1, const float* x, const float* post_w0, const float* post_w1, float* out, int G) {
    const int tid = threadIdx.x, lane = tid & 63, wid = __builtin_amdgcn_readfirstlane(tid >> 6);
    const int gw = blockIdx.x * 8 + wid, NGW = G * 8;
    f32x4 wp0[2][2], wp1[2][2]; load_w16(post_w0, lane, wp0); load_w16(post_w1, lane, wp1);
    for (int row = gw; row < MTOK; row += 2 * NGW) {
        float ps0[2], ps1[2]; u32x4 ya[2][2], yb[2][2]; f32x4 xv[2][2][2]; int rr[2]; bool ok[2];
#pragma unroll
        for (int r = 0; r < 2; ++r) { ok[r] = row + r * NGW < MTOK; rr[r] = ok[r] ? row + r * NGW : row;
            ps0[r] = (lane < 4) ? part0[(size_t)rr[r] * 4 + lane] : 0.f; ps1[r] = (lane < 4) ? part1[(size_t)rr[r] * 4 + lane] : 0.f;
#pragma unroll
            for (int j = 0; j < 2; ++j) { ya[r][j] = *(const u32x4*)(Y0 + (size_t)rr[r] * DM + 512 * j + 8 * lane); yb[r][j] = *(const u32x4*)(Y1 + (size_t)rr[r] * DM + 512 * j + 8 * lane);
#pragma unroll
                for (int h = 0; h < 2; ++h) xv[r][j][h] = *(const f32x4*)(x + (size_t)rr[r] * DM + 512 * j + 8 * lane + 4 * h); } }
#pragma unroll
        for (int r = 0; r < 2; ++r) {
            const float r0 = rsqrtf(wave_sum(ps0[r]) * (1.0f / DM) + NORM_EPS), r1 = rsqrtf(wave_sum(ps1[r]) * (1.0f / DM) + NORM_EPS);
#pragma unroll
            for (int j = 0; j < 2; ++j) {
                f32x4 a0, a1, b0, b1; unpack_bf16x8(ya[r][j], a0, a1); unpack_bf16x8(yb[r][j], b0, b1);
                f32x4 t0 = xv[r][j][0] + a0 * r0 * wp0[j][0], t1 = xv[r][j][1] + a1 * r0 * wp0[j][1];
                t0 = t0 + b0 * r1 * wp1[j][0]; t1 = t1 + b1 * r1 * wp1[j][1];
                if (ok[r]) { *(f32x4*)(out + (size_t)rr[r] * DM + 512 * j + 8 * lane) = t0; *(f32x4*)(out + (size_t)rr[r] * DM + 512 * j + 8 * lane + 4) = t1; }
            }
        }
    }
}

typedef short v4i16_t __attribute__((ext_vector_type(4)));
__device__ __forceinline__ u32x2 tr4(const LAS unsigned char* p) { return __builtin_bit_cast(u32x2, __builtin_amdgcn_ds_read_tr16_b64_v4i16((LAS v4i16_t*)p)); }
__device__ __forceinline__ bf16x8 tr8(const LAS unsigned char* p0, const LAS unsigned char* p1) { const u32x2 a = tr4(p0), b = tr4(p1); return __builtin_bit_cast(bf16x8, (u32x4){a.x, a.y, b.x, b.y}); }
constexpr int AK_STRIDE = 144, AK_BYTES = 256 * AK_STRIDE, AV_BYTES = AK_BYTES, AO_STRIDE = 272, AO_BYTES = 32 * AO_STRIDE;
constexpr int ATTN_LDS = AK_BYTES + AV_BYTES + 8 * AO_BYTES;
template <bool ALLV>
__device__ __forceinline__ void attn_subblocks(LAS unsigned char* Ks, LAS unsigned char* Vs, LAS unsigned char* Os, const bf16_t* QKVZ, bf16_t* G0, bf16x8 (&qn)[4],
                                               int u, int G, int NU, size_t row0, int hq, float sink2, int wid, int lane, int r32, int hi, int orow, int oc8) {
    const float NEG = -INFINITY;
    for (int j = 0; j < 4; ++j) {
        bf16x8 qf[4];
#pragma unroll
        for (int d0 = 0; d0 < 4; ++d0) qf[d0] = qn[d0];
        {
            const int un = (u + G < NU) ? u + G : u;
            const size_t qrow = (j < 3) ? row0 + 32 * (j + 1) : (size_t)(un >> 5) * SEQ + ((un >> 1) & 15) * 128;
            const int qh = (j < 3) ? hq : (un & 1) * 8 + wid;
#pragma unroll
            for (int d0 = 0; d0 < 4; ++d0) qn[d0] = *(const bf16x8*)(QKVZ + (qrow + r32) * ATTN_IN + qh * 64 + d0 * 16 + hi * 8);
        }
        u32x4 zv[4];
#pragma unroll
        for (int i = 0; i < 4; ++i) zv[i] = *(const u32x4*)(QKVZ + (row0 + 32 * j + 8 * i + orow) * ATTN_IN + 1280 + hq * 64 + oc8);
        f32x16 st[5];
        bf16x8 kfr[2][4];
        const LAS unsigned char* kbase = Ks + (32 * j + r32) * AK_STRIDE + hi * 16;
#pragma unroll
        for (int d0 = 0; d0 < 4; ++d0) kfr[0][d0] = *(const LAS bf16x8*)(kbase + d0 * 32);
#pragma unroll
        for (int tt = 0; tt < 5; ++tt) {
            const bool tv = ALLV || (j + tt >= 4);
            if (tt < 4) {
#pragma unroll
                for (int d0 = 0; d0 < 4; ++d0) kfr[(tt + 1) & 1][d0] = *(const LAS bf16x8*)(kbase + (tt + 1) * 32 * AK_STRIDE + d0 * 32);
            }
            __builtin_amdgcn_sched_barrier(0);
            if (tv) {
#pragma unroll
                for (int r = 0; r < 16; ++r) st[tt][r] = 0.f;
#pragma unroll
                for (int d0 = 0; d0 < 4; ++d0) st[tt] = __builtin_amdgcn_mfma_f32_32x32x16_bf16(kfr[tt & 1][d0], qf[d0], st[tt], 0, 0, 0);
            } else {
#pragma unroll
                for (int r = 0; r < 16; ++r) st[tt][r] = NEG;
            }
            __builtin_amdgcn_sched_barrier(0);
        }
        float mx = sink2;
#pragma unroll
        for (int r = 0; r < 16; ++r) {
            const int kk = (r & 3) + 8 * (r >> 2) + 4 * hi;
            if (!(kk > r32)) st[0][r] = NEG;
            if (!(kk <= r32)) st[4][r] = NEG;
        }
#pragma unroll
        for (int tt = 0; tt < 5; ++tt)
#pragma unroll
            for (int r = 0; r < 16; ++r) mx = fmaxf(mx, st[tt][r]);
        mx = fmaxf(mx, __shfl_xor(mx, 32));
        float l = 0.f;
        f32x16 ot[2];
#pragma unroll
        for (int r = 0; r < 16; ++r) { ot[0][r] = 0.f; ot[1][r] = 0.f; }
        bf16x8 vfr[2][2];
        const LAS unsigned char* vbase = Vs + (32 * j + 4 * hi + ((lane & 15) >> 2)) * AK_STRIDE + (16 * ((lane >> 4) & 1) + 4 * (lane & 3)) * 2;
#pragma unroll
        for (int blk = 0; blk < 2; ++blk) { const LAS unsigned char* vp = vbase + (32 * blk) * 2; vfr[0][blk] = tr8(vp, vp + 8 * AK_STRIDE); }
#pragma unroll
        for (int sidx = 0; sidx < 10; ++sidx) {
            const int tt = sidx >> 1, ks = sidx & 1;
            const bool tv = ALLV || (j + tt >= 4);
            if (sidx < 9) {
#pragma unroll
                for (int blk = 0; blk < 2; ++blk) { const LAS unsigned char* vp = vbase + (16 * (sidx + 1)) * AK_STRIDE + (32 * blk) * 2; vfr[(sidx + 1) & 1][blk] = tr8(vp, vp + 8 * AK_STRIDE); }
            }
            __builtin_amdgcn_sched_barrier(0);
            if (tv) {
                if (ks == 0) {
#pragma unroll
                    for (int r = 0; r < 16; ++r) { const float p = __builtin_amdgcn_exp2f(st[tt][r] - mx); st[tt][r] = p; l += p; }
                }
                u32x4 pw; pw.x = cvtpk(st[tt][8 * ks + 0], st[tt][8 * ks + 1]); pw.y = cvtpk(st[tt][8 * ks + 2], st[tt][8 * ks + 3]);
                pw.z = cvtpk(st[tt][8 * ks + 4], st[tt][8 * ks + 5]); pw.w = cvtpk(st[tt][8 * ks + 6], st[tt][8 * ks + 7]);
                const bf16x8 pf = __builtin_bit_cast(bf16x8, pw);
#pragma unroll
                for (int blk = 0; blk < 2; ++blk) ot[blk] = __builtin_amdgcn_mfma_f32_32x32x16_bf16(vfr[sidx & 1][blk], pf, ot[blk], 0, 0, 0);
            }
            __builtin_amdgcn_sched_barrier(0);
        }
        l += __shfl_xor(l, 32);
        l += __builtin_amdgcn_exp2f(sink2 - mx);
        const float inv = 1.0f / l;
#pragma unroll
        for (int blk = 0; blk < 2; ++blk)
#pragma unroll
            for (int rq = 0; rq < 4; ++rq)
                *(LAS f32x4*)(Os + r32 * AO_STRIDE + (32 * blk + 8 * rq + 4 * hi) * 4) = (f32x4){ot[blk][4 * rq + 0] * inv, ot[blk][4 * rq + 1] * inv, ot[blk][4 * rq + 2] * inv, ot[blk][4 * rq + 3] * inv};
        asm volatile("s_waitcnt lgkmcnt(0)" ::: "memory");
#pragma unroll
        for (int i = 0; i < 4; ++i) {
            const LAS unsigned char* op = Os + (8 * i + orow) * AO_STRIDE + oc8 * 4;
            const f32x4 a = *(const LAS f32x4*)op, c = *(const LAS f32x4*)(op + 16);
            u32x4 w; const u32x4 z = zv[i];
            w.x = cvtpk(a[0] * bf_lo(z.x), a[1] * bf_hi(z.x)); w.y = cvtpk(a[2] * bf_lo(z.y), a[3] * bf_hi(z.y));
            w.z = cvtpk(c[0] * bf_lo(z.z), c[1] * bf_hi(z.z)); w.w = cvtpk(c[2] * bf_lo(z.w), c[3] * bf_hi(z.w));
            *(u32x4*)(G0 + (row0 + 32 * j + 8 * i + orow) * DM + hq * 64 + oc8) = w;
        }
        asm volatile("s_waitcnt lgkmcnt(0)" ::: "memory");
    }
}
__device__ __forceinline__ void p_attention(LAS unsigned char* lds, const bf16_t* QKVZ, const float* sinks, bf16_t* G0, int G) {
    const int tid = threadIdx.x, lane = tid & 63, wid = __builtin_amdgcn_readfirstlane(tid >> 6), r32 = lane & 31, hi = lane >> 5;
    LAS unsigned char* Ks = lds; LAS unsigned char* Vs = lds + AK_BYTES; LAS unsigned char* Os = lds + AK_BYTES + AV_BYTES + wid * AO_BYTES;
    const float NEG = -INFINITY;
    const int orow = lane >> 3, oc8 = (lane & 7) * 8;
    constexpr int NU = NB * 16 * 2;
    u32x4 kreg[4], vreg[4];
#define ATTN_LOAD_KV(uu) do { const int kvh_ = (uu) & 1, n_ = ((uu) >> 1) & 15, b_ = (uu) >> 5; \
        _Pragma("unroll") for (int i = 0; i < 4; ++i) { const int kr_ = (tid + 512 * i) >> 3, tok_ = n_ * 128 - 128 + kr_; \
            kreg[i] = (u32x4){0u, 0u, 0u, 0u}; vreg[i] = (u32x4){0u, 0u, 0u, 0u}; \
            if (tok_ >= 0) { const bf16_t* p_ = QKVZ + ((size_t)b_ * SEQ + tok_) * ATTN_IN + 1024 + kvh_ * 64 + (tid & 7) * 8; kreg[i] = *(const u32x4*)p_; vreg[i] = *(const u32x4*)(p_ + 128); } } } while (0)
    if ((int)blockIdx.x < NU) ATTN_LOAD_KV((int)blockIdx.x);
    bf16x8 qn[4];
    if ((int)blockIdx.x < NU) { const int u0 = blockIdx.x, kvh0 = u0 & 1, n0 = (u0 >> 1) & 15, b0 = u0 >> 5;
#pragma unroll
        for (int d0 = 0; d0 < 4; ++d0) qn[d0] = *(const bf16x8*)(QKVZ + ((size_t)b0 * SEQ + n0 * 128 + r32) * ATTN_IN + (kvh0 * 8 + wid) * 64 + d0 * 16 + hi * 8); }
    for (int u = blockIdx.x; u < NU; u += G) {
        const int kvh = u & 1, n = (u >> 1) & 15, b = u >> 5;
        const size_t rowb = (size_t)b * SEQ;
#pragma unroll
        for (int i = 0; i < 4; ++i) {
            const int kr = (tid + 512 * i) >> 3, ch = tid & 7;
            *(LAS u32x4*)(Ks + kr * AK_STRIDE + ch * 16) = kreg[i];
            *(LAS u32x4*)(Vs + kr * AK_STRIDE + ch * 16) = vreg[i];
        }
        const int hq = kvh * 8 + wid;
        const float sink2 = sinks[hq] * LOG2E;
        const size_t row0 = rowb + n * 128;
        if (u + G < NU) ATTN_LOAD_KV(u + G);
        LDS_BAR();
        if (n > 0) attn_subblocks<true>(Ks, Vs, Os, QKVZ, G0, qn, u, G, NU, row0, hq, sink2, wid, lane, r32, hi, orow, oc8);
        else       attn_subblocks<false>(Ks, Vs, Os, QKVZ, G0, qn, u, G, NU, row0, hq, sink2, wid, lane, r32, hi, orow, oc8);
        LDS_BAR();
    }
#undef ATTN_LOAD_KV
}

constexpr int RC = 32, RQ_STRIDE = 272, R_OSTRIDE = 528;
constexpr int R_QD = 0, R_KR = R_QD + RC * RQ_STRIDE, R_KD = R_KR + RC * RQ_STRIDE, R_V = R_KD + RC * RQ_STRIDE, R_DEC = R_V + RC * RQ_STRIDE, R_O = R_DEC + 512,
              R_BUF = R_O + RC * R_OSTRIDE, R_PS = 2 * R_BUF, R_PSZ = 8 * 128 * 4, R_END = R_PS + 2 * R_PSZ;
struct RecRegs { unsigned q[4], g[4], v[4]; };
struct RecCarry { float cs0[4], cs1[4]; };
__device__ __forceinline__ void rec_load(RecRegs& R, const bf16_t* REC, size_t crow, int wid, int lane) {
#pragma unroll
    for (int i = 0; i < 4; ++i) {
        const bf16_t* rp = REC + (crow + 4 * wid + i) * 512 + 2 * lane;
        R.q[i] = *(const unsigned*)(rp); R.g[i] = *(const unsigned*)(rp + 128); R.v[i] = *(const unsigned*)(rp + 256);
    }
}
__device__ __forceinline__ u32x4 rec_load_z(const bf16_t* REC, size_t crow, int tid) { return *(const u32x4*)(REC + (crow + (tid >> 4)) * 512 + 384 + 8 * (tid & 15)); }
__device__ __forceinline__ void rec_finalize(const LAS unsigned char* obuf, const u32x4& z, const f32x4& gw0, const f32x4& gw1, bf16_t* G1row, int tid) {
    const LAS unsigned char* op = obuf + (tid >> 4) * R_OSTRIDE + (tid & 15) * 32;
    const f32x4 a = *(const LAS f32x4*)op, b = *(const LAS f32x4*)(op + 16);
    float ss = (a[0] * a[0] + a[1] * a[1]) + (a[2] * a[2] + a[3] * a[3]) + (b[0] * b[0] + b[1] * b[1]) + (b[2] * b[2] + b[3] * b[3]);
#pragma unroll
    for (int o = 1; o < 16; o <<= 1) ss += __shfl_xor(ss, o);
    const float rs = rsqrtf(ss * (1.0f / 128.0f) + NORM_EPS);
    const f32x4 x = a * rs * gw0, y = b * rs * gw1;
    u32x4 w;
    w.x = cvtpk(x[0] * bf_lo(z.x), x[1] * bf_hi(z.x)); w.y = cvtpk(x[2] * bf_lo(z.y), x[3] * bf_hi(z.y));
    w.z = cvtpk(y[0] * bf_lo(z.z), y[1] * bf_hi(z.z)); w.w = cvtpk(y[2] * bf_lo(z.w), y[3] * bf_hi(z.w));
    *(u32x4*)G1row = w;
}
__device__ __forceinline__ void rec_cumsum(const RecRegs& R, RecCarry& K, LAS unsigned char* ps, int wid, int lane) {
    float c0 = 0.f, c1 = 0.f;
#pragma unroll
    for (int i = 0; i < 4; ++i) { c0 += h_lo(R.g[i]); c1 += h_hi(R.g[i]); K.cs0[i] = c0; K.cs1[i] = c1; }
    *(LAS f32x2_t*)(ps + (wid * 128 + 2 * lane) * 4) = (f32x2_t){c0, c1};
}
__device__ __forceinline__ void rec_alpha(const RecRegs& R, const RecCarry& K, const LAS unsigned char* ps, LAS unsigned char* buf, int wid, int lane) {
    f32x2_t sp[8];
#pragma unroll
    for (int p = 0; p < 8; ++p) sp[p] = *(const LAS f32x2_t*)(ps + (p * 128 + 2 * lane) * 4);
    const f32x2_t u01 = sp[0] + sp[1], u23 = sp[2] + sp[3], u45 = sp[4] + sp[5], u67 = sp[6] + sp[7];
    const f32x2_t h03 = u01 + u23, tot = h03 + (u45 + u67);
    const int wh = wid >> 1;
    const f32x2_t base = wh == 0 ? (f32x2_t){0.f, 0.f} : (wh == 1 ? u01 : (wh == 2 ? h03 : h03 + u45));
    const f32x2_t oddp = wh == 0 ? sp[0] : (wh == 1 ? sp[2] : (wh == 2 ? sp[4] : sp[6]));
    const f32x2_t pre = (wid & 1) ? base + oddp : base;
    const float et0 = __builtin_amdgcn_exp2f(tot.x), et1 = __builtin_amdgcn_exp2f(tot.y);
#pragma unroll
    for (int i = 0; i < 4; ++i) {
        const int t = 4 * wid + i;
        const float b0 = pre.x + K.cs0[i], b1 = pre.y + K.cs1[i];
        const float qd0 = bf_lo(R.q[i]) * __builtin_amdgcn_exp2f(b0), qd1 = bf_hi(R.q[i]) * __builtin_amdgcn_exp2f(b1);
        const float ki0 = (1.0f - __builtin_amdgcn_exp2f(h_lo(R.g[i]))) * __builtin_amdgcn_exp2f(fminf(-b0, 100.f)), ki1 = (1.0f - __builtin_amdgcn_exp2f(h_hi(R.g[i]))) * __builtin_amdgcn_exp2f(fminf(-b1, 100.f));
        *(LAS unsigned*)(buf + R_QD + t * RQ_STRIDE + lane * 4) = cvtpk(qd0, qd1);
        *(LAS unsigned*)(buf + R_KR + t * RQ_STRIDE + lane * 4) = cvtpk(ki0, ki1);
        *(LAS unsigned*)(buf + R_V + t * RQ_STRIDE + lane * 4) = R.v[i];
    }
    if (wid == 0) *(LAS f32x2_t*)(buf + R_DEC + 2 * lane * 4) = (f32x2_t){et0, et1};
}
__device__ __forceinline__ void rec_mfma(LAS unsigned char* buf, f32x4 (&S)[8], int wid, int c16, int quad) {
    const int tr_row = (c16 >> 2), tr_col = 4 * (c16 & 3);
    f32x4 s00 = (f32x4){0.f, 0.f, 0.f, 0.f}, s01 = s00, s11 = s00;
#pragma unroll
    for (int kk = 0; kk < 4; ++kk) {
        const bf16x8 ka0 = *(const LAS bf16x8*)(buf + R_KR + (c16) * RQ_STRIDE + kk * 64 + quad * 16);
        const bf16x8 ka1 = *(const LAS bf16x8*)(buf + R_KR + (16 + c16) * RQ_STRIDE + kk * 64 + quad * 16);
        const bf16x8 qb0 = *(const LAS bf16x8*)(buf + R_QD + (c16) * RQ_STRIDE + kk * 64 + quad * 16);
        const bf16x8 qb1 = *(const LAS bf16x8*)(buf + R_QD + (16 + c16) * RQ_STRIDE + kk * 64 + quad * 16);
        s00 = __builtin_amdgcn_mfma_f32_16x16x32_bf16(ka0, qb0, s00, 0, 0, 0);
        s01 = __builtin_amdgcn_mfma_f32_16x16x32_bf16(ka0, qb1, s01, 0, 0, 0);
        s11 = __builtin_amdgcn_mfma_f32_16x16x32_bf16(ka1, qb1, s11, 0, 0, 0);
    }
#pragma unroll
    for (int r = 0; r < 4; ++r) { if (4 * quad + r > c16) { s00[r] = 0.f; s11[r] = 0.f; } }
    u32x4 pw0, pw1;
    pw0.x = cvtpk(s00[0], s00[1]); pw0.y = cvtpk(s00[2], s00[3]); pw0.z = 0u; pw0.w = 0u;
    pw1.x = cvtpk(s01[0], s01[1]); pw1.y = cvtpk(s01[2], s01[3]); pw1.z = cvtpk(s11[0], s11[1]); pw1.w = cvtpk(s11[2], s11[3]);
    f32x4 o0 = (f32x4){0.f, 0.f, 0.f, 0.f}, o1 = o0;
#pragma unroll
    for (int jj = 0; jj < 4; ++jj) {
        u32x4 sw; sw.x = cvtpk(S[2 * jj][0], S[2 * jj][1]); sw.y = cvtpk(S[2 * jj][2], S[2 * jj][3]); sw.z = cvtpk(S[2 * jj + 1][0], S[2 * jj + 1][1]); sw.w = cvtpk(S[2 * jj + 1][2], S[2 * jj + 1][3]);
        const bf16x8 sb = __builtin_bit_cast(bf16x8, sw);
        const LAS unsigned char* qp0 = buf + R_QD + (c16) * RQ_STRIDE + (32 * jj + 4 * quad) * 2;
        const LAS unsigned char* qp1 = buf + R_QD + (16 + c16) * RQ_STRIDE + (32 * jj + 4 * quad) * 2;
        const u32x2 a0 = *(const LAS u32x2*)qp0, a1 = *(const LAS u32x2*)(qp0 + 32), a2 = *(const LAS u32x2*)qp1, a3 = *(const LAS u32x2*)(qp1 + 32);
        o0 = __builtin_amdgcn_mfma_f32_16x16x32_bf16(__builtin_bit_cast(bf16x8, (u32x4){a0.x, a0.y, a1.x, a1.y}), sb, o0, 0, 0, 0);
        o1 = __builtin_amdgcn_mfma_f32_16x16x32_bf16(__builtin_bit_cast(bf16x8, (u32x4){a2.x, a2.y, a3.x, a3.y}), sb, o1, 0, 0, 0);
    }
    {
        const LAS unsigned char* vp = buf + R_V + (4 * quad + tr_row) * RQ_STRIDE + (16 * wid + tr_col) * 2;
        const bf16x8 vb = tr8(vp, vp + 16 * RQ_STRIDE);
        o0 = __builtin_amdgcn_mfma_f32_16x16x32_bf16(__builtin_bit_cast(bf16x8, pw0), vb, o0, 0, 0, 0);
        o1 = __builtin_amdgcn_mfma_f32_16x16x32_bf16(__builtin_bit_cast(bf16x8, pw1), vb, o1, 0, 0, 0);
    }
#pragma unroll
    for (int r = 0; r < 4; ++r) {
        *(LAS float*)(buf + R_O + (4 * quad + r) * R_OSTRIDE + (16 * wid + c16) * 4) = o0[r];
        *(LAS float*)(buf + R_O + (16 + 4 * quad + r) * R_OSTRIDE + (16 * wid + c16) * 4) = o1[r];
    }
    {
        const LAS unsigned char* vp = buf + R_V + (8 * quad + tr_row) * RQ_STRIDE + (16 * wid + tr_col) * 2;
        const bf16x8 vb = tr8(vp, vp + 4 * RQ_STRIDE);
        const LAS unsigned char* kp = buf + R_KR + (8 * quad + tr_row) * RQ_STRIDE + tr_col * 2;
#pragma unroll
        for (int kt = 0; kt < 8; ++kt) {
            const f32x4 dv = *(const LAS f32x4*)(buf + R_DEC + (16 * kt + 4 * quad) * 4);
            const bf16x8 ka = tr8(kp + kt * 32, kp + kt * 32 + 4 * RQ_STRIDE);
            S[kt] = __builtin_amdgcn_mfma_f32_16x16x32_bf16(ka, vb, S[kt], 0, 0, 0) * dv;
        }
    }
}
__device__ __forceinline__ void rec_iter(LAS unsigned char* lds, const bf16_t* REC, size_t hrow, bf16_t* G1t, int c, RecRegs& R0, RecRegs& R1, RecRegs& R2, RecCarry& K, u32x4& znext,
                                         f32x4 (&S)[8], const f32x4& gw0, const f32x4& gw1, int tid, int lane, int wid, int c16, int quad) {
    constexpr int NC = SEQ / RC;
    const u32x4 zfin = znext;
    znext = rec_load_z(REC, hrow + (size_t)c * RC, tid);
    { const int cn = (c + 3 < NC) ? c + 3 : NC - 1; rec_load(R0, REC, hrow + (size_t)cn * RC, wid, lane); }
    LAS unsigned char* buf = lds + (c & 1) * R_BUF;
    if (c > 0) rec_finalize(lds + ((c & 1) ^ 1) * R_BUF + R_O, zfin, gw0, gw1, G1t + (size_t)(c - 1) * RC * DM, tid);
    rec_mfma(buf, S, wid, c16, quad);
    if (c + 1 < NC) rec_alpha(R1, K, lds + R_PS + ((c + 1) & 1) * R_PSZ, lds + ((c + 1) & 1) * R_BUF, wid, lane);
    if (c + 2 < NC) rec_cumsum(R2, K, lds + R_PS + (c & 1) * R_PSZ, wid, lane);
    LDS_BAR();
}
__device__ __forceinline__ void p_recurrence(LAS unsigned char* lds, const bf16_t* REC, const float* gnw, bf16_t* G1, int G) {
    const int tid = threadIdx.x, lane = tid & 63, wid = __builtin_amdgcn_readfirstlane(tid >> 6), c16 = lane & 15, quad = lane >> 4;
    constexpr int NC = SEQ / RC;
    static_assert(NC % 3 == 1, "chunk loop is unrolled by 3 with one tail chunk");
    for (int u = blockIdx.x; u < NB * 8; u += G) {
        const int b = u >> 3, h = u & 7;
        const size_t hrow = (size_t)u * SEQ;
        const f32x4 gw0 = *(const f32x4*)(gnw + 8 * (tid & 15)), gw1 = *(const f32x4*)(gnw + 8 * (tid & 15) + 4);
        bf16_t* G1t = G1 + ((size_t)b * SEQ + (tid >> 4)) * DM + h * 128 + 8 * (tid & 15);
        f32x4 S[8];
#pragma unroll
        for (int kt = 0; kt < 8; ++kt) S[kt] = (f32x4){0.f, 0.f, 0.f, 0.f};
        RecRegs A, B, C; RecCarry K; u32x4 znext = (u32x4){0u, 0u, 0u, 0u};
        rec_load(A, REC, hrow, wid, lane); rec_load(B, REC, hrow + RC, wid, lane); rec_load(C, REC, hrow + 2 * RC, wid, lane);
        rec_cumsum(A, K, lds + R_PS, wid, lane);
        LDS_BAR();
        rec_alpha(A, K, lds + R_PS, lds, wid, lane);
        rec_cumsum(B, K, lds + R_PS + R_PSZ, wid, lane);
        LDS_BAR();
        for (int c = 0; c < NC - 1; c += 3) {
            rec_iter(lds, REC, hrow, G1t, c, A, B, C, K, znext, S, gw0, gw1, tid, lane, wid, c16, quad);
            rec_iter(lds, REC, hrow, G1t, c + 1, B, C, A, K, znext, S, gw0, gw1, tid, lane, wid, c16, quad);
            rec_iter(lds, REC, hrow, G1t, c + 2, C, A, B, K, znext, S, gw0, gw1, tid, lane, wid, c16, quad);
        }
        rec_iter(lds, REC, hrow, G1t, NC - 1, A, B, C, K, znext, S, gw0, gw1, tid, lane, wid, c16, quad);
        rec_finalize(lds + ((NC - 1) & 1) * R_BUF + R_O, znext, gw0, gw1, G1t + (size_t)(NC - 1) * RC * DM, tid);
        LDS_BAR();
    }
}

#define XB_TMO      128
#define XB_XCNT(j)  (256  + 64 * (j))
#define XB_XSUB(j)  (1280 + 64 * (j))
#define XB_XGEN(j)  (2304 + 64 * (j))
#define XB_TOP      3328
#define XB_TOPGEN   3392
#define XCD_BAR_WORDS 3456
#define XB_SPIN_CAP (1u << 18)
__device__ __forceinline__ unsigned xb_ld(unsigned* p)              { return __hip_atomic_load(p, __ATOMIC_RELAXED, __HIP_MEMORY_SCOPE_AGENT); }
__device__ __forceinline__ unsigned xb_add(unsigned* p, unsigned v) { return __hip_atomic_fetch_add(p, v, __ATOMIC_RELAXED, __HIP_MEMORY_SCOPE_AGENT); }
__device__ __forceinline__ unsigned xb_xcc_id() { return (unsigned)__builtin_amdgcn_s_getreg((3 << 11) | 20) & 0xFu; }
#define XB_SPIN(cond, bar) do { unsigned _sp = 0; while (cond) { __builtin_amdgcn_s_sleep(1); \
    if ((++_sp & 255u) == 0u) { if (xb_ld(&(bar)[XB_TMO])) break; if (_sp > XB_SPIN_CAP) { atomicAdd(&(bar)[XB_TMO], 1u); break; } } } } while (0)
struct XcdBarrier { unsigned* bar; unsigned x; volatile LAS unsigned* st; };
__device__ __forceinline__ XcdBarrier xcd_barrier_post(unsigned* bar, volatile LAS unsigned* st) {
    XcdBarrier b; b.bar = bar; b.x = xb_xcc_id(); b.st = st;
    if (threadIdx.x == 0) (void)xb_add(&bar[XB_XCNT(b.x)], 1u);
    return b;
}
__device__ __forceinline__ void xcd_barrier_complete(unsigned* bar, unsigned x, unsigned& nloc, unsigned& nx) {
    const unsigned G = gridDim.x * gridDim.y * gridDim.z;
    unsigned sum, cnt, mine, sp = 0u;
    for (;;) {
        sum = 0u; cnt = 0u; mine = 0u;
#pragma unroll
        for (unsigned j = 0; j < 16; ++j) { const unsigned c = xb_ld(&bar[XB_XCNT(j)]); sum += c; cnt += (c > 0u) ? 1u : 0u; mine = (j == x) ? c : mine; }
        if (sum == G) break;
        __builtin_amdgcn_s_sleep(1);
        if ((++sp & 255u) == 0u) { if (xb_ld(&bar[XB_TMO])) break; if (sp > XB_SPIN_CAP) { atomicAdd(&bar[XB_TMO], 1u); break; } }
    }
    nloc = mine > 0u ? mine : 1u; nx = cnt > 0u ? cnt : 1u;
}
__device__ __forceinline__ void xcd_barrier(const XcdBarrier& b) {
    asm volatile("s_waitcnt vmcnt(0)" ::: "memory");
    __syncthreads();
    if (threadIdx.x == 0) {
        unsigned* bar = b.bar;
        __builtin_amdgcn_s_waitcnt(0);
        unsigned nloc = b.st[0], nx = b.st[1];
        if (nloc == 0u) { xcd_barrier_complete(bar, b.x, nloc, nx); b.st[0] = nloc; b.st[1] = nx; }
        const unsigned old = xb_add(&bar[XB_XSUB(b.x)], 1u);
        const unsigned gen = old / nloc;
        if (old + 1u == (gen + 1u) * nloc) {
            __builtin_amdgcn_fence(__ATOMIC_RELEASE, "agent");
            asm volatile("s_waitcnt vmcnt(0)" ::: "memory");
            const unsigned og = xb_add(&bar[XB_TOP], 1u);
            const unsigned tg = og / nx;
            if (og + 1u == (tg + 1u) * nx) xb_add(&bar[XB_TOPGEN], 1u);
            else XB_SPIN(xb_ld(&bar[XB_TOPGEN]) == tg, bar);
            __builtin_amdgcn_fence(__ATOMIC_ACQUIRE, "agent");
            xb_add(&bar[XB_XGEN(b.x)], 1u);
            asm volatile("s_waitcnt vmcnt(0)" ::: "memory");
        } else {
            XB_SPIN(xb_ld(&bar[XB_XGEN(b.x)]) == gen, bar);
            __builtin_amdgcn_fence(__ATOMIC_ACQUIRE, "agent");
            asm volatile("s_waitcnt vmcnt(0)" ::: "memory");
        }
    }
    __syncthreads();
}

constexpr int MISC_OFF = 147456 - 64;
constexpr int XCH_OFF = 131072;
constexpr int LDS_BYTES = 147456;
static_assert(pg8::STAGE_BYTES <= LDS_BYTES && ATTN_LDS <= MISC_OFF && R_END <= LDS_BYTES, "LDS map");
constexpr int N_PHASES = 9;
#define PROBE_LO -1
#define PROBE_HI 2
#define PROBE_NULL 0

__global__ void __launch_bounds__(512, 2) hybrid_fwd(Args a) {
    extern __shared__ __attribute__((aligned(16))) unsigned char lds_raw[];
    LAS unsigned char* lds = (LAS unsigned char*)lds_raw;
    cg::grid_group grid = cg::this_grid();
    const int G = gridDim.x;
    const int lo = a.ph_lo, hi = a.ph_hi;
    unsigned char* ws = a.ws;
#define IN(k) (lo <= (k) && (k) < hi)
#define SEAM(k) do { if (IN(k) && IN((k) + 1)) xcd_barrier(xbar); } while (0)
    unsigned* barw = (unsigned*)(ws + WS_BAR);
    volatile LAS unsigned* misc = (volatile LAS unsigned*)(lds + MISC_OFF);
    if (blockIdx.x == 0) for (int i = threadIdx.x; i < XCD_BAR_WORDS; i += 512) __hip_atomic_store(barw + i, 0u, __ATOMIC_RELAXED, __HIP_MEMORY_SCOPE_AGENT);
    if (threadIdx.x < 2) misc[threadIdx.x] = 0u;
    __syncthreads();
    grid.sync();
    XcdBarrier xbar = xcd_barrier_post(barw, misc);
    if (IN(0)) { p_prologue(a, lds, G); __syncthreads(); }
    SEAM(0);
    if (IN(1)) {
        pg8::Gemm g{(const bf16_t*)(ws + WS_H), (const bf16_t*)(ws + WS_WIN0), MTOK, ATTN_IN, DM}; pg8::StaticOrder S; S.init(MTOK, ATTN_IN, G, (int)blockIdx.x);
        pg8::EpiAttnIn E{(bf16_t*)(ws + WS_QKVZ), (const float*)(ws + WS_BIASP), (const unsigned*)(ws + WS_ROPE)};
#if PROBE_NULL
        if (a.flags) { pg8::EpiAttnInT<true> EN{(bf16_t*)(ws + WS_QKVZ), (const float*)(ws + WS_BIASP), (const unsigned*)(ws + WS_ROPE)}; pg8::gemm_phase<pg8::EpiAttnInT<true>, true, true>(lds, g, S, EN); } else
#endif
        pg8::gemm_phase<pg8::EpiAttnIn, true, true>(lds, g, S, E);
    }
    SEAM(1);
    if (IN(2)) p_attention(lds, (const bf16_t*)(ws + WS_QKVZ), a.a_sinks, (bf16_t*)(ws + WS_G0), G);
    SEAM(2);
    if (IN(3)) {
        pg8::Gemm g{(const bf16_t*)(ws + WS_G0), (const bf16_t*)(ws + WS_WOUT0), MTOK, DM, DM}; pg8::StaticOrder S; S.init(MTOK, DM, G, (int)blockIdx.x);
        pg8::EpiOut E{(bf16_t*)(ws + WS_Y), a.a_bout, (float*)(ws + WS_PART), (LAS float*)(lds + XCH_OFF)};
#if PROBE_NULL
        if (a.flags) { pg8::EpiNull EN{(float*)(ws + WS_PART)}; pg8::gemm_phase<pg8::EpiNull, true, true>(lds, g, S, EN); } else
#endif
        pg8::gemm_phase<pg8::EpiOut, true, true>(lds, g, S, E);
    }
    SEAM(3);
    if (IN(4)) p_mid((const bf16_t*)(ws + WS_Y), (const float*)(ws + WS_PART), a.x, a.post_w, a.pre_w + DM, (bf16_t*)(ws + WS_H), G);
    SEAM(4);
    if (IN(5)) {
        pg8::Gemm g{(const bf16_t*)(ws + WS_H), (const bf16_t*)(ws + WS_WIN1), MTOK, REC_IN, DM}; pg8::StaticOrder S; S.init(MTOK, REC_IN, G, (int)blockIdx.x);
        pg8::EpiRecIn E{(bf16_t*)(ws + WS_BIG), (const float*)(ws + WS_LB)};
#if PROBE_NULL
        if (a.flags) { pg8::EpiRecInT<true> EN{(bf16_t*)(ws + WS_BIG), (const float*)(ws + WS_LB)}; pg8::gemm_phase<pg8::EpiRecInT<true>, true, true>(lds, g, S, EN); } else
#endif
        pg8::gemm_phase<pg8::EpiRecIn, true, true>(lds, g, S, E);
    }
    SEAM(5);
    if (IN(6)) p_recurrence(lds, (const bf16_t*)(ws + WS_BIG), a.r_gw, (bf16_t*)(ws + WS_G1), G);
    SEAM(6);
    if (IN(7)) {
        pg8::Gemm g{(const bf16_t*)(ws + WS_G1), (const bf16_t*)(ws + WS_WOUT1), MTOK, DM, DM}; pg8::StaticOrder S; S.init(MTOK, DM, G, (int)blockIdx.x);
        pg8::EpiOut E{(bf16_t*)(ws + WS_H), nullptr, (float*)(ws + WS_PART1), (LAS float*)(lds + XCH_OFF)};
        pg8::gemm_phase<pg8::EpiOut, true, true>(lds, g, S, E);
    }
    SEAM(7);
    if (IN(8)) p_final((const bf16_t*)(ws + WS_Y), (const float*)(ws + WS_PART), (const bf16_t*)(ws + WS_H), (const float*)(ws + WS_PART1), a.x, a.post_w, a.post_w + DM, a.out, G);
#undef IN
#undef SEAM
}

extern "C" void kernel_launch(void* const* d_in, const int* in_sizes, int n_in, void* d_out, int out_size, void* d_ws, size_t ws_size, hipStream_t stream) {
    static int grid = 0;
    if (grid == 0) {
        if (n_in != 13 || in_sizes[0] != MTOK * DM || out_size != MTOK * DM || ws_size < WS_END) { fprintf(stderr, "kernel_launch: unexpected shapes (n_in %d, ws %zu < %zu)\n", n_in, ws_size, (size_t)WS_END); grid = -1; return; }
        int dev = 0, cus = 0, per_cu = 0;
        hipGetDevice(&dev); hipDeviceGetAttribute(&cus, hipDeviceAttributeMultiprocessorCount, dev);
        if (hipFuncSetAttribute((const void*)hybrid_fwd, hipFuncAttributeMaxDynamicSharedMemorySize, LDS_BYTES) != hipSuccess) { fprintf(stderr, "kernel_launch: hipFuncSetAttribute failed\n"); grid = -1; return; }
        if (hipOccupancyMaxActiveBlocksPerMultiprocessor(&per_cu, (const void*)hybrid_fwd, 512, LDS_BYTES) != hipSuccess || per_cu < 1) { fprintf(stderr, "kernel_launch: occupancy query says %d\n", per_cu); per_cu = 1; }
        (void)hipGetLastError();
        grid = cus * 1;
    }
    if (grid < 0) return;
    Args a{};
    a.x = (const float*)d_in[0]; a.pos = (const int*)d_in[1]; a.pre_w = (const float*)d_in[2]; a.post_w = (const float*)d_in[3];
    a.a_win = (const float*)d_in[4]; a.a_bin = (const float*)d_in[5]; a.a_sinks = (const float*)d_in[6]; a.a_wout = (const float*)d_in[7]; a.a_bout = (const float*)d_in[8];
    a.r_win = (const float*)d_in[9]; a.r_lbl = (const float*)d_in[10]; a.r_gw = (const float*)d_in[11]; a.r_wout = (const float*)d_in[12];
    a.out = (float*)d_out; a.ws = (unsigned char*)d_ws;
    void* args[] = {&a};
#if PROBE_LO >= 0
#if PROBE_NULL
    a.ph_lo = 0; a.ph_hi = PROBE_LO;
    if (PROBE_LO > 0) (void)hipLaunchCooperativeKernel((const void*)hybrid_fwd, dim3(grid), dim3(512), args, LDS_BYTES, stream);
    a.ph_lo = PROBE_LO; a.ph_hi = PROBE_HI; a.flags = 1;
    (void)hipLaunchCooperativeKernel((const void*)hybrid_fwd, dim3(grid), dim3(512), args, LDS_BYTES, stream);
    a.flags = 0;
#else
    a.ph_lo = 0; a.ph_hi = PROBE_HI;
    (void)hipLaunchCooperativeKernel((const void*)hybrid_fwd, dim3(grid), dim3(512), args, LDS_BYTES, stream);
#endif
    a.ph_lo = PROBE_LO; a.ph_hi = N_PHASES;
#else
    a.ph_lo = 0; a.ph_hi = N_PHASES;
#endif
    hipError_t e = hipLaunchCooperativeKernel((const void*)hybrid_fwd, dim3(grid), dim3(512), args, LDS_BYTES, stream);
    if (e != hipSuccess) fprintf(stderr, "kernel_launch: cooperative launch failed: %s (grid %d)\n", hipGetErrorString(e), grid);
}
```

```cpp
#include <hip/hip_runtime.h>
#include <hip/hip_cooperative_groups.h>
#include <cstdio>
#include <cstdint>
namespace cg = cooperative_groups;

#define LAS __attribute__((address_space(3)))
typedef unsigned short bf16_t;
typedef short bf16x8 __attribute__((ext_vector_type(8)));
typedef float f32x4 __attribute__((ext_vector_type(4)));
typedef float f32x16 __attribute__((ext_vector_type(16)));
typedef unsigned u32x4 __attribute__((ext_vector_type(4)));
typedef unsigned u32x2 __attribute__((ext_vector_type(2)));
typedef float f32x2_t __attribute__((ext_vector_type(2)));
typedef __bf16 bf16x2_t __attribute__((ext_vector_type(2)));
typedef _Float16 f16x2_t __attribute__((ext_vector_type(2)));

constexpr int NB = 32, SEQ = 2048, DM = 1024, MTOK = NB * SEQ;
constexpr int ATTN_IN = 2304, REC_IN = 4096;
constexpr float NORM_EPS = 1e-6f;
constexpr float LOG2E = 1.4426950408889634f;
constexpr float QSCALE = 0.125f * 1.4426950408889634f;

constexpr size_t WS_WIN0 = 0;
constexpr size_t WS_WOUT0 = WS_WIN0 + (size_t)ATTN_IN * DM * 2;
constexpr size_t WS_WIN1 = WS_WOUT0 + (size_t)DM * DM * 2;
constexpr size_t WS_WOUT1 = WS_WIN1 + (size_t)REC_IN * DM * 2;
constexpr size_t WS_ROPE = WS_WOUT1 + (size_t)DM * DM * 2;
constexpr size_t WS_LB = WS_ROPE + (size_t)MTOK * 16 * 4;
constexpr size_t WS_BIASP = WS_LB + 4096;
constexpr size_t WS_BAR = WS_BIASP + 12288;
constexpr size_t WS_PART = WS_BAR + 16384;
constexpr size_t WS_PART1 = WS_PART + (size_t)MTOK * 16 * 4;
constexpr size_t WS_H = WS_PART1 + (size_t)MTOK * 16 * 4;
constexpr size_t WS_Y = WS_H + (size_t)MTOK * DM * 2;
constexpr size_t WS_G1 = WS_Y + (size_t)MTOK * DM * 2;
constexpr size_t WS_BIG = WS_G1 + (size_t)MTOK * DM * 2;
constexpr size_t WS_QKVZ = WS_BIG;
constexpr size_t WS_G0 = WS_QKVZ + (size_t)MTOK * ATTN_IN * 2;
constexpr size_t WS_VT = WS_G0 + (size_t)MTOK * DM * 2;
constexpr size_t WS_END = WS_BIG + (size_t)MTOK * REC_IN * 2;
static_assert(WS_VT + (size_t)MTOK * 128 * 2 <= WS_END, "overlay");

#define LDS_BAR() do { asm volatile("s_waitcnt lgkmcnt(0)" ::: "memory"); __builtin_amdgcn_s_barrier(); asm volatile("" ::: "memory"); } while (0)
__device__ __forceinline__ unsigned cvtpk(float lo, float hi) { f32x2_t v = {lo, hi}; bf16x2_t b = __builtin_convertvector(v, bf16x2_t); return __builtin_bit_cast(unsigned, b); }
__device__ __forceinline__ unsigned cvtpk_h(float lo, float hi) { f32x2_t v = {lo, hi}; f16x2_t b = __builtin_convertvector(v, f16x2_t); return __builtin_bit_cast(unsigned, b); }
__device__ __forceinline__ float bf_lo(unsigned u) { return __uint_as_float(u << 16); }
__device__ __forceinline__ float bf_hi(unsigned u) { return __uint_as_float(u & 0xffff0000u); }
__device__ __forceinline__ float h_lo(unsigned u) { f16x2_t h = __builtin_bit_cast(f16x2_t, u); return (float)h[0]; }
__device__ __forceinline__ float h_hi(unsigned u) { f16x2_t h = __builtin_bit_cast(f16x2_t, u); return (float)h[1]; }
__device__ __forceinline__ float silu_f(float v) { return v * __builtin_amdgcn_rcpf(1.0f + __expf(-v)); }
__device__ __forceinline__ float wave_sum(float v) {
#pragma unroll
    for (int o = 1; o < 64; o <<= 1) v += __shfl_xor(v, o);
    return v;
}

__host__ __device__ __forceinline__ int rope_src_col(int c) { return (c < 1152 && (c & 63) < 16) ? ((c & ~15) | (((c & 15) >> 1) + 8 * (c & 1))) : c; }

#ifndef SKEW_TICKS
#define SKEW_TICKS 0
#endif
namespace pg8 {
constexpr int BM = 256, BK = 64, HALF = 128, HTB = HALF * BK * 2, STAGE_BYTES = 8 * HTB, NXCD = 8, WGM = 8;
__host__ __device__ __forceinline__ int lds_byte(int r, int c) { const int st = (r >> 4) * 2 + (c >> 5), rr = r & 15, cc = c & 31, ob = rr * 64 + cc * 2; return st * 1024 + (ob ^ (((ob >> 9) & 1) << 5)); }
__host__ __device__ __forceinline__ void stage_rc(int b, int& R, int& C) { const int st = b / 1024, sb = b % 1024, swz = sb ^ (((sb >> 9) & 1) << 5); R = (st >> 1) * 16 + swz / 64; C = (st & 1) * 32 + (swz % 64) / 2; }
__host__ __device__ __forceinline__ int perm32(int rho) { const int n = rho >> 4, i = rho & 15; return 8 * (i >> 2) + 4 * n + (i & 3); }

struct Unit { int pm, pn; };
struct Gemm { const bf16_t* A; const bf16_t* Bt; int M, N, K; };

struct StaticOrder {
    int nM, nN, nwg, G, c;
    __host__ __device__ void init(int M, int N, int G_, int c_) { nM = M / BM; nN = N / BM; nwg = nM * nN; G = G_; c = c_; }
    __host__ __device__ bool next(int i, Unit& u) const {
        const long L = (long)i * G + c; if (L >= nwg) return false;
        int wgid = (int)L; { const int q = nwg / NXCD, r = nwg % NXCD, xcd = wgid % NXCD, off = wgid / NXCD; wgid = (xcd < r ? xcd * (q + 1) : r * (q + 1) + (xcd - r) * q) + off; }
        const int nig = WGM * nN, gid = wgid / nig, fm = gid * WGM, gsz = (nM - fm) < WGM ? (nM - fm) : WGM;
        u.pm = fm + ((wgid % nig) % gsz); u.pn = (wgid % nig) / gsz; return true;
    }
};

template <class Epi, bool ALIGN_EPI, bool SP2>
__device__ __forceinline__ void gemm_phase(LAS unsigned char* lds, const Gemm g, const StaticOrder& S, const Epi& E) {
    const int tid = threadIdx.x, wid = __builtin_amdgcn_readfirstlane(tid >> 6), lane = tid & 63, wr = wid >> 2, wc = wid & 3, fr = lane & 15, fq = lane >> 4;
    const int K = g.K, nt = K / BK;
    unsigned voffA[2], voffB[2];
#pragma unroll
    for (int i = 0; i < 2; ++i) { int R, C; stage_rc(tid * 16 + i * 8192, R, C); const int Rb = Epi::PERM ? ((R & ~31) + perm32(R & 31)) : R;
        voffA[i] = (unsigned)(R * K + C) * 2u; voffB[i] = (unsigned)(Rb * K + C) * 2u; }
    const size_t kstep = (size_t)(BK * 2);
    const size_t hstep = (size_t)HALF * K * 2;
    const size_t tstep = 2 * hstep;
    const unsigned ldsw = (unsigned)wid * 1024u;
    const int aoff = lds_byte(wr * 64 + fr, fq * 8), boff = lds_byte(wc * 32 + fr, fq * 8);
#define PG8_SA(b, h) (((b) * 2 + (h)) * HTB)
#define PG8_SB(b, h) ((4 + (b) * 2 + (h)) * HTB)
#define PG8_STAGE(bufoff, gbase, voff) do { _Pragma("unroll") for (int _i = 0; _i < 2; ++_i) \
        __builtin_amdgcn_global_load_lds((const unsigned*)((const char*)(gbase) + (voff)[_i]), (LAS unsigned*)(lds + (bufoff) + ldsw + _i * 8192), 16, 0, 0); } while (0)
#define PG8_LDA(dst, b, h) do { _Pragma("unroll") for (int m = 0; m < 4; ++m) _Pragma("unroll") for (int k = 0; k < 2; ++k) dst[m][k] = *(const LAS bf16x8*)(lds + PG8_SA(b, h) + aoff + m * 2048 + k * 1024); } while (0)
#define PG8_LDB(dst, b, h) do { _Pragma("unroll") for (int n = 0; n < 2; ++n) _Pragma("unroll") for (int k = 0; k < 2; ++k) dst[n][k] = *(const LAS bf16x8*)(lds + PG8_SB(b, h) + boff + n * 2048 + k * 1024); } while (0)
#define PG8_MMA(ai, bj, Af, Bf) do { __builtin_amdgcn_s_setprio(1); _Pragma("unroll") for (int m = 0; m < 4; ++m) _Pragma("unroll") for (int n = 0; n < 2; ++n) _Pragma("unroll") for (int k = 0; k < 2; ++k) \
        acc[ai][bj][m][n] = __builtin_amdgcn_mfma_f32_16x16x32_bf16(Bf[n][k], Af[m][k], acc[ai][bj][m][n], 0, 0, 0); __builtin_amdgcn_s_setprio(0); } while (0)
#define PG8_WAIT_V(n) asm volatile("s_waitcnt vmcnt(" #n ")" ::: "memory")
#define PG8_WAIT_L(n) asm volatile("s_waitcnt lgkmcnt(" #n ")" ::: "memory")
#define PG8_BAR __builtin_amdgcn_s_barrier()
#define PG8_SCHED __builtin_amdgcn_sched_barrier(0)
    Unit cur, nxt; int ui = 0;
    if (!S.next(0, cur)) return;
    if (SKEW_TICKS > 0) {
        const unsigned long long t0 = __builtin_amdgcn_s_memrealtime(), dl = (unsigned long long)(((unsigned)blockIdx.x >> 3) & 3u) * SKEW_TICKS;
        while (__builtin_amdgcn_s_memrealtime() - t0 < dl) __builtin_amdgcn_s_sleep(8);
    }
    f32x4 acc[2][2][4][2];
#pragma unroll
    for (int a = 0; a < 2; ++a)
#pragma unroll
        for (int b = 0; b < 2; ++b)
#pragma unroll
            for (int m = 0; m < 4; ++m)
#pragma unroll
                for (int n = 0; n < 2; ++n) acc[a][b][m][n] = (f32x4){0.f, 0.f, 0.f, 0.f};
    bf16x8 At[4][2], B0[2][2], B1[2][2];
    const char* cA = (const char*)g.A + (size_t)cur.pm * tstep; const char* cB = (const char*)g.Bt + (size_t)cur.pn * tstep;
    if constexpr (SP2) {
        PG8_STAGE(PG8_SB(0, 0), cB, voffB); PG8_STAGE(PG8_SB(0, 1), cB + hstep, voffB); PG8_STAGE(PG8_SA(0, 0), cA, voffA); PG8_STAGE(PG8_SA(0, 1), cA + hstep, voffA);
        if (wr == 1) PG8_BAR;
        PG8_WAIT_V(2); PG8_BAR;
        PG8_STAGE(PG8_SB(1, 0), cB + kstep, voffB); PG8_STAGE(PG8_SA(1, 0), cA + kstep, voffA); PG8_STAGE(PG8_SB(1, 1), cB + hstep + kstep, voffB);
        PG8_WAIT_V(6); PG8_BAR;
    } else {
        PG8_STAGE(PG8_SB(0, 0), cB, voffB); PG8_STAGE(PG8_SA(0, 0), cA, voffA); PG8_STAGE(PG8_SB(0, 1), cB + hstep, voffB); PG8_STAGE(PG8_SA(0, 1), cA + hstep, voffA);
        if (wr == 1) PG8_BAR;
        PG8_WAIT_V(4); PG8_BAR;
        PG8_STAGE(PG8_SB(1, 0), cB + kstep, voffB); PG8_STAGE(PG8_SA(1, 0), cA + kstep, voffA); PG8_STAGE(PG8_SB(1, 1), cB + hstep + kstep, voffB);
        PG8_WAIT_V(6); PG8_BAR;
    }
    for (;;) {
        const bool has_next = S.next(ui + 1, nxt);
        const char* nA = has_next ? (const char*)g.A + (size_t)nxt.pm * tstep : cA; const char* nB = has_next ? (const char*)g.Bt + (size_t)nxt.pn * tstep : cB;
        for (int t = 0; t < nt; t += 2) {
            const bool last = (t == nt - 2);
            const char* a1 = cA + (size_t)(t + 1) * kstep;
            const char* a2 = last ? nA : cA + (size_t)(t + 2) * kstep; const char* b2 = last ? nB : cB + (size_t)(t + 2) * kstep;
            const char* a3 = a2 + kstep; const char* b3 = b2 + kstep;
            if constexpr (SP2) {
            PG8_LDB(B0, 0, 0); PG8_LDB(B1, 0, 1); PG8_SCHED; PG8_LDA(At, 0, 0); PG8_STAGE(PG8_SA(1, 1), a1 + hstep, voffA);
            PG8_WAIT_V(8); PG8_WAIT_L(0); PG8_BAR; PG8_MMA(0, 0, At, B0); PG8_MMA(0, 1, At, B1); PG8_BAR; PG8_SCHED;
            PG8_LDA(At, 0, 1); PG8_STAGE(PG8_SB(0, 0), b2, voffB); PG8_STAGE(PG8_SB(0, 1), b2 + hstep, voffB); PG8_STAGE(PG8_SA(0, 0), a2, voffA);
            PG8_WAIT_V(8); PG8_WAIT_L(0); PG8_BAR; PG8_MMA(1, 0, At, B0); PG8_MMA(1, 1, At, B1); PG8_BAR; PG8_SCHED;
            PG8_LDB(B0, 1, 0); PG8_LDB(B1, 1, 1); PG8_SCHED; PG8_LDA(At, 1, 0); PG8_STAGE(PG8_SA(0, 1), a2 + hstep, voffA);
            PG8_WAIT_V(8); PG8_WAIT_L(0); PG8_BAR; PG8_MMA(0, 0, At, B0); PG8_MMA(0, 1, At, B1); PG8_BAR; PG8_SCHED;
            PG8_LDA(At, 1, 1); PG8_STAGE(PG8_SB(1, 0), b3, voffB); PG8_STAGE(PG8_SB(1, 1), b3 + hstep, voffB); PG8_STAGE(PG8_SA(1, 0), a3, voffA);
            PG8_WAIT_V(8); PG8_WAIT_L(0); PG8_BAR; PG8_MMA(1, 0, At, B0); PG8_MMA(1, 1, At, B1); PG8_BAR; PG8_SCHED;
            } else {
            PG8_LDB(B0, 0, 0); PG8_SCHED; PG8_LDA(At, 0, 0); PG8_STAGE(PG8_SA(1, 1), a1 + hstep, voffA);
            PG8_WAIT_L(8); PG8_BAR; PG8_WAIT_L(0); PG8_MMA(0, 0, At, B0); PG8_BAR; PG8_SCHED;
            PG8_LDB(B1, 0, 1); PG8_STAGE(PG8_SB(0, 0), b2, voffB);
            PG8_BAR; PG8_WAIT_L(0); PG8_MMA(0, 1, At, B1); PG8_BAR;
            PG8_LDA(At, 0, 1); PG8_STAGE(PG8_SA(0, 0), a2, voffA);
            PG8_BAR; PG8_WAIT_L(0); PG8_MMA(1, 0, At, B0); PG8_BAR; PG8_SCHED;
            PG8_STAGE(PG8_SB(0, 1), b2 + hstep, voffB);
            PG8_WAIT_V(6); PG8_BAR; PG8_MMA(1, 1, At, B1); PG8_BAR;
            PG8_LDB(B0, 1, 0); PG8_SCHED; PG8_LDA(At, 1, 0); PG8_STAGE(PG8_SA(0, 1), a2 + hstep, voffA);
            PG8_WAIT_L(8); PG8_BAR; PG8_WAIT_L(0); PG8_MMA(0, 0, At, B0); PG8_BAR; PG8_SCHED;
            PG8_LDB(B1, 1, 1); PG8_STAGE(PG8_SB(1, 0), b3, voffB);
            PG8_BAR; PG8_WAIT_L(0); PG8_MMA(0, 1, At, B1); PG8_BAR;
            PG8_LDA(At, 1, 1); PG8_STAGE(PG8_SA(1, 0), a3, voffA);
            PG8_BAR; PG8_WAIT_L(0); PG8_MMA(1, 0, At, B0); PG8_BAR; PG8_SCHED;
            PG8_STAGE(PG8_SB(1, 1), b3 + hstep, voffB);
            PG8_WAIT_V(6); PG8_BAR; PG8_MMA(1, 1, At, B1); PG8_BAR;
            }
        }
        if constexpr (ALIGN_EPI) { if (wr == 0) PG8_BAR; }
        E(acc, cur, wr, wc, fr, fq);
        if (!has_next) break;
#pragma unroll
        for (int a = 0; a < 2; ++a)
#pragma unroll
            for (int b = 0; b < 2; ++b)
#pragma unroll
                for (int m = 0; m < 4; ++m)
#pragma unroll
                    for (int n = 0; n < 2; ++n) acc[a][b][m][n] = (f32x4){0.f, 0.f, 0.f, 0.f};
        cur = nxt; cA = nA; cB = nB; ++ui;
        if constexpr (ALIGN_EPI) { if (wr == 1) PG8_BAR; }
    }
    PG8_WAIT_V(0);
    if constexpr (!ALIGN_EPI) { if (wr == 0) PG8_BAR; }
    PG8_BAR;
#undef PG8_SA
#undef PG8_SB
#undef PG8_STAGE
#undef PG8_LDA
#undef PG8_LDB
#undef PG8_MMA
#undef PG8_WAIT_V
#undef PG8_WAIT_L
#undef PG8_BAR
#undef PG8_SCHED
}

template <bool NOSTORE> struct EpiAttnInT {
    static constexpr bool PERM = true;
    bf16_t* O; const float* bias; const unsigned* rope;
    template <int K0, int K1>
    __device__ __forceinline__ void body(const f32x4 (&acc)[2][2][4][2], const Unit& u, int wr, int wc, int fr, int fq) const {
        const int row0 = u.pm * BM + wr * 64 + fr;
        const bool ropew = (K0 <= 1) && ((wc & 1) == 0);
        const bool ropel = ropew && fq < 2;
        f32x4 bv[2][2];
#pragma unroll
        for (int bj = 0; bj < 2; ++bj) { const int c0 = u.pn * BM + bj * HALF + wc * 32 + 8 * fq; bv[bj][0] = *(const f32x4*)(bias + c0); bv[bj][1] = *(const f32x4*)(bias + c0 + 4); }
        u32x4 csv[2][4];
#pragma unroll
        for (int ai = 0; ai < 2; ++ai)
#pragma unroll
            for (int m = 0; m < 4; ++m) csv[ai][m] = (u32x4){0u, 0u, 0u, 0u};
        if (K0 <= 1 && ropew) {
#pragma unroll
            for (int ai = 0; ai < 2; ++ai)
#pragma unroll
                for (int m = 0; m < 4; ++m) csv[ai][m] = *(const u32x4*)(rope + (size_t)(row0 + ai * HALF + m * 16) * 8 + 4 * (fq & 1));
        }
#pragma unroll
        for (int ai = 0; ai < 2; ++ai)
#pragma unroll
            for (int m = 0; m < 4; ++m) {
                const int row = row0 + ai * HALF + m * 16;
                const u32x4 cs = csv[ai][m];
#pragma unroll
                for (int bj = 0; bj < 2; ++bj) {
                    constexpr int kind0 = K0, kind1 = K1;
                    const int kind = bj ? kind1 : kind0;
                    const int c0 = u.pn * BM + bj * HALF + wc * 32 + 8 * fq;
                    f32x4 v0 = acc[ai][bj][m][0] + bv[bj][0], v1 = acc[ai][bj][m][1] + bv[bj][1];
                    if ((bj ? K1 : K0) <= 1) {
                        const float c0f = h_lo(cs.x), s0f = h_hi(cs.x), c1f = h_lo(cs.y), s1f = h_hi(cs.y), c2f = h_lo(cs.z), s2f = h_hi(cs.z), c3f = h_lo(cs.w), s3f = h_hi(cs.w);
                        const f32x4 t0 = v0, t1 = v1;
                        f32x4 r0, r1;
                        r0[0] = t0[0] * c0f - t0[1] * s0f; r0[1] = t0[1] * c0f + t0[0] * s0f; r0[2] = t0[2] * c1f - t0[3] * s1f; r0[3] = t0[3] * c1f + t0[2] * s1f;
                        r1[0] = t1[0] * c2f - t1[1] * s2f; r1[1] = t1[1] * c2f + t1[0] * s2f; r1[2] = t1[2] * c3f - t1[3] * s3f; r1[3] = t1[3] * c3f + t1[2] * s3f;
#pragma unroll
                        for (int i = 0; i < 4; ++i) { v0[i] = ropel ? r0[i] : v0[i]; v1[i] = ropel ? r1[i] : v1[i]; }
                    }
                    if (kind == 0) { v0 = v0 * QSCALE; v1 = v1 * QSCALE; }
                    if (kind == 3) {
#pragma unroll
                        for (int i = 0; i < 4; ++i) { v0[i] = silu_f(v0[i]); v1[i] = silu_f(v1[i]); }
                    }
                    u32x4 w; w.x = cvtpk(v0[0], v0[1]); w.y = cvtpk(v0[2], v0[3]); w.z = cvtpk(v1[0], v1[1]); w.w = cvtpk(v1[2], v1[3]);
                    if (!NOSTORE || (w.x == 0x12345678u && w.y == 0x9abcdef0u))
                    *(u32x4*)(O + (size_t)row * ATTN_IN + c0) = w;
                }
            }
    }
    __device__ __forceinline__ void operator()(const f32x4 (&acc)[2][2][4][2], const Unit& u, int wr, int wc, int fr, int fq) const {
        if (u.pn < 4) body<0, 0>(acc, u, wr, wc, fr, fq);
        else if (u.pn == 4) body<1, 2>(acc, u, wr, wc, fr, fq);
        else body<3, 3>(acc, u, wr, wc, fr, fq);
    }
};
template <bool NOSTORE> struct EpiRecInT {
    static constexpr bool PERM = true;
    bf16_t* O; const float* lb;
    template <int SEG>
    __device__ __forceinline__ void body(const f32x4 (&acc)[2][2][4][2], const Unit& u, int wr, int wc, int fr, int fq) const {
        const int row0 = u.pm * BM + wr * 64 + fr;
        constexpr int seg = SEG;
#pragma unroll
        for (int bj = 0; bj < 2; ++bj) {
            const int c0 = u.pn * BM + bj * HALF + wc * 32 + 8 * fq;
            f32x4 l0 = (f32x4){0.f, 0.f, 0.f, 0.f}, l1 = l0;
            if (seg == 1) { l0 = *(const f32x4*)(lb + (c0 - 1024)); l1 = *(const f32x4*)(lb + (c0 - 1024) + 4); }
#pragma unroll
            for (int ai = 0; ai < 2; ++ai)
#pragma unroll
                for (int m = 0; m < 4; ++m) {
                    const int row = row0 + ai * HALF + m * 16;
                    f32x4 v0 = acc[ai][bj][m][0], v1 = acc[ai][bj][m][1];
                    u32x4 w;
                    if (seg == 1) {
#pragma unroll
                        for (int i = 0; i < 4; ++i) {
                            const float s0 = __builtin_amdgcn_rcpf(1.0f + __expf(-v0[i])), s1 = __builtin_amdgcn_rcpf(1.0f + __expf(-v1[i]));
                            v0[i] = __log2f(l0[i] + (1.0f - l0[i]) * s0); v1[i] = __log2f(l1[i] + (1.0f - l1[i]) * s1);
                        }
                        w.x = cvtpk_h(v0[0], v0[1]); w.y = cvtpk_h(v0[2], v0[3]); w.z = cvtpk_h(v1[0], v1[1]); w.w = cvtpk_h(v1[2], v1[3]);
                    } else {
                        if (seg != 2) {
#pragma unroll
                            for (int i = 0; i < 4; ++i) { v0[i] = silu_f(v0[i]); v1[i] = silu_f(v1[i]); }
                        }
                        w.x = cvtpk(v0[0], v0[1]); w.y = cvtpk(v0[2], v0[3]); w.z = cvtpk(v1[0], v1[1]); w.w = cvtpk(v1[2], v1[3]);
                    }
                    if (!NOSTORE || (w.x == 0x12345678u && w.y == 0x9abcdef0u))
                    *(u32x4*)(O + ((size_t)((row >> 11) * 8 + (u.pn & 3) * 2 + bj) * SEQ + (row & 2047)) * 512 + seg * 128 + wc * 32 + 8 * fq) = w;
                }
        }
    }
    __device__ __forceinline__ void operator()(const f32x4 (&acc)[2][2][4][2], const Unit& u, int wr, int wc, int fr, int fq) const {
        const int sg = u.pn >> 2;
        if (sg == 0) body<0>(acc, u, wr, wc, fr, fq); else if (sg == 1) body<1>(acc, u, wr, wc, fr, fq); else if (sg == 2) body<2>(acc, u, wr, wc, fr, fq); else body<3>(acc, u, wr, wc, fr, fq);
    }
};
struct EpiOut {
    static constexpr bool PERM = true;
    bf16_t* O; const float* bias; float* part; LAS float* xch;
    __device__ __forceinline__ void operator()(const f32x4 (&acc)[2][2][4][2], const Unit& u, int wr, int wc, int fr, int fq) const {
        const int row0 = u.pm * BM + wr * 64 + fr;
        f32x4 bv[2][2];
#pragma unroll
        for (int bj = 0; bj < 2; ++bj) { const int c0 = u.pn * BM + bj * HALF + wc * 32 + 8 * fq;
            bv[bj][0] = bias ? *(const f32x4*)(bias + c0) : (f32x4){0.f, 0.f, 0.f, 0.f}; bv[bj][1] = bias ? *(const f32x4*)(bias + c0 + 4) : (f32x4){0.f, 0.f, 0.f, 0.f}; }
#pragma unroll
        for (int ai = 0; ai < 2; ++ai)
#pragma unroll
            for (int m = 0; m < 4; ++m) {
                const int row = row0 + ai * HALF + m * 16;
                float ss = 0.f;
#pragma unroll
                for (int bj = 0; bj < 2; ++bj) {
                    const int c0 = u.pn * BM + bj * HALF + wc * 32 + 8 * fq;
                    const f32x4 v0 = acc[ai][bj][m][0] + bv[bj][0], v1 = acc[ai][bj][m][1] + bv[bj][1];
                    ss += (v0[0] * v0[0] + v0[1] * v0[1]) + (v0[2] * v0[2] + v0[3] * v0[3]) + (v1[0] * v1[0] + v1[1] * v1[1]) + (v1[2] * v1[2] + v1[3] * v1[3]);
                    u32x4 w; w.x = cvtpk(v0[0], v0[1]); w.y = cvtpk(v0[2], v0[3]); w.z = cvtpk(v1[0], v1[1]); w.w = cvtpk(v1[2], v1[3]);
                    *(u32x4*)(O + (size_t)row * DM + c0) = w;
                }
                ss += __shfl_xor(ss, 16); ss += __shfl_xor(ss, 32);
                xch[fq == 0 ? (ai * HALF + wr * 64 + m * 16 + fr) * 4 + wc : 1024 + threadIdx.x] = ss;
            }
        asm volatile("s_waitcnt lgkmcnt(0)" ::: "memory"); __builtin_amdgcn_s_barrier(); asm volatile("" ::: "memory");
        if (threadIdx.x < 256) { const f32x4 p = *(const LAS f32x4*)(xch + threadIdx.x * 4); part[(size_t)(u.pm * BM + threadIdx.x) * 4 + u.pn] = (p[0] + p[1]) + (p[2] + p[3]); }
    }
};
struct EpiNull {
    static constexpr bool PERM = true;
    float* sink;
    __device__ __forceinline__ void operator()(const f32x4 (&acc)[2][2][4][2], const Unit& u, int wr, int wc, int fr, int fq) const {
        f32x4 s = (f32x4){0.f, 0.f, 0.f, 0.f};
#pragma unroll
        for (int ai = 0; ai < 2; ++ai)
#pragma unroll
            for (int bj = 0; bj < 2; ++bj)
#pragma unroll
                for (int m = 0; m < 4; ++m) { s += acc[ai][bj][m][0]; s += acc[ai][bj][m][1]; }
        if (s[0] + s[1] + s[2] + s[3] == 123456.789f) sink[u.pm] = s[0];
    }
};
typedef EpiRecInT<false> EpiRecIn;
typedef EpiAttnInT<false> EpiAttnIn;
}

template <bool ROPE_PERM>
__device__ __forceinline__ void transpose_item(const float* W, int K, int N, bf16_t* WT, LAS float* scr, int item, int lane) {
    const int nblk = N / 32, kb = item / nblk, nb = item % nblk, k0 = 64 * kb, n0 = 32 * nb;
    const int ncol = ROPE_PERM ? rope_src_col(n0 + (lane & 31)) : n0 + (lane & 31);
#pragma unroll 8
    for (int i = 0; i < 32; ++i) { const int kk = 2 * i + (lane >> 5); scr[kk * 33 + (lane & 31)] = W[(size_t)(k0 + kk) * N + ncol]; }
    asm volatile("s_waitcnt lgkmcnt(0)" ::: "memory");
    const int c = lane & 7;
#pragma unroll
    for (int j = 0; j < 4; ++j) { const int n = (lane >> 3) + 8 * j; const LAS float* s = scr + (8 * c) * 33 + n;
        u32x4 o; o.x = cvtpk(s[0 * 33], s[1 * 33]); o.y = cvtpk(s[2 * 33], s[3 * 33]); o.z = cvtpk(s[4 * 33], s[5 * 33]); o.w = cvtpk(s[6 * 33], s[7 * 33]);
        *(u32x4*)(WT + (size_t)(n0 + n) * K + k0 + 8 * c) = o; }
    asm volatile("s_waitcnt lgkmcnt(0)" ::: "memory");
}

struct Args {
    const float* x; const int* pos; const float* pre_w; const float* post_w; const float* a_win; const float* a_bin; const float* a_sinks;
    const float* a_wout; const float* a_bout; const float* r_win; const float* r_lbl; const float* r_gw; const float* r_wout;
    float* out; unsigned char* ws; int ph_lo, ph_hi, flags, pad;
};

__device__ __forceinline__ void load_w16(const float* w, int lane, f32x4 (&r)[2][2]) {
#pragma unroll
    for (int j = 0; j < 2; ++j)
#pragma unroll
        for (int h = 0; h < 2; ++h) r[j][h] = *(const f32x4*)(w + 512 * j + 8 * lane + 4 * h);
}

__device__ __forceinline__ void p_prologue(const Args& a, LAS unsigned char* lds, int G) {
    const int tid = threadIdx.x, lane = tid & 63, wid = __builtin_amdgcn_readfirstlane(tid >> 6);
    LAS float* scr = (LAS float*)(lds + wid * 16384);
    const int gw = blockIdx.x * 8 + wid, NGW = G * 8;
    constexpr int I_A = (DM / 64) * (ATTN_IN / 32), I_O = (DM / 64) * (DM / 32), I_R = (DM / 64) * (REC_IN / 32);
    constexpr int NITEMS = I_A + I_O + I_R + I_O;
    for (int it = gw; it < NITEMS; it += NGW) {
        int r = it;
        if (r < I_A) { transpose_item<true>(a.a_win, DM, ATTN_IN, (bf16_t*)(a.ws + WS_WIN0), scr, r, lane); continue; } r -= I_A;
        if (r < I_O) { transpose_item<false>(a.a_wout, DM, DM, (bf16_t*)(a.ws + WS_WOUT0), scr, r, lane); continue; } r -= I_O;
        if (r < I_R) { transpose_item<false>(a.r_win, DM, REC_IN, (bf16_t*)(a.ws + WS_WIN1), scr, r, lane); continue; } r -= I_R;
        transpose_item<false>(a.r_wout, DM, DM, (bf16_t*)(a.ws + WS_WOUT1), scr, r, lane);
    }
    {
        unsigned* rope = (unsigned*)(a.ws + WS_ROPE);
        const int gt = blockIdx.x * 512 + tid, NGT = G * 512;
        for (int e = gt; e < MTOK * 8; e += NGT) {
            const int row = e >> 3, i = e & 7;
            const float invf = (i == 0) ? 1.0f : (i == 1) ? 0.19392274474868576f : (i == 2) ? 0.03760603093086393f : (i == 3) ? 0.007292664737217109f :
                               (i == 4) ? 0.001414213562373095f : (i == 5) ? 0.0002742481756762073f : (i == 6) ? 5.318295896944988e-05f : 1.031338537721246e-05f;
            const float ang = (float)a.pos[row] * invf;
            rope[e] = cvtpk_h(cosf(ang), sinf(ang));
        }
        float* biasp = (float*)(a.ws + WS_BIASP);
        for (int e = gt; e < ATTN_IN; e += NGT) biasp[e] = a.a_bin[rope_src_col(e)];
        float* lb = (float*)(a.ws + WS_LB);
        for (int e = gt; e < DM; e += NGT) { const float l0 = a.r_lbl[e], l1 = a.r_lbl[DM + e]; lb[e] = 1.0f / (1.0f + expf(l0 - l1)); }
    }
    {
        f32x4 wv[2][2]; load_w16(a.pre_w, lane, wv);
        bf16_t* H = (bf16_t*)(a.ws + WS_H);
        for (int row = gw; row < MTOK; row += 2 * NGW) {
            f32x4 xv[2][2][2]; float ss[2] = {0.f, 0.f}; int rr[2]; bool ok[2];
#pragma unroll
            for (int r = 0; r < 2; ++r) { ok[r] = row + r * NGW < MTOK; rr[r] = ok[r] ? row + r * NGW : row;
#pragma unroll
                for (int j = 0; j < 2; ++j)
#pragma unroll
                    for (int h = 0; h < 2; ++h) xv[r][j][h] = *(const f32x4*)(a.x + (size_t)rr[r] * DM + 512 * j + 8 * lane + 4 * h); }
#pragma unroll
            for (int r = 0; r < 2; ++r)
#pragma unroll
                for (int j = 0; j < 2; ++j)
#pragma unroll
                    for (int h = 0; h < 2; ++h) { const f32x4 t = xv[r][j][h]; ss[r] += (t[0] * t[0] + t[1] * t[1]) + (t[2] * t[2] + t[3] * t[3]); }
#pragma unroll
            for (int r = 0; r < 2; ++r) {
                const float rstd = rsqrtf(wave_sum(ss[r]) * (1.0f / DM) + NORM_EPS);
#pragma unroll
                for (int j = 0; j < 2; ++j) {
                    const f32x4 h0 = xv[r][j][0] * rstd * wv[j][0], h1 = xv[r][j][1] * rstd * wv[j][1];
                    u32x4 w; w.x = cvtpk(h0[0], h0[1]); w.y = cvtpk(h0[2], h0[3]); w.z = cvtpk(h1[0], h1[1]); w.w = cvtpk(h1[2], h1[3]);
                    if (ok[r]) *(u32x4*)(H + (size_t)rr[r] * DM + 512 * j + 8 * lane) = w;
                }
            }
        }
    }
}

__device__ __forceinline__ void unpack_bf16x8(const u32x4& v, f32x4& lo, f32x4& hi) {
    lo = (f32x4){bf_lo(v.x), bf_hi(v.x), bf_lo(v.y), bf_hi(v.y)}; hi = (f32x4){bf_lo(v.z), bf_hi(v.z), bf_lo(v.w), bf_hi(v.w)};
}
__device__ __forceinline__ void p_mid(const bf16_t* Y0, const float* part0, const float* x, const float* post_w0, const float* pre_w1, bf16_t* Hout, int G) {
    const int tid = threadIdx.x, lane = tid & 63, wid = __builtin_amdgcn_readfirstlane(tid >> 6);
    const int gw = blockIdx.x * 8 + wid, NGW = G * 8;
    f32x4 wp[2][2], wn[2][2]; load_w16(post_w0, lane, wp); load_w16(pre_w1, lane, wn);
    for (int row = gw; row < MTOK; row += 2 * NGW) {
        float ps[2]; u32x4 yv[2][2]; f32x4 xv[2][2][2]; int rr[2]; bool ok[2];
#pragma unroll
        for (int r = 0; r < 2; ++r) { ok[r] = row + r * NGW < MTOK; rr[r] = ok[r] ? row + r * NGW : row;
            ps[r] = (lane < 4) ? part0[(size_t)rr[r] * 4 + lane] : 0.f;
#pragma unroll
            for (int j = 0; j < 2; ++j) { yv[r][j] = *(const u32x4*)(Y0 + (size_t)rr[r] * DM + 512 * j + 8 * lane);
#pragma unroll
                for (int h = 0; h < 2; ++h) xv[r][j][h] = *(const f32x4*)(x + (size_t)rr[r] * DM + 512 * j + 8 * lane + 4 * h); } }
#pragma unroll
        for (int r = 0; r < 2; ++r) {
            const float rstd = rsqrtf(wave_sum(ps[r]) * (1.0f / DM) + NORM_EPS);
            float ss = 0.f;
#pragma unroll
            for (int j = 0; j < 2; ++j) {
                f32x4 y0, y1; unpack_bf16x8(yv[r][j], y0, y1);
                xv[r][j][0] = xv[r][j][0] + y0 * rstd * wp[j][0]; xv[r][j][1] = xv[r][j][1] + y1 * rstd * wp[j][1];
#pragma unroll
                for (int h = 0; h < 2; ++h) { const f32x4 t = xv[r][j][h]; ss += (t[0] * t[0] + t[1] * t[1]) + (t[2] * t[2] + t[3] * t[3]); }
            }
            const float r2 = rsqrtf(wave_sum(ss) * (1.0f / DM) + NORM_EPS);
#pragma unroll
            for (int j = 0; j < 2; ++j) {
                const f32x4 h0 = xv[r][j][0] * r2 * wn[j][0], h1 = xv[r][j][1] * r2 * wn[j][1];
                u32x4 w; w.x = cvtpk(h0[0], h0[1]); w.y = cvtpk(h0[2], h0[3]); w.z = cvtpk(h1[0], h1[1]); w.w = cvtpk(h1[2], h1[3]);
                if (ok[r]) *(u32x4*)(Hout + (size_t)rr[r] * DM + 512 * j + 8 * lane) = w;
            }
        }
    }
}
__device__ __forceinline__ void p_final(const bf16_t* Y0, const float* part0, const bf16_t* Y1, const float* part1, const float* x, const float* post_w0, const float* post_w1, float* out, int G) {
    const int tid = threadIdx.x, lane = tid & 63, wid = __builtin_amdgcn_readfirstlane(tid >> 6);
    const int gw = blockIdx.x * 8 + wid, NGW = G * 8;
    f32x4 wp0[2][2], wp1[2][2]; load_w16(post_w0, lane, wp0); load_w16(post_w1, lane, wp1);
    for (int row = gw; row < MTOK; row += 2 * NGW) {
        float ps0[2], ps1[2]; u32x4 ya[2][2], yb[2][2]; f32x4 xv[2][2][2]; int rr[2]; bool ok[2];
#pragma unroll
        for (int r = 0; r < 2; ++r) { ok[r] = row + r * NGW < MTOK; rr[r] = ok[r] ? row + r * NGW : row;
            ps0[r] = (lane < 4) ? part0[(size_t)rr[r] * 4 + lane] : 0.f; ps1[r] = (lane < 4) ? part1[(size_t)rr[r] * 4 + lane] : 0.f;
#pragma unroll
            for (int j = 0; j < 2; ++j) { ya[r][j] = *(const u32x4*)(Y0 + (size_t)rr[r] * DM + 512 * j + 8 * lane); yb[r][j] = *(const u32x4*)(Y1 + (size_t)rr[r] * DM + 512 * j + 8 * lane);
#pragma unroll
                for (int h = 0; h < 2; ++h) xv[r][j][h] = *(const f32x4*)(x + (size_t)rr[r] * DM + 512 * j + 8 * lane + 4 * h); } }
#pragma unroll
        for (int r = 0; r < 2; ++r) {
            const float r0 = rsqrtf(wave_sum(ps0[r]) * (1.0f / DM) + NORM_EPS), r1 = rsqrtf(wave_sum(ps1[r]) * (1.0f / DM) + NORM_EPS);
#pragma unroll
            for (int j = 0; j < 2; ++j) {
                f32x4 a0, a1, b0, b1; unpack_bf16x8(ya[r][j], a0, a1); unpack_bf16x8(yb[r][j], b0, b1);
                f32x4 t0 = xv[r][j][0] + a0 * r0 * wp0[j][0], t1 = xv[r][j][1] + a1 * r0 * wp0[j][1];
                t0 = t0 + b0 * r1 * wp1[j][0]; t1 = t1 + b1 * r1 * wp1[j][1];
                if (ok[r]) { *(f32x4*)(out + (size_t)rr[r] * DM + 512 * j + 8 * lane) = t0; *(f32x4*)(out + (size_t)rr[r] * DM + 512 * j + 8 * lane + 4) = t1; }
            }
        }
    }
}

typedef short v4i16_t __attribute__((ext_vector_type(4)));
__device__ __forceinline__ u32x2 tr4(const LAS unsigned char* p) { return __builtin_bit_cast(u32x2, __builtin_amdgcn_ds_read_tr16_b64_v4i16((LAS v4i16_t*)p)); }
__device__ __forceinline__ bf16x8 tr8(const LAS unsigned char* p0, const LAS unsigned char* p1) { const u32x2 a = tr4(p0), b = tr4(p1); return __builtin_bit_cast(bf16x8, (u32x4){a.x, a.y, b.x, b.y}); }
constexpr int AK_STRIDE = 144, AK_BYTES = 256 * AK_STRIDE, AV_BYTES = AK_BYTES, AO_STRIDE = 272, AO_BYTES = 32 * AO_STRIDE;
constexpr int ATTN_LDS = AK_BYTES + AV_BYTES + 8 * AO_BYTES;
template <bool ALLV>
__device__ __forceinline__ void attn_subblocks(LAS unsigned char* Ks, LAS unsigned char* Vs, LAS unsigned char* Os, const bf16_t* QKVZ, bf16_t* G0, bf16x8 (&qn)[4],
                                               int u, int G, int NU, size_t row0, int hq, float sink2, int wid, int lane, int r32, int hi, int orow, int oc8) {
    const float NEG = -INFINITY;
    for (int j = 0; j < 4; ++j) {
        bf16x8 qf[4];
#pragma unroll
        for (int d0 = 0; d0 < 4; ++d0) qf[d0] = qn[d0];
        {
            const int un = (u + G < NU) ? u + G : u;
            const size_t qrow = (j < 3) ? row0 + 32 * (j + 1) : (size_t)(un >> 5) * SEQ + ((un >> 1) & 15) * 128;
            const int qh = (j < 3) ? hq : (un & 1) * 8 + wid;
#pragma unroll
            for (int d0 = 0; d0 < 4; ++d0) qn[d0] = *(const bf16x8*)(QKVZ + (qrow + r32) * ATTN_IN + qh * 64 + d0 * 16 + hi * 8);
        }
        u32x4 zv[4];
#pragma unroll
        for (int i = 0; i < 4; ++i) zv[i] = *(const u32x4*)(QKVZ + (row0 + 32 * j + 8 * i + orow) * ATTN_IN + 1280 + hq * 64 + oc8);
        f32x16 st[5];
        bf16x8 kfr[2][4];
        const LAS unsigned char* kbase = Ks + (32 * j + r32) * AK_STRIDE + hi * 16;
#pragma unroll
        for (int d0 = 0; d0 < 4; ++d0) kfr[0][d0] = *(const LAS bf16x8*)(kbase + d0 * 32);
#pragma unroll
        for (int tt = 0; tt < 5; ++tt) {
            const bool tv = ALLV || (j + tt >= 4);
            if (tt < 4) {
#pragma unroll
                for (int d0 = 0; d0 < 4; ++d0) kfr[(tt + 1) & 1][d0] = *(const LAS bf16x8*)(kbase + (tt + 1) * 32 * AK_STRIDE + d0 * 32);
            }
            __builtin_amdgcn_sched_barrier(0);
            if (tv) {
#pragma unroll
                for (int r = 0; r < 16; ++r) st[tt][r] = 0.f;
#pragma unroll
                for (int d0 = 0; d0 < 4; ++d0) st[tt] = __builtin_amdgcn_mfma_f32_32x32x16_bf16(kfr[tt & 1][d0], qf[d0], st[tt], 0, 0, 0);
            } else {
#pragma unroll
                for (int r = 0; r < 16; ++r) st[tt][r] = NEG;
            }
            __builtin_amdgcn_sched_barrier(0);
        }
        float mx = sink2;
#pragma unroll
        for (int r = 0; r < 16; ++r) {
            const int kk = (r & 3) + 8 * (r >> 2) + 4 * hi;
            if (!(kk > r32)) st[0][r] = NEG;
            if (!(kk <= r32)) st[4][r] = NEG;
        }
#pragma unroll
        for (int tt = 0; tt < 5; ++tt)
#pragma unroll
            for (int r = 0; r < 16; ++r) mx = fmaxf(mx, st[tt][r]);
        mx = fmaxf(mx, __shfl_xor(mx, 32));
        float l = 0.f;
        f32x16 ot[2];
#pragma unroll
        for (int r = 0; r < 16; ++r) { ot[0][r] = 0.f; ot[1][r] = 0.f; }
        bf16x8 vfr[2][2];
        const LAS unsigned char* vbase = Vs + (32 * j + 4 * hi + ((lane & 15) >> 2)) * AK_STRIDE + (16 * ((lane >> 4) & 1) + 4 * (lane & 3)) * 2;
#pragma unroll
        for (int blk = 0; blk < 2; ++blk) { const LAS unsigned char* vp = vbase + (32 * blk) * 2; vfr[0][blk] = tr8(vp, vp + 8 * AK_STRIDE); }
#pragma unroll
        for (int sidx = 0; sidx < 10; ++sidx) {
            const int tt = sidx >> 1, ks = sidx & 1;
            const bool tv = ALLV || (j + tt >= 4);
            if (sidx < 9) {
#pragma unroll
                for (int blk = 0; blk < 2; ++blk) { const LAS unsigned char* vp = vbase + (16 * (sidx + 1)) * AK_STRIDE + (32 * blk) * 2; vfr[(sidx + 1) & 1][blk] = tr8(vp, vp + 8 * AK_STRIDE); }
            }
            __builtin_amdgcn_sched_barrier(0);
            if (tv) {
                if (ks == 0) {
#pragma unroll
                    for (int r = 0; r < 16; ++r) { const float p = __builtin_amdgcn_exp2f(st[tt][r] - mx); st[tt][r] = p; l += p; }
                }
                u32x4 pw; pw.x = cvtpk(st[tt][8 * ks + 0], st[tt][8 * ks + 1]); pw.y = cvtpk(st[tt][8 * ks + 2], st[tt][8 * ks + 3]);
                pw.z = cvtpk(st[tt][8 * ks + 4], st[tt][8 * ks + 5]); pw.w = cvtpk(st[tt][8 * ks + 6], st[tt][8 * ks + 7]);
                const bf16x8 pf = __builtin_bit_cast(bf16x8, pw);
#pragma unroll
                for (int blk = 0; blk < 2; ++blk) ot[blk] = __builtin_amdgcn_mfma_f32_32x32x16_bf16(vfr[sidx & 1][blk], pf, ot[blk], 0, 0, 0);
            }
            __builtin_amdgcn_sched_barrier(0);
        }
        l += __shfl_xor(l, 32);
        l += __builtin_amdgcn_exp2f(sink2 - mx);
        const float inv = 1.0f / l;
#pragma unroll
        for (int blk = 0; blk < 2; ++blk)
#pragma unroll
            for (int rq = 0; rq < 4; ++rq)
                *(LAS f32x4*)(Os + r32 * AO_STRIDE + (32 * blk + 8 * rq + 4 * hi) * 4) = (f32x4){ot[blk][4 * rq + 0] * inv, ot[blk][4 * rq + 1] * inv, ot[blk][4 * rq + 2] * inv, ot[blk][4 * rq + 3] * inv};
        asm volatile("s_waitcnt lgkmcnt(0)" ::: "memory");
#pragma unroll
        for (int i = 0; i < 4; ++i) {
            const LAS unsigned char* op = Os + (8 * i + orow) * AO_STRIDE + oc8 * 4;
            const f32x4 a = *(const LAS f32x4*)op, c = *(const LAS f32x4*)(op + 16);
            u32x4 w; const u32x4 z = zv[i];
            w.x = cvtpk(a[0] * bf_lo(z.x), a[1] * bf_hi(z.x)); w.y = cvtpk(a[2] * bf_lo(z.y), a[3] * bf_hi(z.y));
            w.z = cvtpk(c[0] * bf_lo(z.z), c[1] * bf_hi(z.z)); w.w = cvtpk(c[2] * bf_lo(z.w), c[3] * bf_hi(z.w));
            *(u32x4*)(G0 + (row0 + 32 * j + 8 * i + orow) * DM + hq * 64 + oc8) = w;
        }
        asm volatile("s_waitcnt lgkmcnt(0)" ::: "memory");
    }
}
__device__ __forceinline__ void p_attention(LAS unsigned char* lds, const bf16_t* QKVZ, const float* sinks, bf16_t* G0, int G) {
    const int tid = threadIdx.x, lane = tid & 63, wid = __builtin_amdgcn_readfirstlane(tid >> 6), r32 = lane & 31, hi = lane >> 5;
    LAS unsigned char* Ks = lds; LAS unsigned char* Vs = lds + AK_BYTES; LAS unsigned char* Os = lds + AK_BYTES + AV_BYTES + wid * AO_BYTES;
    const float NEG = -INFINITY;
    const int orow = lane >> 3, oc8 = (lane & 7) * 8;
    constexpr int NU = NB * 16 * 2;
    u32x4 kreg[4], vreg[4];
#define ATTN_LOAD_KV(uu) do { const int kvh_ = (uu) & 1, n_ = ((uu) >> 1) & 15, b_ = (uu) >> 5; \
        _Pragma("unroll") for (int i = 0; i < 4; ++i) { const int kr_ = (tid + 512 * i) >> 3, tok_ = n_ * 128 - 128 + kr_; \
            kreg[i] = (u32x4){0u, 0u, 0u, 0u}; vreg[i] = (u32x4){0u, 0u, 0u, 0u}; \
            if (tok_ >= 0) { const bf16_t* p_ = QKVZ + ((size_t)b_ * SEQ + tok_) * ATTN_IN + 1024 + kvh_ * 64 + (tid & 7) * 8; kreg[i] = *(const u32x4*)p_; vreg[i] = *(const u32x4*)(p_ + 128); } } } while (0)
    if ((int)blockIdx.x < NU) ATTN_LOAD_KV((int)blockIdx.x);
    bf16x8 qn[4];
    if ((int)blockIdx.x < NU) { const int u0 = blockIdx.x, kvh0 = u0 & 1, n0 = (u0 >> 1) & 15, b0 = u0 >> 5;
#pragma unroll
        for (int d0 = 0; d0 < 4; ++d0) qn[d0] = *(const bf16x8*)(QKVZ + ((size_t)b0 * SEQ + n0 * 128 + r32) * ATTN_IN + (kvh0 * 8 + wid) * 64 + d0 * 16 + hi * 8); }
    for (int u = blockIdx.x; u < NU; u += G) {
        const int kvh = u & 1, n = (u >> 1) & 15, b = u >> 5;
        const size_t rowb = (size_t)b * SEQ;
#pragma unroll
        for (int i = 0; i < 4; ++i) {
            const int kr = (tid + 512 * i) >> 3, ch = tid & 7;
            *(LAS u32x4*)(Ks + kr * AK_STRIDE + ch * 16) = kreg[i];
            *(LAS u32x4*)(Vs + kr * AK_STRIDE + ch * 16) = vreg[i];
        }
        const int hq = kvh * 8 + wid;
        const float sink2 = sinks[hq] * LOG2E;
        const size_t row0 = rowb + n * 128;
        if (u + G < NU) ATTN_LOAD_KV(u + G);
        LDS_BAR();
        if (n > 0) attn_subblocks<true>(Ks, Vs, Os, QKVZ, G0, qn, u, G, NU, row0, hq, sink2, wid, lane, r32, hi, orow, oc8);
        else       attn_subblocks<false>(Ks, Vs, Os, QKVZ, G0, qn, u, G, NU, row0, hq, sink2, wid, lane, r32, hi, orow, oc8);
        LDS_BAR();
    }
#undef ATTN_LOAD_KV
}

constexpr int RC = 32, RQ_STRIDE = 272, R_OSTRIDE = 528;
constexpr int R_QD = 0, R_KR = R_QD + RC * RQ_STRIDE, R_KD = R_KR + RC * RQ_STRIDE, R_V = R_KD + RC * RQ_STRIDE, R_DEC = R_V + RC * RQ_STRIDE, R_O = R_DEC + 512,
              R_BUF = R_O + RC * R_OSTRIDE, R_PS = 2 * R_BUF, R_PSZ = 8 * 128 * 4, R_END = R_PS + 2 * R_PSZ;
struct RecRegs { unsigned q[4], g[4], v[4]; };
struct RecCarry { float cs0[4], cs1[4]; };
__device__ __forceinline__ void rec_load(RecRegs& R, const bf16_t* REC, size_t crow, int wid, int lane) {
#pragma unroll
    for (int i = 0; i < 4; ++i) {
        const bf16_t* rp = REC + (crow + 4 * wid + i) * 512 + 2 * lane;
        R.q[i] = *(const unsigned*)(rp); R.g[i] = *(const unsigned*)(rp + 128); R.v[i] = *(const unsigned*)(rp + 256);
    }
}
__device__ __forceinline__ u32x4 rec_load_z(const bf16_t* REC, size_t crow, int tid) { return *(const u32x4*)(REC + (crow + (tid >> 4)) * 512 + 384 + 8 * (tid & 15)); }
__device__ __forceinline__ void rec_finalize(const LAS unsigned char* obuf, const u32x4& z, const f32x4& gw0, const f32x4& gw1, bf16_t* G1row, int tid) {
    const LAS unsigned char* op = obuf + (tid >> 4) * R_OSTRIDE + (tid & 15) * 32;
    const f32x4 a = *(const LAS f32x4*)op, b = *(const LAS f32x4*)(op + 16);
    float ss = (a[0] * a[0] + a[1] * a[1]) + (a[2] * a[2] + a[3] * a[3]) + (b[0] * b[0] + b[1] * b[1]) + (b[2] * b[2] + b[3] * b[3]);
#pragma unroll
    for (int o = 1; o < 16; o <<= 1) ss += __shfl_xor(ss, o);
    const float rs = rsqrtf(ss * (1.0f / 128.0f) + NORM_EPS);
    const f32x4 x = a * rs * gw0, y = b * rs * gw1;
    u32x4 w;
    w.x = cvtpk(x[0] * bf_lo(z.x), x[1] * bf_hi(z.x)); w.y = cvtpk(x[2] * bf_lo(z.y), x[3] * bf_hi(z.y));
    w.z = cvtpk(y[0] * bf_lo(z.z), y[1] * bf_hi(z.z)); w.w = cvtpk(y[2] * bf_lo(z.w), y[3] * bf_hi(z.w));
    *(u32x4*)G1row = w;
}
__device__ __forceinline__ void rec_cumsum(const RecRegs& R, RecCarry& K, LAS unsigned char* ps, int wid, int lane) {
    float c0 = 0.f, c1 = 0.f;
#pragma unroll
    for (int i = 0; i < 4; ++i) { c0 += h_lo(R.g[i]); c1 += h_hi(R.g[i]); K.cs0[i] = c0; K.cs1[i] = c1; }
    *(LAS f32x2_t*)(ps + (wid * 128 + 2 * lane) * 4) = (f32x2_t){c0, c1};
}
__device__ __forceinline__ void rec_alpha(const RecRegs& R, const RecCarry& K, const LAS unsigned char* ps, LAS unsigned char* buf, int wid, int lane) {
    f32x2_t sp[8];
#pragma unroll
    for (int p = 0; p < 8; ++p) sp[p] = *(const LAS f32x2_t*)(ps + (p * 128 + 2 * lane) * 4);
    const f32x2_t u01 = sp[0] + sp[1], u23 = sp[2] + sp[3], u45 = sp[4] + sp[5], u67 = sp[6] + sp[7];
    const f32x2_t h03 = u01 + u23, tot = h03 + (u45 + u67);
    const int wh = wid >> 1;
    const f32x2_t base = wh == 0 ? (f32x2_t){0.f, 0.f} : (wh == 1 ? u01 : (wh == 2 ? h03 : h03 + u45));
    const f32x2_t oddp = wh == 0 ? sp[0] : (wh == 1 ? sp[2] : (wh == 2 ? sp[4] : sp[6]));
    const f32x2_t pre = (wid & 1) ? base + oddp : base;
    const float et0 = __builtin_amdgcn_exp2f(tot.x), et1 = __builtin_amdgcn_exp2f(tot.y);
#pragma unroll
    for (int i = 0; i < 4; ++i) {
        const int t = 4 * wid + i;
        const float b0 = pre.x + K.cs0[i], b1 = pre.y + K.cs1[i];
        const float qd0 = bf_lo(R.q[i]) * __builtin_amdgcn_exp2f(b0), qd1 = bf_hi(R.q[i]) * __builtin_amdgcn_exp2f(b1);
        const float ki0 = (1.0f - __builtin_amdgcn_exp2f(h_lo(R.g[i]))) * __builtin_amdgcn_exp2f(fminf(-b0, 100.f)), ki1 = (1.0f - __builtin_amdgcn_exp2f(h_hi(R.g[i]))) * __builtin_amdgcn_exp2f(fminf(-b1, 100.f));
        *(LAS unsigned*)(buf + R_QD + t * RQ_STRIDE + lane * 4) = cvtpk(qd0, qd1);
        *(LAS unsigned*)(buf + R_KR + t * RQ_STRIDE + lane * 4) = cvtpk(ki0, ki1);
        *(LAS unsigned*)(buf + R_V + t * RQ_STRIDE + lane * 4) = R.v[i];
    }
    if (wid == 0) *(LAS f32x2_t*)(buf + R_DEC + 2 * lane * 4) = (f32x2_t){et0, et1};
}
__device__ __forceinline__ void rec_mfma(LAS unsigned char* buf, f32x4 (&S)[8], int wid, int c16, int quad) {
    const int tr_row = (c16 >> 2), tr_col = 4 * (c16 & 3);
    f32x4 s00 = (f32x4){0.f, 0.f, 0.f, 0.f}, s01 = s00, s11 = s00;
#pragma unroll
    for (int kk = 0; kk < 4; ++kk) {
        const bf16x8 ka0 = *(const LAS bf16x8*)(buf + R_KR + (c16) * RQ_STRIDE + kk * 64 + quad * 16);
        const bf16x8 ka1 = *(const LAS bf16x8*)(buf + R_KR + (16 + c16) * RQ_STRIDE + kk * 64 + quad * 16);
        const bf16x8 qb0 = *(const LAS bf16x8*)(buf + R_QD + (c16) * RQ_STRIDE + kk * 64 + quad * 16);
        const bf16x8 qb1 = *(const LAS bf16x8*)(buf + R_QD + (16 + c16) * RQ_STRIDE + kk * 64 + quad * 16);
        s00 = __builtin_amdgcn_mfma_f32_16x16x32_bf16(ka0, qb0, s00, 0, 0, 0);
        s01 = __builtin_amdgcn_mfma_f32_16x16x32_bf16(ka0, qb1, s01, 0, 0, 0);
        s11 = __builtin_amdgcn_mfma_f32_16x16x32_bf16(ka1, qb1, s11, 0, 0, 0);
    }
#pragma unroll
    for (int r = 0; r < 4; ++r) { if (4 * quad + r > c16) { s00[r] = 0.f; s11[r] = 0.f; } }
    u32x4 pw0, pw1;
    pw0.x = cvtpk(s00[0], s00[1]); pw0.y = cvtpk(s00[2], s00[3]); pw0.z = 0u; pw0.w = 0u;
    pw1.x = cvtpk(s01[0], s01[1]); pw1.y = cvtpk(s01[2], s01[3]); pw1.z = cvtpk(s11[0], s11[1]); pw1.w = cvtpk(s11[2], s11[3]);
    f32x4 o0 = (f32x4){0.f, 0.f, 0.f, 0.f}, o1 = o0;
#pragma unroll
    for (int jj = 0; jj < 4; ++jj) {
        u32x4 sw; sw.x = cvtpk(S[2 * jj][0], S[2 * jj][1]); sw.y = cvtpk(S[2 * jj][2], S[2 * jj][3]); sw.z = cvtpk(S[2 * jj + 1][0], S[2 * jj + 1][1]); sw.w = cvtpk(S[2 * jj + 1][2], S[2 * jj + 1][3]);
        const bf16x8 sb = __builtin_bit_cast(bf16x8, sw);
        const LAS unsigned char* qp0 = buf + R_QD + (c16) * RQ_STRIDE + (32 * jj + 4 * quad) * 2;
        const LAS unsigned char* qp1 = buf + R_QD + (16 + c16) * RQ_STRIDE + (32 * jj + 4 * quad) * 2;
        const u32x2 a0 = *(const LAS u32x2*)qp0, a1 = *(const LAS u32x2*)(qp0 + 32), a2 = *(const LAS u32x2*)qp1, a3 = *(const LAS u32x2*)(qp1 + 32);
        o0 = __builtin_amdgcn_mfma_f32_16x16x32_bf16(__builtin_bit_cast(bf16x8, (u32x4){a0.x, a0.y, a1.x, a1.y}), sb, o0, 0, 0, 0);
        o1 = __builtin_amdgcn_mfma_f32_16x16x32_bf16(__builtin_bit_cast(bf16x8, (u32x4){a2.x, a2.y, a3.x, a3.y}), sb, o1, 0, 0, 0);
    }
    {
        const LAS unsigned char* vp = buf + R_V + (4 * quad + tr_row) * RQ_STRIDE + (16 * wid + tr_col) * 2;
        const bf16x8 vb = tr8(vp, vp + 16 * RQ_STRIDE);
        o0 = __builtin_amdgcn_mfma_f32_16x16x32_bf16(__builtin_bit_cast(bf16x8, pw0), vb, o0, 0, 0, 0);
        o1 = __builtin_amdgcn_mfma_f32_16x16x32_bf16(__builtin_bit_cast(bf16x8, pw1), vb, o1, 0, 0, 0);
    }
#pragma unroll
    for (int r = 0; r < 4; ++r) {
        *(LAS float*)(buf + R_O + (4 * quad + r) * R_OSTRIDE + (16 * wid + c16) * 4) = o0[r];
        *(LAS float*)(buf + R_O + (16 + 4 * quad + r) * R_OSTRIDE + (16 * wid + c16) * 4) = o1[r];
    }
    {
        const LAS unsigned char* vp = buf + R_V + (8 * quad + tr_row) * RQ_STRIDE + (16 * wid + tr_col) * 2;
        const bf16x8 vb = tr8(vp, vp + 4 * RQ_STRIDE);
        const LAS unsigned char* kp = buf + R_KR + (8 * quad + tr_row) * RQ_STRIDE + tr_col * 2;
#pragma unroll
        for (int kt = 0; kt < 8; ++kt) {
            const f32x4 dv = *(const LAS f32x4*)(buf + R_DEC + (16 * kt + 4 * quad) * 4);
            const bf16x8 ka = tr8(kp + kt * 32, kp + kt * 32 + 4 * RQ_STRIDE);
            S[kt] = __builtin_amdgcn_mfma_f32_16x16x32_bf16(ka, vb, S[kt], 0, 0, 0) * dv;
        }
    }
}
__device__ __forceinline__ void rec_iter(LAS unsigned char* lds, const bf16_t* REC, size_t hrow, bf16_t* G1t, int c, RecRegs& R0, RecRegs& R1, RecRegs& R2, RecCarry& K, u32x4& znext,
                                         f32x4 (&S)[8], const f32x4& gw0, const f32x4& gw1, int tid, int lane, int wid, int c16, int quad) {
    constexpr int NC = SEQ / RC;
    const u32x4 zfin = znext;
    znext = rec_load_z(REC, hrow + (size_t)c * RC, tid);
    { const int cn = (c + 3 < NC) ? c + 3 : NC - 1; rec_load(R0, REC, hrow + (size_t)cn * RC, wid, lane); }
    LAS unsigned char* buf = lds + (c & 1) * R_BUF;
    if (c > 0) rec_finalize(lds + ((c & 1) ^ 1) * R_BUF + R_O, zfin, gw0, gw1, G1t + (size_t)(c - 1) * RC * DM, tid);
    rec_mfma(buf, S, wid, c16, quad);
    if (c + 1 < NC) rec_alpha(R1, K, lds + R_PS + ((c + 1) & 1) * R_PSZ, lds + ((c + 1) & 1) * R_BUF, wid, lane);
    if (c + 2 < NC) rec_cumsum(R2, K, lds + R_PS + (c & 1) * R_PSZ, wid, lane);
    LDS_BAR();
}
__device__ __forceinline__ void p_recurrence(LAS unsigned char* lds, const bf16_t* REC, const float* gnw, bf16_t* G1, int G) {
    const int tid = threadIdx.x, lane = tid & 63, wid = __builtin_amdgcn_readfirstlane(tid >> 6), c16 = lane & 15, quad = lane >> 4;
    constexpr int NC = SEQ / RC;
    static_assert(NC % 3 == 1, "chunk loop is unrolled by 3 with one tail chunk");
    for (int u = blockIdx.x; u < NB * 8; u += G) {
        const int b = u >> 3, h = u & 7;
        const size_t hrow = (size_t)u * SEQ;
        const f32x4 gw0 = *(const f32x4*)(gnw + 8 * (tid & 15)), gw1 = *(const f32x4*)(gnw + 8 * (tid & 15) + 4);
        bf16_t* G1t = G1 + ((size_t)b * SEQ + (tid >> 4)) * DM + h * 128 + 8 * (tid & 15);
        f32x4 S[8];
#pragma unroll
        for (int kt = 0; kt < 8; ++kt) S[kt] = (f32x4){0.f, 0.f, 0.f, 0.f};
        RecRegs A, B, C; RecCarry K; u32x4 znext = (u32x4){0u, 0u, 0u, 0u};
        rec_load(A, REC, hrow, wid, lane); rec_load(B, REC, hrow + RC, wid, lane); rec_load(C, REC, hrow + 2 * RC, wid, lane);
        rec_cumsum(A, K, lds + R_PS, wid, lane);
        LDS_BAR();
        rec_alpha(A, K, lds + R_PS, lds, wid, lane);
        rec_cumsum(B, K, lds + R_PS + R_PSZ, wid, lane);
        LDS_BAR();
        for (int c = 0; c < NC - 1; c += 3) {
            rec_iter(lds, REC, hrow, G1t, c, A, B, C, K, znext, S, gw0, gw1, tid, lane, wid, c16, quad);
            rec_iter(lds, REC, hrow, G1t, c + 1, B, C, A, K, znext, S, gw0, gw1, tid, lane, wid, c16, quad);
            rec_iter(lds, REC, hrow, G1t, c + 2, C, A, B, K, znext, S, gw0, gw1, tid, lane, wid, c16, quad);
        }
        rec_iter(lds, REC, hrow, G1t, NC - 1, A, B, C, K, znext, S, gw0, gw1, tid, lane, wid, c16, quad);
        rec_finalize(lds + ((NC - 1) & 1) * R_BUF + R_O, znext, gw0, gw1, G1t + (size_t)(NC - 1) * RC * DM, tid);
        LDS_BAR();
    }
}

#define XB_TMO      128
#define XB_XCNT(j)  (256  + 64 * (j))
#define XB_XSUB(j)  (1280 + 64 * (j))
#define XB_XGEN(j)  (2304 + 64 * (j))
#define XB_TOP      3328
#define XB_TOPGEN   3392
#define XCD_BAR_WORDS 3456
#define XB_SPIN_CAP (1u << 18)
__device__ __forceinline__ unsigned xb_ld(unsigned* p)              { return __hip_atomic_load(p, __ATOMIC_RELAXED, __HIP_MEMORY_SCOPE_AGENT); }
__device__ __forceinline__ unsigned xb_add(unsigned* p, unsigned v) { return __hip_atomic_fetch_add(p, v, __ATOMIC_RELAXED, __HIP_MEMORY_SCOPE_AGENT); }
__device__ __forceinline__ unsigned xb_xcc_id() { return (unsigned)__builtin_amdgcn_s_getreg((3 << 11) | 20) & 0xFu; }
#define XB_SPIN(cond, bar) do { unsigned _sp = 0; while (cond) { __builtin_amdgcn_s_sleep(1); \
    if ((++_sp & 255u) == 0u) { if (xb_ld(&(bar)[XB_TMO])) break; if (_sp > XB_SPIN_CAP) { atomicAdd(&(bar)[XB_TMO], 1u); break; } } } } while (0)
struct XcdBarrier { unsigned* bar; unsigned x; volatile LAS unsigned* st; };
__device__ __forceinline__ XcdBarrier xcd_barrier_post(unsigned* bar, volatile LAS unsigned* st) {
    XcdBarrier b; b.bar = bar; b.x = xb_xcc_id(); b.st = st;
    if (threadIdx.x == 0) (void)xb_add(&bar[XB_XCNT(b.x)], 1u);
    return b;
}
__device__ __forceinline__ void xcd_barrier_complete(unsigned* bar, unsigned x, unsigned& nloc, unsigned& nx) {
    const unsigned G = gridDim.x * gridDim.y * gridDim.z;
    unsigned sum, cnt, mine, sp = 0u;
    for (;;) {
        sum = 0u; cnt = 0u; mine = 0u;
#pragma unroll
        for (unsigned j = 0; j < 16; ++j) { const unsigned c = xb_ld(&bar[XB_XCNT(j)]); sum += c; cnt += (c > 0u) ? 1u : 0u; mine = (j == x) ? c : mine; }
        if (sum == G) break;
        __builtin_amdgcn_s_sleep(1);
        if ((++sp & 255u) == 0u) { if (xb_ld(&bar[XB_TMO])) break; if (sp > XB_SPIN_CAP) { atomicAdd(&bar[XB_TMO], 1u); break; } }
    }
    nloc = mine > 0u ? mine : 1u; nx = cnt > 0u ? cnt : 1u;
}
__device__ __forceinline__ void xcd_barrier(const XcdBarrier& b) {
    asm volatile("s_waitcnt vmcnt(0)" ::: "memory");
    __syncthreads();
    if (threadIdx.x == 0) {
        unsigned* bar = b.bar;
        __builtin_amdgcn_s_waitcnt(0);
        unsigned nloc = b.st[0], nx = b.st[1];
        if (nloc == 0u) { xcd_barrier_complete(bar, b.x, nloc, nx); b.st[0] = nloc; b.st[1] = nx; }
        const unsigned old = xb_add(&bar[XB_XSUB(b.x)], 1u);
        const unsigned gen = old / nloc;
        if (old + 1u == (gen + 1u) * nloc) {
            __builtin_amdgcn_fence(__ATOMIC_RELEASE, "agent");
            asm volatile("s_waitcnt vmcnt(0)" ::: "memory");
            const unsigned og = xb_add(&bar[XB_TOP], 1u);
            const unsigned tg = og / nx;
            if (og + 1u == (tg + 1u) * nx) xb_add(&bar[XB_TOPGEN], 1u);
            else XB_SPIN(xb_ld(&bar[XB_TOPGEN]) == tg, bar);
            __builtin_amdgcn_fence(__ATOMIC_ACQUIRE, "agent");
            xb_add(&bar[XB_XGEN(b.x)], 1u);
            asm volatile("s_waitcnt vmcnt(0)" ::: "memory");
        } else {
            XB_SPIN(xb_ld(&bar[XB_XGEN(b.x)]) == gen, bar);
            __builtin_amdgcn_fence(__ATOMIC_ACQUIRE, "agent");
            asm volatile("s_waitcnt vmcnt(0)" ::: "memory");
        }
    }
    __syncthreads();
}

constexpr int MISC_OFF = 147456 - 64;
constexpr int XCH_OFF = 131072;
constexpr int LDS_BYTES = 147456;
static_assert(pg8::STAGE_BYTES <= LDS_BYTES && ATTN_LDS <= MISC_OFF && R_END <= LDS_BYTES, "LDS map");
constexpr int N_PHASES = 9;
#define PROBE_LO -1
#define PROBE_HI 2
#define PROBE_NULL 0

__global__ void __launch_bounds__(512, 2) hybrid_fwd(Args a) {
    extern __shared__ __attribute__((aligned(16))) unsigned char lds_raw[];
    LAS unsigned char* lds = (LAS unsigned char*)lds_raw;
    cg::grid_group grid = cg::this_grid();
    const int G = gridDim.x;
    const int lo = a.ph_lo, hi = a.ph_hi;
    unsigned char* ws = a.ws;
#define IN(k) (lo <= (k) && (k) < hi)
#define SEAM(k) do { if (IN(k) && IN((k) + 1)) xcd_barrier(xbar); } while (0)
    unsigned* barw = (unsigned*)(ws + WS_BAR);
    volatile LAS unsigned* misc = (volatile LAS unsigned*)(lds + MISC_OFF);
    if (blockIdx.x == 0) for (int i = threadIdx.x; i < XCD_BAR_WORDS; i += 512) __hip_atomic_store(barw + i, 0u, __ATOMIC_RELAXED, __HIP_MEMORY_SCOPE_AGENT);
    if (threadIdx.x < 2) misc[threadIdx.x] = 0u;
    __syncthreads();
    grid.sync();
    XcdBarrier xbar = xcd_barrier_post(barw, misc);
    if (IN(0)) { p_prologue(a, lds, G); __syncthreads(); }
    SEAM(0);
    if (IN(1)) {
        pg8::Gemm g{(const bf16_t*)(ws + WS_H), (const bf16_t*)(ws + WS_WIN0), MTOK, ATTN_IN, DM}; pg8::StaticOrder S; S.init(MTOK, ATTN_IN, G, (int)blockIdx.x);
        pg8::EpiAttnIn E{(bf16_t*)(ws + WS_QKVZ), (const float*)(ws + WS_BIASP), (const unsigned*)(ws + WS_ROPE)};
#if PROBE_NULL
        if (a.flags) { pg8::EpiAttnInT<true> EN{(bf16_t*)(ws + WS_QKVZ), (const float*)(ws + WS_BIASP), (const unsigned*)(ws + WS_ROPE)}; pg8::gemm_phase<pg8::EpiAttnInT<true>, true, true>(lds, g, S, EN); } else
#endif
        pg8::gemm_phase<pg8::EpiAttnIn, true, true>(lds, g, S, E);
    }
    SEAM(1);
    if (IN(2)) p_attention(lds, (const bf16_t*)(ws + WS_QKVZ), a.a_sinks, (bf16_t*)(ws + WS_G0), G);
    SEAM(2);
    if (IN(3)) {
        pg8::Gemm g{(const bf16_t*)(ws + WS_G0), (const bf16_t*)(ws + WS_WOUT0), MTOK, DM, DM}; pg8::StaticOrder S; S.init(MTOK, DM, G, (int)blockIdx.x);
        pg8::EpiOut E{(bf16_t*)(ws + WS_Y), a.a_bout, (float*)(ws + WS_PART), (LAS float*)(lds + XCH_OFF)};
#if PROBE_NULL
        if (a.flags) { pg8::EpiNull EN{(float*)(ws + WS_PART)}; pg8::gemm_phase<pg8::EpiNull, true, true>(lds, g, S, EN); } else
#endif
        pg8::gemm_phase<pg8::EpiOut, true, true>(lds, g, S, E);
    }
    SEAM(3);
    if (IN(4)) p_mid((const bf16_t*)(ws + WS_Y), (const float*)(ws + WS_PART), a.x, a.post_w, a.pre_w + DM, (bf16_t*)(ws + WS_H), G);
    SEAM(4);
    if (IN(5)) {
        pg8::Gemm g{(const bf16_t*)(ws + WS_H), (const bf16_t*)(ws + WS_WIN1), MTOK, REC_IN, DM}; pg8::StaticOrder S; S.init(MTOK, REC_IN, G, (int)blockIdx.x);
        pg8::EpiRecIn E{(bf16_t*)(ws + WS_BIG), (const float*)(ws + WS_LB)};
#if PROBE_NULL
        if (a.flags) { pg8::EpiRecInT<true> EN{(bf16_t*)(ws + WS_BIG), (const float*)(ws + WS_LB)}; pg8::gemm_phase<pg8::EpiRecInT<true>, true, true>(lds, g, S, EN); } else
#endif
        pg8::gemm_phase<pg8::EpiRecIn, true, true>(lds, g, S, E);
    }
    SEAM(5);
    if (IN(6)) p_recurrence(lds, (const bf16_t*)(ws + WS_BIG), a.r_gw, (bf16_t*)(ws + WS_G1), G);
    SEAM(6);
    if (IN(7)) {
        pg8::Gemm g{(const bf16_t*)(ws + WS_G1), (const bf16_t*)(ws + WS_WOUT1), MTOK, DM, DM}; pg8::StaticOrder S; S.init(MTOK, DM, G, (int)blockIdx.x);
        pg8::EpiOut E{(bf16_t*)(ws + WS_H), nullptr, (float*)(ws + WS_PART1), (LAS float*)(lds + XCH_OFF)};
        pg8::gemm_phase<pg8::EpiOut, true, true>(lds, g, S, E);
    }
    SEAM(7);
    if (IN(8)) p_final((const bf16_t*)(ws + WS_Y), (const float*)(ws + WS_PART), (const bf16_t*)(ws + WS_H), (const float*)(ws + WS_PART1), a.x, a.post_w, a.post_w + DM, a.out, G);
#undef IN
#undef SEAM
}

extern "C" void kernel_launch(void* const* d_in, const int* in_sizes, int n_in, void* d_out, int out_size, void* d_ws, size_t ws_size, hipStream_t stream) {
    static int grid = 0;
    if (grid == 0) {
        if (n_in != 13 || in_sizes[0] != MTOK * DM || out_size != MTOK * DM || ws_size < WS_END) { fprintf(stderr, "kernel_launch: unexpected shapes (n_in %d, ws %zu < %zu)\n", n_in, ws_size, (size_t)WS_END); grid = -1; return; }
        int dev = 0, cus = 0, per_cu = 0;
        hipGetDevice(&dev); hipDeviceGetAttribute(&cus, hipDeviceAttributeMultiprocessorCount, dev);
        if (hipFuncSetAttribute((const void*)hybrid_fwd, hipFuncAttributeMaxDynamicSharedMemorySize, LDS_BYTES) != hipSuccess) { fprintf(stderr, "kernel_launch: hipFuncSetAttribute failed\n"); grid = -1; return; }
        if (hipOccupancyMaxActiveBlocksPerMultiprocessor(&per_cu, (const void*)hybrid_fwd, 512, LDS_BYTES) != hipSuccess || per_cu < 1) { fprintf(stderr, "kernel_launch: occupancy query says %d\n", per_cu); per_cu = 1; }
        (void)hipGetLastError();
        grid = cus * 1;
    }
    if (grid < 0) return;
    Args a{};
    a.x = (const float*)d_in[0]; a.pos = (const int*)d_in[1]; a.pre_w = (const float*)d_in[2]; a.post_w = (const float*)d_in[3];
    a.a_win = (const float*)d_in[4]; a.a_bin = (const float*)d_in[5]; a.a_sinks = (const float*)d_in[6]; a.a_wout = (const float*)d_in[7]; a.a_bout = (const float*)d_in[8];
    a.r_win = (const float*)d_in[9]; a.r_lbl = (const float*)d_in[10]; a.r_gw = (const float*)d_in[11]; a.r_wout = (const float*)d_in[12];
    a.out = (float*)d_out; a.ws = (unsigned char*)d_ws;
    void* args[] = {&a};
#if PROBE_LO >= 0
#if PROBE_NULL
    a.ph_lo = 0; a.ph_hi = PROBE_LO;
    if (PROBE_LO > 0) (void)hipLaunchCooperativeKernel((const void*)hybrid_fwd, dim3(grid), dim3(512), args, LDS_BYTES, stream);
    a.ph_lo = PROBE_LO; a.ph_hi = PROBE_HI; a.flags = 1;
    (void)hipLaunchCooperativeKernel((const void*)hybrid_fwd, dim3(grid), dim3(512), args, LDS_BYTES, stream);
    a.flags = 0;
#else
    a.ph_lo = 0; a.ph_hi = PROBE_HI;
    (void)hipLaunchCooperativeKernel((const void*)hybrid_fwd, dim3(grid), dim3(512), args, LDS_BYTES, stream);
#endif
    a.ph_lo = PROBE_LO; a.ph_hi = N_PHASES;
#else
    a.ph_lo = 0; a.ph_hi = N_PHASES;
#endif
    hipError_t e = hipLaunchCooperativeKernel((const void*)hybrid_fwd, dim3(grid), dim3(512), args, LDS_BYTES, stream);
    if (e != hipSuccess) fprintf(stderr, "kernel_launch: cooperative launch failed: %s (grid %d)\n", hipGetErrorString(e), grid);
}
```
